# Optimizing an MI355X kernel written in HIP

```python
import math
import jax, jax.numpy as jnp
from jax import lax
import numpy as np

D_MODEL = 2048
BATCH = 1
SEQ = 8192
DEPTH = 4

GRID_W = 64
MIX_WIDTH = D_MODEL
DIFF_HEADS = 8
DIFF_QK_DIM = MIX_WIDTH // (4 * DIFF_HEADS)
DIFF_V_DIM = 2 * DIFF_QK_DIM
DIFF_W = DIFF_HEADS * DIFF_V_DIM
NA_HEADS = 8
NA_HEAD_DIM = MIX_WIDTH // (2 * NA_HEADS)
NA_W = NA_HEADS * NA_HEAD_DIM
NA_WIN_ROWS = 8
NA_WIN_COLS = 16
IN_COLS = 3 * DIFF_W + 3 * NA_W
D_FF = 4 * D_MODEL
ROPE_THETA = 10000.0
EPS = 1e-6
Q_BLOCK = 128

kernel_name = "hybrid_diffattn_natten_encoder"


def rmsnorm(x, g):
    xf = x.astype(jnp.float32)
    y = xf * lax.rsqrt(jnp.mean(xf * xf, axis=-1, keepdims=True) + EPS)
    return (y * g.astype(jnp.float32)).astype(x.dtype)


def rope_tables(seq, dim):
    inv_freq = 1.0 / (ROPE_THETA ** (jnp.arange(0, dim, 2, dtype=jnp.float32) / dim))
    ang = jnp.arange(seq, dtype=jnp.float32)[:, None] * inv_freq[None, :]
    return jnp.cos(ang), jnp.sin(ang)


def apply_rope(x, cos, sin):
    xf = x.astype(jnp.float32)
    x1, x2 = jnp.split(xf, 2, axis=-1)
    c = cos[None, :, None, None, :]
    s = sin[None, :, None, None, :]
    return jnp.concatenate([x1 * c - x2 * s, x2 * c + x1 * s], axis=-1).astype(x.dtype)


def diff_attention(q, k, v, lam, lambda_init, subln_g):
    b, s, h, _, d = q.shape
    nblk = s // Q_BLOCK
    scale = d ** -0.5
    qb = jnp.moveaxis(q.reshape(b, nblk, Q_BLOCK, h, 2, d), 1, 0)

    def block(qi):
        sc = jnp.einsum('bqhmd,bkhmd->bhmqk', qi, k).astype(jnp.float32) * scale
        p = jax.nn.softmax(sc, axis=-1)
        w = (p[:, :, 0] - lam * p[:, :, 1]).astype(v.dtype)
        return jnp.einsum('bhqk,bkhe->bqhe', w, v)

    o = lax.map(block, qb)
    o = jnp.moveaxis(o, 0, 1).reshape(b, s, h, DIFF_V_DIM)
    o = rmsnorm(o, subln_g) * (1.0 - lambda_init)
    return o.reshape(b, s, h * DIFF_V_DIM)


def neighbourhood_attention(q, k, v, rpb):
    b, s, h, d = q.shape
    rows = s // GRID_W
    kr = min(NA_WIN_ROWS, rows)
    kc = NA_WIN_COLS
    scale = d ** -0.5
    qg = q.reshape(b, rows, GRID_W, h, d)
    kg = k.reshape(b, rows, GRID_W, h, d)
    vg = v.reshape(b, rows, GRID_W, h, d)
    c = np.arange(GRID_W)
    cs = np.clip(c - kc // 2, 0, GRID_W - kc)
    col_idx = cs[:, None] + np.arange(kc)
    col_rel = col_idx - c[:, None] + (NA_WIN_COLS - 1)

    def row_block(r):
        rs = jnp.clip(r - kr // 2, 0, rows - kr)
        q_r = lax.dynamic_index_in_dim(qg, r, axis=1, keepdims=False)
        k_rows = lax.dynamic_slice_in_dim(kg, rs, kr, axis=1)
        v_rows = lax.dynamic_slice_in_dim(vg, rs, kr, axis=1)
        k_nb = k_rows[:, :, col_idx]
        v_nb = v_rows[:, :, col_idx]
        row_rel = rs + jnp.arange(kr) - r + (NA_WIN_ROWS - 1)
        bias = jnp.take(rpb, row_rel, axis=1)[:, :, col_rel]
        bias = jnp.transpose(bias, (0, 2, 1, 3)).astype(jnp.float32)
        sc = jnp.einsum('bchd,brcjhd->bhcrj', q_r, k_nb).astype(jnp.float32) * scale + bias[None]
        p = jax.nn.softmax(sc.reshape(b, h, GRID_W, kr * kc), axis=-1).reshape(b, h, GRID_W, kr, kc)
        return jnp.einsum('bhcrj,brcjhd->bchd', p.astype(v.dtype), v_nb)

    o = lax.map(row_block, jnp.arange(rows))
    return jnp.moveaxis(o, 0, 1).reshape(b, s, h * d)


def setup_inputs(seed: int = 0) -> dict:
    key = jax.random.key(seed)
    ks = jax.random.split(key, 15)
    f32 = jnp.float32
    nrm = lambda k, shape, sc: jax.random.normal(k, shape, f32) * sc
    return {
        "x": nrm(ks[0], (BATCH, SEQ, D_MODEL), 1.0),
        "attn_norm": 1.0 + nrm(ks[1], (DEPTH, D_MODEL), 0.05),
        "w_in": nrm(ks[2], (DEPTH, D_MODEL, IN_COLS), D_MODEL ** -0.5),
        "lambda_q1": nrm(ks[3], (DEPTH, DIFF_QK_DIM), 0.1),
        "lambda_k1": nrm(ks[4], (DEPTH, DIFF_QK_DIM), 0.1),
        "lambda_q2": nrm(ks[5], (DEPTH, DIFF_QK_DIM), 0.1),
        "lambda_k2": nrm(ks[6], (DEPTH, DIFF_QK_DIM), 0.1),
        "diff_subln": 1.0 + nrm(ks[7], (DEPTH, DIFF_V_DIM), 0.05),
        "na_norm": 1.0 + nrm(ks[8], (DEPTH, NA_W), 0.05),
        "na_rpb": nrm(ks[9], (DEPTH, NA_HEADS, 2 * NA_WIN_ROWS - 1, 2 * NA_WIN_COLS - 1), 0.1),
        "w_out": nrm(ks[10], (DEPTH, MIX_WIDTH, D_MODEL), MIX_WIDTH ** -0.5),
        "mlp_norm": 1.0 + nrm(ks[11], (DEPTH, D_MODEL), 0.05),
        "w_mlp_in": nrm(ks[12], (DEPTH, D_MODEL, D_FF), D_MODEL ** -0.5),
        "w_mlp_out": nrm(ks[13], (DEPTH, D_FF, D_MODEL), D_FF ** -0.5),
        "final_norm": 1.0 + nrm(ks[14], (D_MODEL,), 0.05),
    }


def reference(x, attn_norm, w_in, lambda_q1, lambda_k1, lambda_q2, lambda_k2, diff_subln,
              na_norm, na_rpb, w_out, mlp_norm, w_mlp_in, w_mlp_out, final_norm):
    b, s, _ = x.shape
    cos, sin = rope_tables(s, DIFF_QK_DIM)
    split_pts = [DIFF_W, 2 * DIFF_W, 3 * DIFF_W, 3 * DIFF_W + NA_W, 3 * DIFF_W + 2 * NA_W]
    for l in range(DEPTH):
        lambda_init = 0.8 - 0.6 * math.exp(-0.3 * l)
        h = rmsnorm(x, attn_norm[l])
        proj = jnp.einsum('bsd,dc->bsc', h, w_in[l])
        qd, kd, vd, qn, kn, vn = jnp.split(proj, split_pts, axis=-1)
        qd = apply_rope(qd.reshape(b, s, DIFF_HEADS, 2, DIFF_QK_DIM), cos, sin)
        kd = apply_rope(kd.reshape(b, s, DIFF_HEADS, 2, DIFF_QK_DIM), cos, sin)
        vd = vd.reshape(b, s, DIFF_HEADS, DIFF_V_DIM)
        lam = (jnp.exp(jnp.sum(lambda_q1[l].astype(jnp.float32) * lambda_k1[l].astype(jnp.float32)))
               - jnp.exp(jnp.sum(lambda_q2[l].astype(jnp.float32) * lambda_k2[l].astype(jnp.float32)))
               + lambda_init)
        o_diff = diff_attention(qd, kd, vd, lam, lambda_init, diff_subln[l])
        o_na = neighbourhood_attention(qn.reshape(b, s, NA_HEADS, NA_HEAD_DIM),
                                       kn.reshape(b, s, NA_HEADS, NA_HEAD_DIM),
                                       vn.reshape(b, s, NA_HEADS, NA_HEAD_DIM),
                                       na_rpb[l])
        o_na = rmsnorm(o_na, na_norm[l])
        mix = jnp.concatenate([o_diff, o_na], axis=-1)
        x = x + jnp.einsum('bsc,cd->bsd', mix, w_out[l])
        h = rmsnorm(x, mlp_norm[l])
        u = jax.nn.relu(jnp.einsum('bsd,df->bsf', h, w_mlp_in[l]))
        x = x + jnp.einsum('bsf,fd->bsd', u * u, w_mlp_out[l])
    return rmsnorm(x, final_norm)
```

```cpp
#include <hip/hip_runtime.h>
#include <hip/hip_cooperative_groups.h>
#include <cstdio>
#include <cstdint>
namespace cg = cooperative_groups;
namespace pg8 {
#define PG8_LAS __attribute__((address_space(3)))
typedef unsigned short bf16_t;
typedef short bf16x8 __attribute__((ext_vector_type(8)));
typedef float f32x4 __attribute__((ext_vector_type(4)));
typedef unsigned u32x4 __attribute__((ext_vector_type(4)));
constexpr int BM = 256, BK = 64, HALF = 128, HTB = HALF * BK * 2  , STAGE_BYTES = 8 * HTB, NXCD = 8, WGM = 8;

__host__ __device__ __forceinline__ int lds_byte(int r, int c) { const int st = (r >> 4) * 2 + (c >> 5), rr = r & 15, cc = c & 31, ob = rr * 64 + cc * 2; return st * 1024 + (ob ^ (((ob >> 9) & 1) << 5)); }
__host__ __device__ __forceinline__ void stage_rc(int b, int& R, int& C) { const int st = b / 1024, sb = b % 1024, swz = sb ^ (((sb >> 9) & 1) << 5); R = (st >> 1) * 16 + swz / 64; C = (st & 1) * 32 + (swz % 64) / 2; }
__host__ __device__ __forceinline__ int perm32(int rho) { const int n = rho >> 4, i = rho & 15; return 8 * (i >> 2) + 4 * n + (i & 3); }

struct Unit { int pm, pn; };
struct Gemm { const bf16_t* A; const bf16_t* Bt; int M, N, K; };

struct StaticOrder {
    int nM, nN, nwg, G, c;
    __host__ __device__ void init(int M, int N, int G_, int c_) { nM = M / BM; nN = N / BM; nwg = nM * nN; G = G_; c = c_; }
    __host__ __device__ bool next(int i, Unit& u) const {
        const long L = (long)i * G + c; if (L >= nwg) return false;
        int wgid = (int)L; { const int q = nwg / NXCD, r = nwg % NXCD, xcd = wgid % NXCD, off = wgid / NXCD; wgid = (xcd < r ? xcd * (q + 1) : r * (q + 1) + (xcd - r) * q) + off; }
        const int nig = WGM * nN, gid = wgid / nig, fm = gid * WGM, gsz = (nM - fm) < WGM ? (nM - fm) : WGM;
        u.pm = fm + ((wgid % nig) % gsz); u.pn = (wgid % nig) / gsz; return true;
    }
    __device__ __forceinline__ void a_ready(const Unit&) const {}
    __device__ __forceinline__ void done(const Unit&) const {}
};

__device__ __forceinline__ unsigned cvt_pk_bf16(float lo, float hi) { unsigned r; asm volatile("v_cvt_pk_bf16_f32 %0, %1, %2" : "=v"(r) : "v"(lo), "v"(hi)); return r; }
typedef float f32x2 __attribute__((ext_vector_type(2)));
typedef unsigned u32x2 __attribute__((ext_vector_type(2)));
constexpr float RMS_EPS = 1e-6f;
__device__ __forceinline__ float row_rstd(const float* ss, int row, int fq) {
    const f32x4* sp = (const f32x4*)(ss + (size_t)row * 32 + fq * 8); const f32x4 a = sp[0], b = sp[1];
    float s = ((a[0] + a[1]) + (a[2] + a[3])) + ((b[0] + b[1]) + (b[2] + b[3]));
    s += __shfl_xor(s, 16); s += __shfl_xor(s, 32);
    return rsqrtf(s * (1.0f / 2048.0f) + RMS_EPS);
}
struct EpiProj {
    static constexpr bool PERM = true, AFTER_DRAIN = false, MIDK = false;
    bf16_t* O; const float* ss; const float* cosT; const float* sinT;
    __device__ __forceinline__ void operator()(const f32x4 (&acc)[2][2][4][2], const Unit& u, int wr, int wc, int fr, int fq) const {
        const int row0 = u.pm * BM + wr * 64 + fr; const int colt = u.pn * BM;
        const bool rope = colt < 2048;
        const float qs = colt < 1024 ? 0.125f * 1.4426950408889634f : 1.f;
        const int g = (wc & 1) * 4 + fq;
        const int pos0 = colt + wc * 32 + 8 * fq;
        const int rbase = colt + 64 * (wc >> 1) + 4 * g;
#pragma unroll
        for (int ai = 0; ai < 2; ++ai)
#pragma unroll
            for (int m = 0; m < 4; ++m) {
                const int row = row0 + ai * HALF + m * 16;
                const float rs = row_rstd(ss, row, fq) * qs;
                bf16_t* rowp = O + (size_t)row * 6144;
                if (rope) {
                    const f32x4 c4 = *(const f32x4*)(cosT + row * 32 + 4 * g), s4 = *(const f32x4*)(sinT + row * 32 + 4 * g);
#pragma unroll
                    for (int bj = 0; bj < 2; ++bj) {
                        const f32x4 v0 = acc[ai][bj][m][0] * rs, v1 = acc[ai][bj][m][1] * rs;
                        const f32x4 o1 = v0 * c4 - v1 * s4, o2 = v1 * c4 + v0 * s4;
                        u32x2 w1, w2; w1.x = cvt_pk_bf16(o1[0], o1[1]); w1.y = cvt_pk_bf16(o1[2], o1[3]); w2.x = cvt_pk_bf16(o2[0], o2[1]); w2.y = cvt_pk_bf16(o2[2], o2[3]);
                        *(u32x2*)(rowp + rbase + bj * HALF) = w1; *(u32x2*)(rowp + rbase + bj * HALF + 32) = w2;
                    }
                } else {
#pragma unroll
                    for (int bj = 0; bj < 2; ++bj) {
                        const f32x4 v0 = acc[ai][bj][m][0] * rs, v1 = acc[ai][bj][m][1] * rs;
                        u32x4 w; w.x = cvt_pk_bf16(v0[0], v0[1]); w.y = cvt_pk_bf16(v0[2], v0[3]); w.z = cvt_pk_bf16(v1[0], v1[1]); w.w = cvt_pk_bf16(v1[2], v1[3]);
                        *(u32x4*)(rowp + pos0 + bj * HALF) = w;
                    }
                }
            }
    }
};
struct EpiRelu2 {
    static constexpr bool PERM = true, AFTER_DRAIN = false, MIDK = false;
    bf16_t* O; const float* ss;
    __device__ __forceinline__ void operator()(const f32x4 (&acc)[2][2][4][2], const Unit& u, int wr, int wc, int fr, int fq) const {
        const int row0 = u.pm * BM + wr * 64 + fr; const int pos0 = u.pn * BM + wc * 32 + 8 * fq;
#pragma unroll
        for (int ai = 0; ai < 2; ++ai)
#pragma unroll
            for (int m = 0; m < 4; ++m) {
                const int row = row0 + ai * HALF + m * 16;
                const float rs = row_rstd(ss, row, fq);
                bf16_t* rowp = O + (size_t)row * 8192 + pos0;
#pragma unroll
                for (int bj = 0; bj < 2; ++bj) {
                    f32x4 v0 = acc[ai][bj][m][0] * rs, v1 = acc[ai][bj][m][1] * rs;
#pragma unroll
                    for (int e = 0; e < 4; ++e) { v0[e] = fmaxf(v0[e], 0.f); v1[e] = fmaxf(v1[e], 0.f); }
                    v0 = v0 * v0; v1 = v1 * v1;
                    u32x4 w; w.x = cvt_pk_bf16(v0[0], v0[1]); w.y = cvt_pk_bf16(v0[2], v0[3]); w.z = cvt_pk_bf16(v1[0], v1[1]); w.w = cvt_pk_bf16(v1[2], v1[3]);
                    *(u32x4*)(rowp + bj * HALF) = w;
                }
            }
    }
};
template <bool MID> struct EpiResidT {
    static constexpr bool PERM = false, AFTER_DRAIN = false, MIDK = MID;
    const float* Xin; float* X; bf16_t* XB; float* ssout; float sign; const float* nass;
    __device__ __forceinline__ void mid(f32x4 (&acc)[2][2][4][2], const Unit& u, int wr, int wc, int fr, int fq) const {
        int t_ = threadIdx.x; asm volatile("" : "+v"(t_));
        const int row0 = u.pm * BM + wr * 64 + (t_ & 15);
#pragma unroll
        for (int ai = 0; ai < 2; ++ai)
#pragma unroll
            for (int m = 0; m < 4; ++m) {
                const f32x4* sp = (const f32x4*)(nass + (size_t)(row0 + ai * HALF + m * 16) * 8); const f32x4 a = sp[0], b = sp[1];
                const float rn = rsqrtf((((a[0] + a[1]) + (a[2] + a[3])) + ((b[0] + b[1]) + (b[2] + b[3]))) * (1.0f / 1024.0f) + RMS_EPS);
#pragma unroll
                for (int bj = 0; bj < 2; ++bj)
#pragma unroll
                    for (int n = 0; n < 2; ++n) acc[ai][bj][m][n] = acc[ai][bj][m][n] * rn;
            }
    }
    __device__ __forceinline__ void operator()(const f32x4 (&acc)[2][2][4][2], const Unit& u, int wr, int wc, int fr, int fq) const {
        const int row0 = u.pm * BM + wr * 64 + fr; const int col0 = u.pn * BM + wc * 32 + 4 * fq;
#pragma unroll
        for (int ai = 0; ai < 2; ++ai)
#pragma unroll
            for (int m = 0; m < 4; ++m) {
                const int row = row0 + ai * HALF + m * 16; float sq = 0.f;
#pragma unroll
                for (int bj = 0; bj < 2; ++bj)
#pragma unroll
                    for (int n = 0; n < 2; ++n) {
                        const size_t off = (size_t)row * 2048 + col0 + bj * HALF + n * 16;
                        const f32x4 xv = *(const f32x4*)(Xin + off) + acc[ai][bj][m][n] * sign;
                        *(f32x4*)(X + off) = xv;
                        u32x2 w; w.x = cvt_pk_bf16(xv[0], xv[1]); w.y = cvt_pk_bf16(xv[2], xv[3]);
                        *(u32x2*)(XB + off) = w;
                        sq += (xv[0] * xv[0] + xv[1] * xv[1]) + (xv[2] * xv[2] + xv[3] * xv[3]);
                    }
                sq += __shfl_xor(sq, 16); sq += __shfl_xor(sq, 32);
                if (fq == 0) ssout[(size_t)row * 32 + u.pn * 4 + wc] = sq;
            }
    }
};
typedef EpiResidT<false> EpiResid; typedef EpiResidT<true> EpiResidMid;
template <class Epi, class Sched, bool ALIGN_EPI = false, bool SP2 = false>
__device__ __forceinline__ void gemm_phase(PG8_LAS unsigned char* lds, const Gemm g, const Sched& S, const Epi& E) {
    int tid_ = threadIdx.x; asm volatile("" : "+v"(tid_));
    const int tid = tid_, wid = __builtin_amdgcn_readfirstlane(tid >> 6), lane = tid & 63, wr = wid >> 2, wc = wid & 3, fr = lane & 15, fq = lane >> 4;
    const int K = g.K, nt = K / BK;
    unsigned voffA[2], voffB[2];
#pragma unroll
    for (int i = 0; i < 2; ++i) { int R, C; stage_rc(tid * 16 + i * 8192, R, C); const int Rb = Epi::PERM ? ((R & ~31) + perm32(R & 31)) : R;
        voffA[i] = (unsigned)(R * K + C) * 2u; voffB[i] = (unsigned)(Rb * K + C) * 2u; }
    const size_t kstep = (size_t)(BK * 2);
    const size_t hstep = (size_t)HALF * K * 2;
    const size_t tstep = 2 * hstep;
    const unsigned ldsw = (unsigned)wid * 1024u;
    const int aoff = lds_byte(wr * 64 + fr, fq * 8), boff = lds_byte(wc * 32 + fr, fq * 8);
#define PG8_SA(b, h) (((b) * 2 + (h)) * HTB)
#define PG8_SB(b, h) ((4 + (b) * 2 + (h)) * HTB)
#define PG8_STAGE(bufoff, gbase, voff) do { _Pragma("unroll") for (int _i = 0; _i < 2; ++_i) \
        __builtin_amdgcn_global_load_lds((const unsigned*)((const char*)(gbase) + (voff)[_i]), (PG8_LAS unsigned*)(lds + (bufoff) + ldsw + _i * 8192), 16, 0, 0); } while (0)
#define PG8_LDA(dst, b, h) do { _Pragma("unroll") for (int m = 0; m < 4; ++m) _Pragma("unroll") for (int k = 0; k < 2; ++k) dst[m][k] = *(const PG8_LAS bf16x8*)(lds + PG8_SA(b, h) + aoff + m * 2048 + k * 1024); } while (0)
#define PG8_LDB(dst, b, h) do { _Pragma("unroll") for (int n = 0; n < 2; ++n) _Pragma("unroll") for (int k = 0; k < 2; ++k) dst[n][k] = *(const PG8_LAS bf16x8*)(lds + PG8_SB(b, h) + boff + n * 2048 + k * 1024); } while (0)
#define PG8_MMA(ai, bj, At, Bt) do { __builtin_amdgcn_s_setprio(1); _Pragma("unroll") for (int m = 0; m < 4; ++m) _Pragma("unroll") for (int n = 0; n < 2; ++n) _Pragma("unroll") for (int k = 0; k < 2; ++k) \
        acc[ai][bj][m][n] = __builtin_amdgcn_mfma_f32_16x16x32_bf16(Bt[n][k], At[m][k], acc[ai][bj][m][n], 0, 0, 0); __builtin_amdgcn_s_setprio(0); } while (0)
#define PG8_WAIT_V(n) asm volatile("s_waitcnt vmcnt(" #n ")" ::: "memory")
#define PG8_WAIT_L(n) asm volatile("s_waitcnt lgkmcnt(" #n ")" ::: "memory")
#define PG8_BAR __builtin_amdgcn_s_barrier()
#define PG8_SCHED __builtin_amdgcn_sched_barrier(0)
    Unit cur, nxt; int ui = 0;
    if (!S.next(0, cur)) return;
    f32x4 acc[2][2][4][2];
#pragma unroll
    for (int a = 0; a < 2; ++a)
#pragma unroll
        for (int b = 0; b < 2; ++b)
#pragma unroll
            for (int m = 0; m < 4; ++m)
#pragma unroll
                for (int n = 0; n < 2; ++n) acc[a][b][m][n] = (f32x4){0.f, 0.f, 0.f, 0.f};
    bf16x8 At[4][2], B0[2][2], B1[2][2];
    const char* cA = (const char*)g.A + (size_t)cur.pm * tstep; const char* cB = (const char*)g.Bt + (size_t)cur.pn * tstep;
    S.a_ready(cur);
    if constexpr (SP2) {
        PG8_STAGE(PG8_SB(0, 0), cB, voffB); PG8_STAGE(PG8_SB(0, 1), cB + hstep, voffB); PG8_STAGE(PG8_SA(0, 0), cA, voffA); PG8_STAGE(PG8_SA(0, 1), cA + hstep, voffA);
        if (wr == 1) PG8_BAR;
        PG8_WAIT_V(2); PG8_BAR;
        PG8_STAGE(PG8_SB(1, 0), cB + kstep, voffB); PG8_STAGE(PG8_SA(1, 0), cA + kstep, voffA); PG8_STAGE(PG8_SB(1, 1), cB + hstep + kstep, voffB);
        PG8_WAIT_V(6); PG8_BAR;
    } else {
        PG8_STAGE(PG8_SB(0, 0), cB, voffB); PG8_STAGE(PG8_SA(0, 0), cA, voffA); PG8_STAGE(PG8_SB(0, 1), cB + hstep, voffB); PG8_STAGE(PG8_SA(0, 1), cA + hstep, voffA);
        if (wr == 1) PG8_BAR;
        PG8_WAIT_V(4); PG8_BAR;
        PG8_STAGE(PG8_SB(1, 0), cB + kstep, voffB); PG8_STAGE(PG8_SA(1, 0), cA + kstep, voffA); PG8_STAGE(PG8_SB(1, 1), cB + hstep + kstep, voffB);
        PG8_WAIT_V(6); PG8_BAR;
    }
    for (;;) {
        const bool has_next = S.next(ui + 1, nxt);
        const char* nA = has_next ? (const char*)g.A + (size_t)nxt.pm * tstep : cA; const char* nB = has_next ? (const char*)g.Bt + (size_t)nxt.pn * tstep : cB;
        for (int t = 0; t < nt; t += 2) {
            if constexpr (Epi::MIDK) { if (t == nt / 2) E.mid(acc, cur, wr, wc, fr, fq); }
            const bool last = (t == nt - 2);
            const char* a1 = cA + (size_t)(t + 1) * kstep;
            const char* a2 = last ? nA : cA + (size_t)(t + 2) * kstep; const char* b2 = last ? nB : cB + (size_t)(t + 2) * kstep;
            const char* a3 = a2 + kstep; const char* b3 = b2 + kstep;
            if (last && has_next) S.a_ready(nxt);
            if constexpr (SP2) {
            PG8_LDB(B0, 0, 0); PG8_LDB(B1, 0, 1); PG8_SCHED; PG8_LDA(At, 0, 0); PG8_STAGE(PG8_SA(1, 1), a1 + hstep, voffA);
            PG8_WAIT_V(8); PG8_WAIT_L(0); PG8_BAR; PG8_MMA(0, 0, At, B0); PG8_MMA(0, 1, At, B1); PG8_BAR; PG8_SCHED;
            PG8_LDA(At, 0, 1); PG8_STAGE(PG8_SB(0, 0), b2, voffB); PG8_STAGE(PG8_SB(0, 1), b2 + hstep, voffB); PG8_STAGE(PG8_SA(0, 0), a2, voffA);
            PG8_WAIT_V(8); PG8_WAIT_L(0); PG8_BAR; PG8_MMA(1, 0, At, B0); PG8_MMA(1, 1, At, B1); PG8_BAR; PG8_SCHED;
            PG8_LDB(B0, 1, 0); PG8_LDB(B1, 1, 1); PG8_SCHED; PG8_LDA(At, 1, 0); PG8_STAGE(PG8_SA(0, 1), a2 + hstep, voffA);
            PG8_WAIT_V(8); PG8_WAIT_L(0); PG8_BAR; PG8_MMA(0, 0, At, B0); PG8_MMA(0, 1, At, B1); PG8_BAR; PG8_SCHED;
            PG8_LDA(At, 1, 1); PG8_STAGE(PG8_SB(1, 0), b3, voffB); PG8_STAGE(PG8_SB(1, 1), b3 + hstep, voffB); PG8_STAGE(PG8_SA(1, 0), a3, voffA);
            PG8_WAIT_V(8); PG8_WAIT_L(0); PG8_BAR; PG8_MMA(1, 0, At, B0); PG8_MMA(1, 1, At, B1); PG8_BAR; PG8_SCHED;
            } else {
            PG8_LDB(B0, 0, 0); PG8_SCHED; PG8_LDA(At, 0, 0); PG8_STAGE(PG8_SA(1, 1), a1 + hstep, voffA);
            PG8_WAIT_L(8); PG8_BAR; PG8_WAIT_L(0); PG8_MMA(0, 0, At, B0); PG8_BAR; PG8_SCHED;
            PG8_LDB(B1, 0, 1); PG8_STAGE(PG8_SB(0, 0), b2, voffB);
            PG8_BAR; PG8_WAIT_L(0); PG8_MMA(0, 1, At, B1); PG8_BAR;
            PG8_LDA(At, 0, 1); PG8_STAGE(PG8_SA(0, 0), a2, voffA);
            PG8_BAR; PG8_WAIT_L(0); PG8_MMA(1, 0, At, B0); PG8_BAR; PG8_SCHED;
            PG8_STAGE(PG8_SB(0, 1), b2 + hstep, voffB);
            PG8_WAIT_V(6); PG8_BAR; PG8_MMA(1, 1, At, B1); PG8_BAR;
            PG8_LDB(B0, 1, 0); PG8_SCHED; PG8_LDA(At, 1, 0); PG8_STAGE(PG8_SA(0, 1), a2 + hstep, voffA);
            PG8_WAIT_L(8); PG8_BAR; PG8_WAIT_L(0); PG8_MMA(0, 0, At, B0); PG8_BAR; PG8_SCHED;
            PG8_LDB(B1, 1, 1); PG8_STAGE(PG8_SB(1, 0), b3, voffB);
            PG8_BAR; PG8_WAIT_L(0); PG8_MMA(0, 1, At, B1); PG8_BAR;
            PG8_LDA(At, 1, 1); PG8_STAGE(PG8_SA(1, 0), a3, voffA);
            PG8_BAR; PG8_WAIT_L(0); PG8_MMA(1, 0, At, B0); PG8_BAR; PG8_SCHED;
            PG8_STAGE(PG8_SB(1, 1), b3 + hstep, voffB);
            PG8_WAIT_V(6); PG8_BAR; PG8_MMA(1, 1, At, B1); PG8_BAR;
            }
        }
        if constexpr (ALIGN_EPI) { if (wr == 0) PG8_BAR; }
        if constexpr (!Epi::AFTER_DRAIN) { E(acc, cur, wr, wc, fr, fq); S.done(cur); }
        if (!has_next) break;
#pragma unroll
        for (int a = 0; a < 2; ++a)
#pragma unroll
            for (int b = 0; b < 2; ++b)
#pragma unroll
                for (int m = 0; m < 4; ++m)
#pragma unroll
                    for (int n = 0; n < 2; ++n) acc[a][b][m][n] = (f32x4){0.f, 0.f, 0.f, 0.f};
        cur = nxt; cA = nA; cB = nB; ++ui;
        if constexpr (ALIGN_EPI) { if (wr == 1) PG8_BAR; }
    }
    PG8_WAIT_V(0);
    if constexpr (!ALIGN_EPI) { if (wr == 0) PG8_BAR; }
    PG8_BAR;
    if constexpr (Epi::AFTER_DRAIN) { E.fused(acc, cur, wr, wc, fr, fq, lds, wid, lane); S.done(cur); }
#undef PG8_SA
#undef PG8_SB
#undef PG8_STAGE
#undef PG8_LDA
#undef PG8_LDB
#undef PG8_MMA
#undef PG8_WAIT_V
#undef PG8_WAIT_L
#undef PG8_BAR
#undef PG8_SCHED
}
}
namespace att {
typedef unsigned short bf16;
using bf16x8 = __attribute__((ext_vector_type(8))) short;
using s16x4  = __attribute__((ext_vector_type(4))) short;
using f32x16 = __attribute__((ext_vector_type(16))) float;
using u32x4  = __attribute__((ext_vector_type(4))) unsigned;
constexpr int LDP = 6144;
constexpr int SHM_V = 64 * 128 * 2, SHM_K = 64 * 128 * 2;
constexpr int OFF_WS = 2 * SHM_V + 2 * SHM_K, OFF_RPB = OFF_WS + 8 * 64 * 4, ATT_LDS = OFF_RPB + 2048;
constexpr float THR = 8.f;
#define KSWZ(row, colB) ((row) * 256 + ((colB) ^ (((row) & 7) << 4)))
#define SBAR() __builtin_amdgcn_sched_barrier(0)
__device__ __forceinline__ int crow(int r, int hi) { return (r & 3) + 8 * (r >> 2) + 4 * hi; }
__device__ __forceinline__ unsigned cvtpk(float lo, float hi) {
  unsigned r; asm volatile("v_cvt_pk_bf16_f32 %0, %1, %2" : "=v"(r) : "v"(lo), "v"(hi)); return r;
}
__device__ __forceinline__ bf16x8 ld8(const bf16* p) { return *reinterpret_cast<const bf16x8*>(p); }

template <int MODE> struct Cfg;
template <> struct Cfg<0> { static constexpr int ND0 = 4; static constexpr float SCALE = 0.125f; };
template <> struct Cfg<1> { static constexpr int ND0 = 8; static constexpr float SCALE = 0.088388347648318440f; };

template <int MODE>
__device__ __forceinline__ void partialSM(f32x16& p0, f32x16& p1, float& m_reg, float& mn, float& alpha) {
  constexpr float SCALE = Cfg<MODE>::SCALE;
  constexpr float C = SCALE * 1.4426950408889634f;
  float pmax = p0[0];
#pragma unroll
  for (int r = 1; r < 16; ++r) pmax = fmaxf(pmax, p0[r]);
#pragma unroll
  for (int r = 0; r < 16; ++r) pmax = fmaxf(pmax, p1[r]);
  { auto rr = __builtin_amdgcn_permlane32_swap(__float_as_uint(pmax), __float_as_uint(pmax), false, false);
    pmax = fmaxf(__uint_as_float(rr[0]), __uint_as_float(rr[1])); }
  if (__builtin_expect(__all(pmax - m_reg <= THR / SCALE), 1)) { mn = m_reg; alpha = 1.f; }
  else { mn = fmaxf(m_reg, pmax); alpha = __builtin_amdgcn_exp2f((m_reg - mn) * C); m_reg = mn; }
  float mnC = -mn * C;
#pragma unroll
  for (int r = 0; r < 16; ++r) p0[r] = fmaf(p0[r], C, mnC);
#pragma unroll
  for (int r = 0; r < 16; ++r) p1[r] = fmaf(p1[r], C, mnC);
#pragma unroll
  for (int r = 0; r < 16; ++r) p0[r] = __builtin_amdgcn_exp2f(p0[r]);
}
__device__ __forceinline__ void finishSM(f32x16& p0, f32x16& p1, float alpha, float& l_reg, bf16x8& pa0, bf16x8& pa1, bf16x8& pa2, bf16x8& pa3) {
#pragma unroll
  for (int r = 0; r < 16; ++r) p1[r] = __builtin_amdgcn_exp2f(p1[r]);
  float ps = 0;
#pragma unroll
  for (int r = 0; r < 16; ++r) ps += p0[r];
#pragma unroll
  for (int r = 0; r < 16; ++r) ps += p1[r];
  { auto rr = __builtin_amdgcn_permlane32_swap(__float_as_uint(ps), __float_as_uint(ps), false, false);
    ps = __uint_as_float(rr[0]) + __uint_as_float(rr[1]); }
  l_reg = l_reg * alpha + ps;
#define PK4(P, BASE, OUT) do { unsigned a0 = cvtpk(P[BASE + 0], P[BASE + 1]), a1 = cvtpk(P[BASE + 2], P[BASE + 3]);   \
    unsigned b0 = cvtpk(P[BASE + 4], P[BASE + 5]), b1 = cvtpk(P[BASE + 6], P[BASE + 7]);                              \
    auto r0 = __builtin_amdgcn_permlane32_swap(a0, b0, false, false); auto r1 = __builtin_amdgcn_permlane32_swap(a1, b1, false, false); \
    u32x4 w = {r0[0], r1[0], r0[1], r1[1]}; OUT = *reinterpret_cast<bf16x8*>(&w); } while (0)
  PK4(p0, 0, pa0); PK4(p0, 8, pa1); PK4(p1, 0, pa2); PK4(p1, 8, pa3);
#undef PK4
}
__device__ __forceinline__ void finishSM_ns(f32x16& p0, f32x16& p1, bf16x8& pa0, bf16x8& pa1, bf16x8& pa2, bf16x8& pa3) {
#pragma unroll
  for (int r = 0; r < 16; ++r) p1[r] = __builtin_amdgcn_exp2f(p1[r]);
#define PK4(P, BASE, OUT) do { unsigned a0 = cvtpk(P[BASE + 0], P[BASE + 1]), a1 = cvtpk(P[BASE + 2], P[BASE + 3]);   \
    unsigned b0 = cvtpk(P[BASE + 4], P[BASE + 5]), b1 = cvtpk(P[BASE + 6], P[BASE + 7]);                              \
    auto r0 = __builtin_amdgcn_permlane32_swap(a0, b0, false, false); auto r1 = __builtin_amdgcn_permlane32_swap(a1, b1, false, false); \
    u32x4 w = {r0[0], r1[0], r0[1], r1[1]}; OUT = *reinterpret_cast<bf16x8*>(&w); } while (0)
  PK4(p0, 0, pa0); PK4(p0, 8, pa1); PK4(p1, 0, pa2); PK4(p1, 8, pa3);
#undef PK4
}
__device__ __forceinline__ void sm_sum(const f32x16& p0, const f32x16& p1, float& ps) {
  ps = 0;
#pragma unroll
  for (int r = 0; r < 16; ++r) ps += p0[r];
#pragma unroll
  for (int r = 0; r < 16; ++r) ps += p1[r];
}
template <int MODE>
__device__ __forceinline__ void sm_lmax(float ps, float alpha_prev, float& l_reg, const f32x16& p0, const f32x16& p1, float& m_reg, float& mn, float& alpha, float& mnC) {
  constexpr float SCALE = Cfg<MODE>::SCALE; constexpr float C = SCALE * 1.4426950408889634f;
  { auto rr = __builtin_amdgcn_permlane32_swap(__float_as_uint(ps), __float_as_uint(ps), false, false);
    ps = __uint_as_float(rr[0]) + __uint_as_float(rr[1]); }
  l_reg = l_reg * alpha_prev + ps;
  float pmax = p0[0];
#pragma unroll
  for (int r = 1; r < 16; ++r) pmax = fmaxf(pmax, p0[r]);
#pragma unroll
  for (int r = 0; r < 16; ++r) pmax = fmaxf(pmax, p1[r]);
  { auto rr = __builtin_amdgcn_permlane32_swap(__float_as_uint(pmax), __float_as_uint(pmax), false, false);
    pmax = fmaxf(__uint_as_float(rr[0]), __uint_as_float(rr[1])); }
  if (__builtin_expect(__all(pmax - m_reg <= THR / SCALE), 1)) { mn = m_reg; alpha = 1.f; }
  else { mn = fmaxf(m_reg, pmax); alpha = __builtin_amdgcn_exp2f((m_reg - mn) * C); m_reg = mn; }
  mnC = -mn * C;
}
template <int MODE>
__device__ __forceinline__ void sm_fma(f32x16& p0, f32x16& p1, float mnC) {
  constexpr float C = Cfg<MODE>::SCALE * 1.4426950408889634f;
#pragma unroll
  for (int r = 0; r < 16; ++r) p0[r] = fmaf(p0[r], C, mnC);
#pragma unroll
  for (int r = 0; r < 16; ++r) p1[r] = fmaf(p1[r], C, mnC);
}
__device__ __forceinline__ void sm_exp0(f32x16& p0) {
#pragma unroll
  for (int r = 0; r < 16; ++r) p0[r] = __builtin_amdgcn_exp2f(p0[r]);
}
template <int ND0>
__device__ __forceinline__ void qkt(f32x16& p0, f32x16& p1, const bf16* Ks, const bf16x8* qr, int r32, int hi, int kcb) {
  p0 = f32x16{}; p1 = f32x16{};
#pragma unroll
  for (int d0 = 0; d0 < ND0; ++d0) { int cb = kcb + (d0 * 16 + hi * 8) * 2;
    bf16x8 b0 = *reinterpret_cast<const bf16x8*>((const char*)Ks + KSWZ(r32, cb));
    bf16x8 b1 = *reinterpret_cast<const bf16x8*>((const char*)Ks + KSWZ(32 + r32, cb));
    p0 = __builtin_amdgcn_mfma_f32_32x32x16_bf16(b0, qr[d0], p0, 0, 0, 0);
    p1 = __builtin_amdgcn_mfma_f32_32x32x16_bf16(b1, qr[d0], p1, 0, 0, 0); }
}
constexpr float THRL = 8.f * 1.4426950408889634f;
template <int ND0>
__device__ __forceinline__ void qkt_c(f32x16& p0, f32x16& p1, const bf16* Ks, const bf16x8* qr, int r32, int hi, int kcb, const f32x16& negm) {
#pragma unroll
  for (int d0 = 0; d0 < ND0; ++d0) { int cb = kcb + (d0 * 16 + hi * 8) * 2;
    bf16x8 b0 = *reinterpret_cast<const bf16x8*>((const char*)Ks + KSWZ(r32, cb));
    bf16x8 b1 = *reinterpret_cast<const bf16x8*>((const char*)Ks + KSWZ(32 + r32, cb));
    if (d0 == 0) { p0 = __builtin_amdgcn_mfma_f32_32x32x16_bf16(b0, qr[d0], negm, 0, 0, 0); p1 = __builtin_amdgcn_mfma_f32_32x32x16_bf16(b1, qr[d0], negm, 0, 0, 0); }
    else { p0 = __builtin_amdgcn_mfma_f32_32x32x16_bf16(b0, qr[d0], p0, 0, 0, 0); p1 = __builtin_amdgcn_mfma_f32_32x32x16_bf16(b1, qr[d0], p1, 0, 0, 0); } }
}
__device__ __forceinline__ float rowmax32(const f32x16& p0, const f32x16& p1) {
  float pmax = p0[0];
#pragma unroll
  for (int r = 1; r < 16; ++r) pmax = fmaxf(pmax, p0[r]);
#pragma unroll
  for (int r = 0; r < 16; ++r) pmax = fmaxf(pmax, p1[r]);
  auto rr = __builtin_amdgcn_permlane32_swap(__float_as_uint(pmax), __float_as_uint(pmax), false, false);
  return fmaxf(__uint_as_float(rr[0]), __uint_as_float(rr[1]));
}
__device__ __forceinline__ void firstSM_l2(f32x16& p0, f32x16& p1, float& m_reg, f32x16& negm) {
  const float pmax = rowmax32(p0, p1);
  m_reg = pmax;
#pragma unroll
  for (int r = 0; r < 16; ++r) { negm[r] = -pmax; p0[r] -= pmax; p1[r] -= pmax; }
#pragma unroll
  for (int r = 0; r < 16; ++r) p0[r] = __builtin_amdgcn_exp2f(p0[r]);
}
__device__ __forceinline__ void sm_lmax_l2(float ps, float alpha_prev, float& l_reg, f32x16& p0, f32x16& p1, float& m_reg, float& alpha, f32x16& negm) {
  { auto rr = __builtin_amdgcn_permlane32_swap(__float_as_uint(ps), __float_as_uint(ps), false, false);
    ps = __uint_as_float(rr[0]) + __uint_as_float(rr[1]); }
  l_reg = l_reg * alpha_prev + ps;
  const float pmax = rowmax32(p0, p1);
  if (__builtin_expect(__all(pmax <= THRL), 1)) { alpha = 1.f; }
  else { const float dlt = fmaxf(pmax, 0.f); alpha = __builtin_amdgcn_exp2f(-dlt); m_reg += dlt;
#pragma unroll
    for (int r = 0; r < 16; ++r) { negm[r] -= dlt; p0[r] -= dlt; p1[r] -= dlt; } }
}
__device__ __forceinline__ void sm_exp_lo(f32x16& p0) {
#pragma unroll
  for (int r = 0; r < 8; ++r) p0[r] = __builtin_amdgcn_exp2f(p0[r]);
}
__device__ __forceinline__ void sm_exp_hi(f32x16& p0) {
#pragma unroll
  for (int r = 8; r < 16; ++r) p0[r] = __builtin_amdgcn_exp2f(p0[r]);
}
__device__ __forceinline__ int v_st(int k, int c) { const int kk = (k & ~0xC) | ((k & 4) << 1) | ((k & 8) >> 1); return ((kk >> 3) * 4 + (c >> 5)) * 512 + ((kk & 7) * 32 + (c & 31)) * 2; }
__device__ __forceinline__ int v_rd_base(int lane) { return ((lane & 3) << 3) | (((lane >> 2) & 3) << 6) | (((lane >> 4) & 1) << 5) | (((lane >> 5) & 1) << 8); }
constexpr int v_rd_off(int d0, int ks, int half) { return d0 * 512 + ks * 4096 + half * 2048; }
template <int OFF> __device__ __forceinline__ s16x4 tr_read(int vb) {
  s16x4 r; asm volatile("ds_read_b64_tr_b16 %0, %1 offset:%2" : "=&v"(r) : "v"(vb), "i"(OFF) : "memory"); return r;
}
template <int D0> __device__ __forceinline__ void pv_one(f32x16& od, int vb, bf16x8 pa0, bf16x8 pa1, bf16x8 pa2, bf16x8 pa3) {
  const s16x4 l0 = tr_read<v_rd_off(D0, 0, 0)>(vb), h0 = tr_read<v_rd_off(D0, 0, 1)>(vb), l1 = tr_read<v_rd_off(D0, 1, 0)>(vb), h1 = tr_read<v_rd_off(D0, 1, 1)>(vb);
  const s16x4 l2 = tr_read<v_rd_off(D0, 2, 0)>(vb), h2 = tr_read<v_rd_off(D0, 2, 1)>(vb), l3 = tr_read<v_rd_off(D0, 3, 0)>(vb), h3 = tr_read<v_rd_off(D0, 3, 1)>(vb);
  asm volatile("s_waitcnt lgkmcnt(0)" ::: "memory"); SBAR();
#define PK(L, H) (bf16x8){L[0], L[1], L[2], L[3], H[0], H[1], H[2], H[3]}
  od = __builtin_amdgcn_mfma_f32_32x32x16_bf16(pa0, PK(l0, h0), od, 0, 0, 0);
  od = __builtin_amdgcn_mfma_f32_32x32x16_bf16(pa1, PK(l1, h1), od, 0, 0, 0);
  od = __builtin_amdgcn_mfma_f32_32x32x16_bf16(pa2, PK(l2, h2), od, 0, 0, 0);
  od = __builtin_amdgcn_mfma_f32_32x32x16_bf16(pa3, PK(l3, h3), od, 0, 0, 0);
#undef PK
}
__device__ __forceinline__ void pv_d0(f32x16* o, int vb, bf16x8 pa0, bf16x8 pa1, bf16x8 pa2, bf16x8 pa3) {
  pv_one<0>(o[0], vb, pa0, pa1, pa2, pa3); pv_one<1>(o[1], vb, pa0, pa1, pa2, pa3); pv_one<2>(o[2], vb, pa0, pa1, pa2, pa3); pv_one<3>(o[3], vb, pa0, pa1, pa2, pa3);
}
struct VFrag { s16x4 l0, h0, l1, h1, l2, h2, l3, h3; };
template <int D0> __device__ __forceinline__ void pv_rd(VFrag& f, int vb) {
  f.l0 = tr_read<v_rd_off(D0, 0, 0)>(vb); f.h0 = tr_read<v_rd_off(D0, 0, 1)>(vb); f.l1 = tr_read<v_rd_off(D0, 1, 0)>(vb); f.h1 = tr_read<v_rd_off(D0, 1, 1)>(vb);
  f.l2 = tr_read<v_rd_off(D0, 2, 0)>(vb); f.h2 = tr_read<v_rd_off(D0, 2, 1)>(vb); f.l3 = tr_read<v_rd_off(D0, 3, 0)>(vb); f.h3 = tr_read<v_rd_off(D0, 3, 1)>(vb);
}
__device__ __forceinline__ void pv_mm(f32x16& od, const VFrag& f, bf16x8 pa0, bf16x8 pa1, bf16x8 pa2, bf16x8 pa3) {
  asm volatile("s_waitcnt lgkmcnt(0)" ::: "memory"); SBAR();
#define PK(L, H) (bf16x8){L[0], L[1], L[2], L[3], H[0], H[1], H[2], H[3]}
  od = __builtin_amdgcn_mfma_f32_32x32x16_bf16(pa0, PK(f.l0, f.h0), od, 0, 0, 0);
  od = __builtin_amdgcn_mfma_f32_32x32x16_bf16(pa1, PK(f.l1, f.h1), od, 0, 0, 0);
  od = __builtin_amdgcn_mfma_f32_32x32x16_bf16(pa2, PK(f.l2, f.h2), od, 0, 0, 0);
  od = __builtin_amdgcn_mfma_f32_32x32x16_bf16(pa3, PK(f.l3, f.h3), od, 0, 0, 0);
#undef PK
}
__device__ __forceinline__ void na_fix(f32x16& p0, f32x16& p1, int kr, int qr_, int rs, int qc, int cs, int hi, const float* rpbS) {
  const float NEG = -__builtin_inff();
  if (kr < rs || kr >= rs + 8) {
#pragma unroll
    for (int r = 0; r < 16; ++r) { p0[r] = NEG; p1[r] = NEG; }
  } else {
    const float* brow = rpbS + (kr - qr_ + 7) * 31 + (15 - qc);
#pragma unroll
    for (int g = 0; g < 4; ++g) {
#pragma unroll
      for (int q = 0; q < 4; ++q) { const int r = 4 * g + q;
        const int k0 = crow(r, hi), k1 = 32 + k0;
        const bool v0 = (unsigned)(k0 - cs) < 16u, v1 = (unsigned)(k1 - cs) < 16u;
        const float b0 = brow[v0 ? k0 : qc], b1 = brow[v1 ? k1 : qc];
        p0[r] = (p0[r] + b0) + (v0 ? 0.f : NEG); p1[r] = (p1[r] + b1) + (v1 ? 0.f : NEG);
      }
      SBAR();
    }
  }
}

template <int MODE>
__device__ __forceinline__ void attn_core(const bf16* __restrict__ Qw, const bf16* __restrict__ Kh, const bf16* __restrict__ Vh, const int NT, char* lds, const int kcb,
                                          const int, const int, const int, const int, const int, f32x16 (&o)[4], float& l_reg) {
  constexpr int ND0 = Cfg<MODE>::ND0;
  int tid_ = threadIdx.x; asm volatile("" : "+v"(tid_));
  const int tid = tid_, wid = __builtin_amdgcn_readfirstlane(tid >> 6), lane = tid & 63, r32 = lane & 31, hi = lane >> 5, half = wid >> 2, ht = tid & 255;
  bf16* V_lds = (bf16*)lds; bf16* K_lds = (bf16*)(lds + 2 * SHM_V);
  float* ws = (float*)(lds + OFF_WS) + wid * 64; float* al_l = ws + 32;
  float m_reg = 0.f; l_reg = 0.f; f32x16 negm = f32x16{};
#pragma unroll
  for (int d = 0; d < 4; ++d) o[d] = f32x16{};
  bf16x8 qr[ND0];
#pragma unroll
  for (int d0 = 0; d0 < ND0; ++d0) qr[d0] = ld8(Qw + d0 * 16);
  const int vb0 = (int)(uintptr_t)V_lds + v_rd_base(lane);
  {
    const int sr = tid >> 4, sc = (tid & 15) * 8;
    const bf16x8 v0 = ld8(&Vh[(long)sr * LDP + sc]), v1 = ld8(&Vh[(long)(32 + sr) * LDP + sc]), k0 = ld8(&Kh[(long)sr * LDP + sc]), k1 = ld8(&Kh[(long)(32 + sr) * LDP + sc]);
    *(bf16x8*)((char*)V_lds + v_st(sr, sc)) = v0; *(bf16x8*)((char*)V_lds + v_st(32 + sr, sc)) = v1;
    *(bf16x8*)((char*)K_lds + KSWZ(sr, sc * 2)) = k0; *(bf16x8*)((char*)K_lds + KSWZ(32 + sr, sc * 2)) = k1; }
  const int hr = ht >> 4, hc = (ht & 15) * 8;
  const bf16* Sg = (half == 0 ? Kh : Vh) + (long)hr * LDP + hc;
  char* Sl = half == 0 ? (char*)K_lds : (char*)V_lds;
  int soff[4];
#pragma unroll
  for (int i = 0; i < 4; ++i) soff[i] = half == 0 ? KSWZ(hr + 16 * i, hc * 2) : v_st(hr + 16 * i, hc);
  bf16x8 st[4];
#define HLOAD(t) do { _Pragma("unroll") for (int i = 0; i < 4; ++i) st[i] = ld8(Sg + (long)((t) * 64 + 16 * i) * LDP); } while (0)
#define HWRITE(b) do { _Pragma("unroll") for (int i = 0; i < 4; ++i) *(bf16x8*)(Sl + (b) * SHM_V + soff[i]) = st[i]; } while (0)
#define BAR_P() do { asm volatile("" : "+v"(p0), "+v"(p1)); SBAR(); asm volatile("s_waitcnt lgkmcnt(0)\n\ts_barrier" ::: "memory"); SBAR(); } while (0)
#define BAR_A() do { asm volatile("" : "+v"(pa0), "+v"(pa1), "+v"(pa2), "+v"(pa3)); SBAR(); asm volatile("s_waitcnt lgkmcnt(0)\n\ts_barrier" ::: "memory"); SBAR(); } while (0)
  f32x16 p0 = f32x16{}, p1 = f32x16{}; bf16x8 pa0, pa1, pa2, pa3; float alpha;
#define VSEG(FIRST) do { alpha = 1.f; const float pmax_ = rowmax32(p0, p1); \
    if (FIRST) { m_reg = pmax_; _Pragma("unroll") for (int r = 0; r < 16; ++r) { negm[r] = -pmax_; p0[r] -= pmax_; p1[r] -= pmax_; } } \
    else if (!__builtin_expect(__all(pmax_ <= THRL), 1)) { const float dlt_ = fmaxf(pmax_, 0.f); alpha = __builtin_amdgcn_exp2f(-dlt_); m_reg += dlt_; \
      _Pragma("unroll") for (int r = 0; r < 16; ++r) { negm[r] -= dlt_; p0[r] -= dlt_; p1[r] -= dlt_; } \
      if (hi == 0) al_l[r32] = alpha; asm volatile("s_waitcnt lgkmcnt(0)" ::: "memory"); \
      _Pragma("unroll") for (int d = 0; d < 4; ++d) _Pragma("unroll") for (int r = 0; r < 16; ++r) o[d][r] *= al_l[crow(r, hi)]; } \
    sm_exp0(p0); finishSM(p0, p1, alpha, l_reg, pa0, pa1, pa2, pa3); } while (0)
  __syncthreads();
  HLOAD(1);
  if (half == 1) BAR_P();
  qkt<ND0>(p0, p1, K_lds, qr, r32, hi, kcb);
  BAR_P();
  VSEG(true); HWRITE(1); HLOAD(2); BAR_A();
  pv_d0(o, vb0, pa0, pa1, pa2, pa3); qkt_c<ND0>(p0, p1, (bf16*)((char*)K_lds + SHM_K), qr, r32, hi, kcb, negm); BAR_P();
#pragma unroll 1
  for (int j = 1; j + 1 < NT; j += 2) {
    VSEG(false); HWRITE(0); HLOAD(j + 2); BAR_A();
    pv_d0(o, vb0 + SHM_V, pa0, pa1, pa2, pa3); qkt_c<ND0>(p0, p1, K_lds, qr, r32, hi, kcb, negm); BAR_P();
    VSEG(false); HWRITE(1); if (j + 3 < NT) HLOAD(j + 3); BAR_A();
    pv_d0(o, vb0, pa0, pa1, pa2, pa3); qkt_c<ND0>(p0, p1, (bf16*)((char*)K_lds + SHM_K), qr, r32, hi, kcb, negm); BAR_P();
  }
  VSEG(false); BAR_A();
  pv_d0(o, vb0 + SHM_V, pa0, pa1, pa2, pa3); BAR_P();
  if (half == 0) BAR_P();
#undef VSEG
#undef HLOAD
#undef HWRITE
#undef BAR_P
#undef BAR_A
}
__device__ __forceinline__ float half_sum32(float v) {
#pragma unroll
  for (int o = 1; o < 32; o <<= 1) v += __shfl_xor(v, o);
  return v;
}
__device__ __forceinline__ void diff_unit(const bf16* __restrict__ proj, bf16* __restrict__ mix, int h, int q0, float lam, float oml, const float* __restrict__ subg, char* lds) {
  int tid_ = threadIdx.x; asm volatile("" : "+v"(tid_));
  const int tid = tid_, wid = tid >> 6, lane = tid & 63, r32 = lane & 31, hi = lane >> 5, map = wid >> 2, wq = wid & 3;
  const bf16* Qw = proj + (size_t)(q0 + wq * 32 + r32) * LDP + h * 128 + map * 64 + hi * 8;
  f32x16 o[4]; float l_reg;
  attn_core<0>(Qw, proj + 1024 + h * 128, proj + 2048 + h * 128, 8192 / 64, lds, map * 128, 0, 0, 0, 0, 0, o, l_reg);
  float* ws = (float*)(lds + OFF_WS) + wid * 64;
  if (hi == 0) ws[r32] = l_reg;
  asm volatile("s_waitcnt lgkmcnt(0)" ::: "memory");
  float rli[16];
#pragma unroll
  for (int r = 0; r < 16; ++r) rli[r] = __builtin_amdgcn_rcpf(ws[crow(r, hi)]);
  __syncthreads();
  float* X = (float*)lds + (wq * 64) * 64 + lane;
  if (map == 1) {
#pragma unroll
    for (int d = 0; d < 4; ++d)
#pragma unroll
      for (int r = 0; r < 16; ++r) X[(d * 16 + r) * 64] = o[d][r] * rli[r];
  }
  __syncthreads();
  if (map == 0) {
    float gv[4];
#pragma unroll
    for (int d = 0; d < 4; ++d) gv[d] = subg[32 * d + r32] * oml;
    bf16* Ow = mix + (size_t)(q0 + wq * 32) * 2048 + 1024 + h * 128 + r32;
#pragma unroll
    for (int r = 0; r < 16; ++r) {
      float dv[4]; float sq = 0.f;
#pragma unroll
      for (int d = 0; d < 4; ++d) { dv[d] = o[d][r] * rli[r] - lam * X[(d * 16 + r) * 64]; sq += dv[d] * dv[d]; }
      sq = half_sum32(sq);
      const float rn = rsqrtf(sq * (1.0f / 128.0f) + 1e-6f);
      bf16* orow = Ow + (size_t)crow(r, hi) * 2048;
#pragma unroll
      for (int d = 0; d < 4; ++d) orow[32 * d] = (bf16)(cvtpk(dv[d] * rn * gv[d], 0.f) & 0xffffu);
    }
  }
  __syncthreads();
}
__device__ __forceinline__ void attn_na_core(const bf16* __restrict__ Qw, const bf16* __restrict__ Kh, const bf16* __restrict__ Vh, const int NT, char* lds,
                                             const int na_qr, const int na_rs, const int na_qc, const int na_cs, const int na_k0, f32x16 (&o)[4], float& l_reg) {
  int tid_ = threadIdx.x; asm volatile("" : "+v"(tid_));
  const int tid = tid_, wid = tid >> 6, lane = tid & 63, r32 = lane & 31, hi = lane >> 5;
  bf16* V_lds = (bf16*)lds; bf16* K_lds = (bf16*)(lds + 2 * SHM_V);
  float* ws = (float*)(lds + OFF_WS) + wid * 64; float* al_l = ws + 32;
  const float* rpbS = (const float*)(lds + OFF_RPB);
  float m_reg = -1e30f; l_reg = 0.f;
#pragma unroll
  for (int d = 0; d < 4; ++d) o[d] = f32x16{};
  bf16x8 qr[8];
#pragma unroll
  for (int d0 = 0; d0 < 8; ++d0) qr[d0] = ld8(Qw + d0 * 16);
  const int sr = tid >> 4, sc = (tid & 15) * 8, vst0 = v_st(sr, sc), vst1 = v_st(32 + sr, sc);
  const int vb0 = (int)(uintptr_t)V_lds + v_rd_base(lane);
  bf16x8 vs0, vs1, ks0, ks1;
#define SLOAD(k0) do { vs0 = ld8(&Vh[(long)((k0) + sr) * LDP + sc]); vs1 = ld8(&Vh[(long)((k0) + 32 + sr) * LDP + sc]); \
    ks0 = ld8(&Kh[(long)((k0) + sr) * LDP + sc]); ks1 = ld8(&Kh[(long)((k0) + 32 + sr) * LDP + sc]); } while (0)
  SLOAD(0);
#pragma unroll 1
  for (int j = 0; j < NT; ++j) {
    __syncthreads();
    *(bf16x8*)((char*)V_lds + vst0) = vs0; *(bf16x8*)((char*)V_lds + vst1) = vs1;
    *(bf16x8*)((char*)K_lds + KSWZ(sr, sc * 2)) = ks0; *(bf16x8*)((char*)K_lds + KSWZ(32 + sr, sc * 2)) = ks1;
    if (j + 1 < NT) SLOAD((j + 1) * 64);
    __syncthreads();
    const int kr = na_k0 + j;
    if (kr >= na_rs && kr < na_rs + 8) {
      f32x16 p0, p1; float mn, al; bf16x8 pa0, pa1, pa2, pa3;
      qkt<8>(p0, p1, K_lds, qr, r32, hi, 0);
      na_fix(p0, p1, kr, na_qr, na_rs, na_qc, na_cs, hi, rpbS);
      partialSM<1>(p0, p1, m_reg, mn, al);
      if (__any(al < 1.f)) { if (hi == 0) al_l[r32] = al; asm volatile("s_waitcnt lgkmcnt(0)" ::: "memory");
#pragma unroll
        for (int d = 0; d < 4; ++d)
#pragma unroll
          for (int r = 0; r < 16; ++r) o[d][r] *= al_l[crow(r, hi)]; }
      finishSM(p0, p1, al, l_reg, pa0, pa1, pa2, pa3); SBAR();
      pv_d0(o, vb0, pa0, pa1, pa2, pa3);
    }
  }
#undef SLOAD
}
__device__ __forceinline__ void na_unit(const bf16* __restrict__ proj, bf16* __restrict__ mix, float* __restrict__ nass, int h, int rb, const float* __restrict__ rpb_h, char* lds) {
  int tid_ = threadIdx.x; asm volatile("" : "+v"(tid_));
  const int tid = tid_, wid = tid >> 6, lane = tid & 63, r32 = lane & 31, hi = lane >> 5;
  float* rpbS = (float*)(lds + OFF_RPB);
  if (tid < 15 * 31) rpbS[tid] = rpb_h[tid] * 11.313708498984761f;
  const int q0 = rb * 256; int k0row = rb * 4 - 4; k0row = k0row < 0 ? 0 : (k0row > 116 ? 116 : k0row);
  const int qr_ = rb * 4 + (wid >> 1), qc = (wid & 1) * 32 + r32;
  int rs = qr_ - 4; rs = rs < 0 ? 0 : (rs > 120 ? 120 : rs);
  int cs = qc - 8; cs = cs < 0 ? 0 : (cs > 48 ? 48 : cs);
  const bf16* Qw = proj + (size_t)(q0 + wid * 32 + r32) * LDP + 3072 + h * 128 + hi * 8;
  const bf16* Kh = proj + (size_t)k0row * 64 * LDP + 4096 + h * 128;
  const bf16* Vh = proj + (size_t)k0row * 64 * LDP + 5120 + h * 128;
  f32x16 o[4]; float l_reg;
  attn_na_core(Qw, Kh, Vh, 12, lds, qr_, rs, qc, cs, k0row, o, l_reg);
  int t2 = threadIdx.x; asm volatile("" : "+v"(t2));
  const int wid2 = t2 >> 6, r32b = t2 & 31, hib = (t2 >> 5) & 1;
  float* ws = (float*)(lds + OFF_WS) + wid2 * 64;
  if (hib == 0) ws[r32b] = l_reg;
  asm volatile("s_waitcnt lgkmcnt(0)" ::: "memory");
  bf16* Ow = mix + (size_t)(rb * 256 + wid2 * 32) * 2048 + h * 128 + r32b;
  float* nrow = nass + (size_t)(rb * 256 + wid2 * 32) * 8 + h;
#pragma unroll
  for (int r = 0; r < 16; ++r) {
    const float rl = __builtin_amdgcn_rcpf(ws[crow(r, hib)]);
    bf16* orow = Ow + (size_t)crow(r, hib) * 2048; float sq = 0.f;
#pragma unroll
    for (int d = 0; d < 4; ++d) { const float v = o[d][r] * rl; sq += v * v; orow[32 * d] = (bf16)(cvtpk(v, 0.f) & 0xffffu); }
    sq = half_sum32(sq);
    if (r32b == 0) nrow[(size_t)crow(r, hib) * 8] = sq;
  }
  __syncthreads();
}
#undef KSWZ
#undef SBAR
}
#define LAS __attribute__((address_space(3)))
typedef unsigned short bf16_t;
typedef unsigned v4u __attribute__((ext_vector_type(4)));
typedef unsigned v2u __attribute__((ext_vector_type(2)));
typedef float v4f __attribute__((ext_vector_type(4)));
#define XB_TMO      128
#define XB_XCNT(j)  (256  + 64 * (j))
#define XB_XSUB(j)  (1280 + 64 * (j))
#define XB_XGEN(j)  (2304 + 64 * (j))
#define XB_TOP      3328
#define XB_TOPGEN   3392
#define XCD_BAR_WORDS 3456
#define XB_SPIN_CAP (1u << 18)

__device__ __forceinline__ unsigned xb_ld(unsigned* p)              { return __hip_atomic_load(p, __ATOMIC_RELAXED, __HIP_MEMORY_SCOPE_AGENT); }
__device__ __forceinline__ unsigned xb_add(unsigned* p, unsigned v) { return __hip_atomic_fetch_add(p, v, __ATOMIC_RELAXED, __HIP_MEMORY_SCOPE_AGENT); }
__device__ __forceinline__ unsigned xb_xcc_id() { return (unsigned)__builtin_amdgcn_s_getreg((3 << 11) | 20) & 0xFu; }
#define XB_SPIN(cond, bar) do { unsigned _sp = 0; while (cond) { __builtin_amdgcn_s_sleep(1); \
    if ((++_sp & 255u) == 0u) { if (xb_ld(&(bar)[XB_TMO])) break; if (_sp > XB_SPIN_CAP) { atomicAdd(&(bar)[XB_TMO], 1u); break; } } } } while (0)

struct XcdBarrier {
    unsigned* bar; unsigned x;
    volatile LAS unsigned* st;
};

__device__ __forceinline__ XcdBarrier xcd_barrier_post(unsigned* bar, volatile LAS unsigned* st) {
    XcdBarrier b; b.bar = bar; b.x = xb_xcc_id(); b.st = st;
    if (threadIdx.x == 0) (void)xb_add(&bar[XB_XCNT(b.x)], 1u);
    return b;
}
__device__ __forceinline__ void xcd_barrier_complete(unsigned* bar, unsigned x, unsigned& nloc, unsigned& nx) {
    const unsigned G = gridDim.x * gridDim.y * gridDim.z;
    unsigned sum, cnt, mine, sp = 0u;
    for (;;) {
        sum = 0u; cnt = 0u; mine = 0u;
#pragma unroll
        for (unsigned j = 0; j < 16; ++j) { const unsigned c = xb_ld(&bar[XB_XCNT(j)]); sum += c; cnt += (c > 0u) ? 1u : 0u; mine = (j == x) ? c : mine; }
        if (sum == G) break;
        __builtin_amdgcn_s_sleep(1);
        if ((++sp & 255u) == 0u) { if (xb_ld(&bar[XB_TMO])) break; if (sp > XB_SPIN_CAP) { atomicAdd(&bar[XB_TMO], 1u); break; } }
    }
    nloc = mine > 0u ? mine : 1u; nx = cnt > 0u ? cnt : 1u;
}

__device__ __forceinline__ void xcd_barrier(const XcdBarrier& b) {
    asm volatile("s_waitcnt vmcnt(0)" ::: "memory");
    __syncthreads();
    if (threadIdx.x == 0) {
        unsigned xq = b.x; asm volatile("" : "+s"(xq));
        unsigned* bar = b.bar; asm volatile("" : "+s"(bar));
        __builtin_amdgcn_s_waitcnt(0);
        unsigned nloc = b.st[0], nx = b.st[1];
        if (nloc == 0u) { xcd_barrier_complete(bar, xq, nloc, nx); b.st[0] = nloc; b.st[1] = nx; }
        const unsigned old = xb_add(&bar[XB_XSUB(xq)], 1u);
        const unsigned gen = old / nloc;
        if (old + 1u == (gen + 1u) * nloc) {
            __builtin_amdgcn_fence(__ATOMIC_RELEASE, "agent");
            asm volatile("s_waitcnt vmcnt(0)" ::: "memory");
            const unsigned og = xb_add(&bar[XB_TOP], 1u);
            const unsigned tg = og / nx;
            if (og + 1u == (tg + 1u) * nx) xb_add(&bar[XB_TOPGEN], 1u);
            else XB_SPIN(xb_ld(&bar[XB_TOPGEN]) == tg, bar);
            __builtin_amdgcn_fence(__ATOMIC_ACQUIRE, "agent");
            xb_add(&bar[XB_XGEN(xq)], 1u);
            asm volatile("s_waitcnt vmcnt(0)" ::: "memory");
        } else {
            XB_SPIN(xb_ld(&bar[XB_XGEN(xq)]) == gen, bar);
            __builtin_amdgcn_fence(__ATOMIC_ACQUIRE, "agent");
            asm volatile("s_waitcnt vmcnt(0)" ::: "memory");
        }
    }
    __syncthreads();
}

constexpr int SEQ = 8192, DM = 2048, INC = 6144, FF = 8192, DEPTH = 4, NTHR = 512;
constexpr size_t SZ_WIN = (size_t)INC * DM * 2, SZ_WOUT = (size_t)DM * DM * 2, SZ_WMI = (size_t)FF * DM * 2, SZ_WMO = (size_t)DM * FF * 2;
constexpr size_t WS_WIN = 0, WS_WOUT = WS_WIN + DEPTH * SZ_WIN, WS_WMI = WS_WOUT + DEPTH * SZ_WOUT, WS_WMO = WS_WMI + DEPTH * SZ_WMI;
constexpr size_t WS_X = WS_WMO + DEPTH * SZ_WMO, WS_XB = WS_X + (size_t)SEQ * DM * 4, WS_PROJ = WS_XB + (size_t)SEQ * DM * 2, WS_MIX = WS_PROJ + (size_t)SEQ * INC * 2;
constexpr size_t WS_U = WS_MIX + (size_t)SEQ * DM * 2, WS_SS = WS_U + (size_t)SEQ * FF * 2, WS_COS = WS_SS + 9 * (size_t)SEQ * 32 * 4, WS_SIN = WS_COS + (size_t)SEQ * 32 * 4;
constexpr size_t WS_LAM = WS_SIN + (size_t)SEQ * 32 * 4, WS_BAR = WS_LAM + 256, WS_NASS = WS_BAR + 16384, WS_END = WS_NASS + (size_t)SEQ * 8 * 4;
#ifndef REP_P0
#define REP_P0 1
#endif
#ifndef REP_P1
#define REP_P1 1
#endif
#ifndef REP_P2
#define REP_P2 1
#endif
#ifndef REP_P3
#define REP_P3 1
#endif
#ifndef REP_P4
#define REP_P4 1
#endif
#ifndef REP_P6
#define REP_P6 1
#endif
#ifndef REP_P5
#define REP_P5 1
#endif
constexpr int LDS_BYTES = 139264;
static_assert(att::ATT_LDS <= LDS_BYTES && pg8::STAGE_BYTES <= LDS_BYTES, "LDS map");

struct Args {
    const float* in[15]; float* out; unsigned char* ws;
    double invf[32];
    float lam_init[4]; int pad[2];
};

__device__ __forceinline__ float wave_sum(float v) {
#pragma unroll
    for (int o = 1; o < 64; o <<= 1) v += __shfl_xor(v, o);
    return v;
}
__device__ __forceinline__ unsigned pk2(float lo, float hi) { return pg8::cvt_pk_bf16(lo, hi); }

struct TpItem { const float* W; bf16_t* WT; const float* gv; int K, N, k0, n0, krot; bool perm; };
__device__ __forceinline__ void tp_load(const TpItem& d, int lane, float (&w)[32]) {
    const float* wp = d.W + (size_t)(d.k0 + (lane >> 5)) * d.N + d.n0 + (lane & 31);
#pragma unroll
    for (int i = 0; i < 32; ++i) w[i] = wp[(size_t)(2 * i) * d.N];
}
__device__ __forceinline__ void tp_store(const TpItem& d, int lane, const float (&w)[32], LAS float* scr) {
    const int c = lane & 7;
    v4f g0 = {1.f, 1.f, 1.f, 1.f}, g1 = {1.f, 1.f, 1.f, 1.f};
    if (d.gv) { g0 = *(const v4f*)(d.gv + d.k0 + 8 * c); g1 = *(const v4f*)(d.gv + d.k0 + 8 * c + 4); }
#pragma unroll
    for (int i = 0; i < 32; ++i) scr[(2 * i + (lane >> 5)) * 33 + (lane & 31)] = w[i];
    asm volatile("s_waitcnt lgkmcnt(0)" ::: "memory");
#pragma unroll
    for (int j = 0; j < 4; ++j) { const int n = (lane >> 3) + 8 * j; const LAS float* s = scr + (8 * c) * 33 + n;
        v4u o; o.x = pk2(s[0 * 33] * g0.x, s[1 * 33] * g0.y); o.y = pk2(s[2 * 33] * g0.z, s[3 * 33] * g0.w); o.z = pk2(s[4 * 33] * g1.x, s[5 * 33] * g1.y); o.w = pk2(s[6 * 33] * g1.z, s[7 * 33] * g1.w);
        const int no = d.n0 + n; int dst = no;
        if (d.perm && no < 2048) { const int q = no & 63; dst = (no & ~63) + 8 * ((q & 31) >> 2) + 4 * (q >> 5) + (q & 3); }
        *(v4u*)(d.WT + (size_t)dst * d.K + ((d.k0 + d.krot) & (d.K - 1)) + 8 * c) = o; }
    asm volatile("s_waitcnt lgkmcnt(0)" ::: "memory");
}

__global__ void __launch_bounds__(NTHR, 2) fwd_megakernel(Args a) {
    extern __shared__ __attribute__((aligned(16))) unsigned char lds[];
    cg::grid_group grid = cg::this_grid();
#define GRID_SYNC() do { asm volatile("s_waitcnt vmcnt(0) lgkmcnt(0)" ::: "memory"); grid.sync(); __builtin_amdgcn_fence(__ATOMIC_ACQUIRE, "agent"); asm volatile("s_waitcnt vmcnt(0)" ::: "memory"); } while (0)
    const int tid = threadIdx.x, lane = tid & 63, wave = __builtin_amdgcn_readfirstlane(tid >> 6);
    const int G = gridDim.x, bx = blockIdx.x;
    const int gw = bx * 8 + wave, NGW = G * 8;
    unsigned char* ws = a.ws;
    bf16_t* WinT = (bf16_t*)(ws + WS_WIN); bf16_t* WoutT = (bf16_t*)(ws + WS_WOUT); bf16_t* WmiT = (bf16_t*)(ws + WS_WMI); bf16_t* WmoT = (bf16_t*)(ws + WS_WMO);
    float* X = (float*)(ws + WS_X); bf16_t* XB = (bf16_t*)(ws + WS_XB); bf16_t* PROJ = (bf16_t*)(ws + WS_PROJ); bf16_t* MIX = (bf16_t*)(ws + WS_MIX); bf16_t* U = (bf16_t*)(ws + WS_U);
    float* SS = (float*)(ws + WS_SS); float* COS = (float*)(ws + WS_COS); float* SIN = (float*)(ws + WS_SIN); float* LAM = (float*)(ws + WS_LAM); float* NASS = (float*)(ws + WS_NASS);
    LAS unsigned char* ldsl = (LAS unsigned char*)lds;
    volatile LAS unsigned* bst = (volatile LAS unsigned*)(ldsl + 135168);
    if (tid < 2) bst[tid] = 0u;
    __syncthreads();
    const XcdBarrier xbar = xcd_barrier_post((unsigned*)(ws + WS_BAR), bst);

    for (int rep = 0; rep < REP_P0; ++rep) {
        LAS float* scr = (LAS float*)(ldsl + wave * 16384);
        constexpr int I_IN = (DM / 64) * (INC / 32), I_OUT = (DM / 64) * (DM / 32), I_MI = (DM / 64) * (FF / 32), I_MO = (FF / 64) * (DM / 32), I_L = I_IN + I_OUT + I_MI + I_MO;
        auto mk = [&](int it) {
            TpItem d; const int l = it / I_L; int r = it % I_L; d.gv = nullptr; d.perm = false; d.krot = 0;
            if (r < I_IN) { d.W = a.in[2] + (size_t)l * DM * INC; d.K = DM; d.N = INC; d.WT = WinT + (size_t)l * INC * DM; d.gv = a.in[1] + l * DM; d.perm = true; }
            else if ((r -= I_IN) < I_OUT) {
                d.W = a.in[10] + (size_t)l * DM * DM; d.K = DM; d.N = DM; d.WT = WoutT + (size_t)l * DM * DM; d.krot = 1024; if (r / (DM / 32) >= 16) d.gv = a.in[8] + l * 1024 - 1024; }
            else if ((r -= I_OUT) < I_MI) { d.W = a.in[12] + (size_t)l * DM * FF; d.K = DM; d.N = FF; d.WT = WmiT + (size_t)l * FF * DM; d.gv = a.in[11] + l * DM; }
            else { r -= I_MI; d.W = a.in[13] + (size_t)l * FF * DM; d.K = FF; d.N = DM; d.WT = WmoT + (size_t)l * DM * FF; }
            const int nblk = d.N / 32; d.k0 = 64 * (r / nblk); d.n0 = 32 * (r % nblk);
            return d; };
        {
            constexpr int NIT = DEPTH * I_L; float wa[32], wb[32]; int it = gw;
            TpItem da = mk(it < NIT ? it : 0), db = da;
            if (it < NIT) tp_load(da, lane, wa);
            while (it < NIT) {
                const int itb = it + NGW; if (itb < NIT) { db = mk(itb); tp_load(db, lane, wb); }
                tp_store(da, lane, wa, scr);
                if (itb >= NIT) break;
                const int ita = itb + NGW; if (ita < NIT) { da = mk(ita); tp_load(da, lane, wa); }
                tp_store(db, lane, wb, scr);
                it = ita;
            }
        }
        for (int m = gw; m < SEQ; m += NGW) {
            const v4f* xr = (const v4f*)(a.in[0] + (size_t)m * DM) + lane; v2u* bo = (v2u*)(XB + (size_t)m * DM) + lane;
            float s = 0.f;
#pragma unroll
            for (int j = 0; j < 8; ++j) { const v4f v = xr[64 * j]; v2u w; w.x = pk2(v.x, v.y); w.y = pk2(v.z, v.w); bo[64 * j] = w; s += (v.x * v.x + v.y * v.y) + (v.z * v.z + v.w * v.w); }
            s = wave_sum(s);
            if (lane < 32) SS[(size_t)m * 32 + lane] = lane == 0 ? s : 0.f;
        }
        for (int i = bx * NTHR + tid; i < SEQ * 32; i += G * NTHR) {
            const int t = i >> 5, j = i & 31; double rev = (double)t * a.invf[j] * 0.15915494309189535; rev -= floor(rev);
            const float rf = (float)rev; COS[i] = __builtin_amdgcn_cosf(rf); SIN[i] = __builtin_amdgcn_sinf(rf);
        }
        if (bx == 0 && wave < DEPTH) {
            const int l = wave;
            const float p1 = wave_sum(a.in[3][l * 64 + lane] * a.in[4][l * 64 + lane]), p2 = wave_sum(a.in[5][l * 64 + lane] * a.in[6][l * 64 + lane]);
            if (lane == 0) LAM[l] = expf(p1) - expf(p2) + a.lam_init[l];
        }
    }
    if (a.ws == nullptr) GRID_SYNC();
    xcd_barrier(xbar);

#pragma unroll 1
    for (int l = 0; l < DEPTH; ++l) {
        unsigned char* wsl = a.ws; asm volatile("" : "+s"(wsl));
        bf16_t* WinT = (bf16_t*)(wsl + WS_WIN); bf16_t* WoutT = (bf16_t*)(wsl + WS_WOUT); bf16_t* WmiT = (bf16_t*)(wsl + WS_WMI); bf16_t* WmoT = (bf16_t*)(wsl + WS_WMO);
        float* X = (float*)(wsl + WS_X); bf16_t* XB = (bf16_t*)(wsl + WS_XB); bf16_t* PROJ = (bf16_t*)(wsl + WS_PROJ); bf16_t* MIX = (bf16_t*)(wsl + WS_MIX); bf16_t* U = (bf16_t*)(wsl + WS_U);
        float* SS = (float*)(wsl + WS_SS); float* COS = (float*)(wsl + WS_COS); float* SIN = (float*)(wsl + WS_SIN); float* LAM = (float*)(wsl + WS_LAM); float* NASS = (float*)(wsl + WS_NASS);
        const float* ss1 = SS + (size_t)(2 * l) * SEQ * 32; float* ss2 = SS + (size_t)(2 * l + 1) * SEQ * 32; float* ss3 = SS + (size_t)(2 * l + 2) * SEQ * 32;
        for (int rep = 0; rep < REP_P1; ++rep) {
            pg8::Gemm g{XB, WinT + (size_t)l * INC * DM, SEQ, INC, DM}; pg8::StaticOrder S; S.init(SEQ, INC, G, bx);
            pg8::EpiProj E{PROJ, ss1, COS, SIN};
            pg8::gemm_phase<pg8::EpiProj, pg8::StaticOrder, true, true>(ldsl, g, S, E);
        }
        xcd_barrier(xbar);
        {
            for (int rep = 0; rep < REP_P2; ++rep)
            for (int u = bx; u < 8 * 32; u += G) { const int h = u >> 5, rb = u & 31;
                att::na_unit(PROJ, MIX, NASS, h, rb, a.in[9] + ((size_t)l * 8 + h) * 15 * 31, (char*)lds); }
            const float lam = LAM[l], oml = 1.0f - a.lam_init[l];
            for (int rep = 0; rep < REP_P3; ++rep)
            for (int u = bx; u < 8 * 64; u += G) { const int h = u & 7, qb = u >> 3;
                att::diff_unit(PROJ, MIX, h, qb * 128, lam, oml, a.in[7] + l * 128, (char*)lds); }
        }
        xcd_barrier(xbar);
        for (int rep = 0; rep < REP_P4; ++rep) {
            pg8::Gemm g{MIX, WoutT + (size_t)l * DM * DM, SEQ, DM, DM}; pg8::StaticOrder S; S.init(SEQ, DM, G, bx);
            pg8::EpiResidMid E{(l == 0 && rep == 0) ? a.in[0] : (const float*)X, X, XB, ss2, (rep & 1) ? -1.f : 1.f, NASS};
            pg8::gemm_phase<pg8::EpiResidMid, pg8::StaticOrder, true, true>(ldsl, g, S, E);
        }
        xcd_barrier(xbar);
        for (int rep = 0; rep < REP_P5; ++rep) {
            pg8::Gemm g{XB, WmiT + (size_t)l * FF * DM, SEQ, FF, DM}; pg8::StaticOrder S; S.init(SEQ, FF, G, bx);
            pg8::EpiRelu2 E{U, ss2};
            pg8::gemm_phase<pg8::EpiRelu2, pg8::StaticOrder, true, true>(ldsl, g, S, E);
        }
        xcd_barrier(xbar);
        for (int rep = 0; rep < REP_P6; ++rep) {
            pg8::Gemm g{U, WmoT + (size_t)l * DM * FF, SEQ, DM, FF}; pg8::StaticOrder S; S.init(SEQ, DM, G, bx);
            pg8::EpiResid E{X, X, XB, ss3, (rep & 1) ? -1.f : 1.f, nullptr};
            pg8::gemm_phase<pg8::EpiResid, pg8::StaticOrder, true, true>(ldsl, g, S, E);
        }
        xcd_barrier(xbar);
    }
    {
        const float* fg = a.in[14]; const float* ssf = SS + (size_t)8 * SEQ * 32;
        int lnf = threadIdx.x; asm volatile("" : "+v"(lnf)); lnf &= 63;
        for (int m = gw; m < SEQ; m += NGW) {
            const float rn = rsqrtf(wave_sum(lnf < 32 ? ssf[(size_t)m * 32 + lnf] : 0.f) * (1.0f / 2048.0f) + 1e-6f);
            const v4f* xr = (const v4f*)(X + (size_t)m * DM) + lnf; v4f* xo = (v4f*)(a.out + (size_t)m * DM) + lnf; const v4f* gp = (const v4f*)fg + lnf;
#pragma unroll
            for (int j = 0; j < 8; ++j) xo[64 * j] = xr[64 * j] * rn * gp[64 * j];
        }
    }
}

extern "C" void kernel_launch(void* const* d_in, const int* in_sizes, int n_in, void* d_out, int out_size, void* d_ws, size_t ws_size, hipStream_t stream) {
    static int grid_blocks = 0;
    if (grid_blocks == 0) {
        if (n_in != 15 || out_size != SEQ * DM || ws_size < WS_END) { fprintf(stderr, "kernel_launch: unexpected shapes (n_in %d out %d ws %zu, need %zu)\n", n_in, out_size, ws_size, (size_t)WS_END); grid_blocks = -1; return; }
        int dev = 0, cus = 0, per_cu = 0;
        hipGetDevice(&dev); hipDeviceGetAttribute(&cus, hipDeviceAttributeMultiprocessorCount, dev);
        if (hipFuncSetAttribute((const void*)fwd_megakernel, hipFuncAttributeMaxDynamicSharedMemorySize, LDS_BYTES) != hipSuccess) { fprintf(stderr, "kernel_launch: hipFuncSetAttribute failed\n"); grid_blocks = -1; return; }
        if (hipOccupancyMaxActiveBlocksPerMultiprocessor(&per_cu, (const void*)fwd_megakernel, NTHR, LDS_BYTES) != hipSuccess || per_cu < 1) { fprintf(stderr, "kernel_launch: occupancy query gave %d\n", per_cu); per_cu = 1; (void)hipGetLastError(); }
        grid_blocks = cus * per_cu;
    }
    if (grid_blocks < 0) return;
    Args a{};
    for (int i = 0; i < 15; ++i) a.in[i] = (const float*)d_in[i];
    a.out = (float*)d_out; a.ws = (unsigned char*)d_ws;
    for (int j = 0; j < 32; ++j) a.invf[j] = 1.0 / pow(10000.0, (double)(2 * j) / 64.0);
    for (int l = 0; l < 4; ++l) a.lam_init[l] = (float)(0.8 - 0.6 * exp(-0.3 * l));
    if (hipMemsetAsync((char*)d_ws + WS_BAR, 0, XCD_BAR_WORDS * 4, stream) != hipSuccess) { fprintf(stderr, "kernel_launch: hipMemsetAsync of the barrier words failed\n"); return; }
    void* args[] = {&a};
    hipError_t e = hipLaunchCooperativeKernel((void*)fwd_megakernel, dim3(grid_blocks), dim3(NTHR), args, LDS_BYTES, stream);
    if (e != hipSuccess) fprintf(stderr, "cooperative launch failed: %s (grid %d)\n", hipGetErrorString(e), grid_blocks);
}
```

```cpp
#include <hip/hip_runtime.h>
#include <hip/hip_cooperative_groups.h>
#include <cstdio>
#include <cstdint>
namespace cg = cooperative_groups;
namespace pg8 {
#define PG8_LAS __attribute__((address_space(3)))
typedef unsigned short bf16_t;
typedef short bf16x8 __attribute__((ext_vector_type(8)));
typedef float f32x4 __attribute__((ext_vector_type(4)));
typedef unsigned u32x4 __attribute__((ext_vector_type(4)));
constexpr int BM = 256, BK = 64, HALF = 128, HTB = HALF * BK * 2  , STAGE_BYTES = 8 * HTB, NXCD = 8, WGM = 8;

__host__ __device__ __forceinline__ int lds_byte(int r, int c) { const int st = (r >> 4) * 2 + (c >> 5), rr = r & 15, cc = c & 31, ob = rr * 64 + cc * 2; return st * 1024 + (ob ^ (((ob >> 9) & 1) << 5)); }
__host__ __device__ __forceinline__ void stage_rc(int b, int& R, int& C) { const int st = b / 1024, sb = b % 1024, swz = sb ^ (((sb >> 9) & 1) << 5); R = (st >> 1) * 16 + swz / 64; C = (st & 1) * 32 + (swz % 64) / 2; }
__host__ __device__ __forceinline__ int perm32(int rho) { const int n = rho >> 4, i = rho & 15; return 8 * (i >> 2) + 4 * n + (i & 3); }

struct Unit { int pm, pn; };
struct Gemm { const bf16_t* A; const bf16_t* Bt; int M, N, K; };

struct StaticOrder {
    int nM, nN, nwg, G, c;
    __host__ __device__ void init(int M, int N, int G_, int c_) { nM = M / BM; nN = N / BM; nwg = nM * nN; G = G_; c = c_; }
    __host__ __device__ bool next(int i, Unit& u) const {
        const long L = (long)i * G + c; if (L >= nwg) return false;
        int wgid = (int)L; { const int q = nwg / NXCD, r = nwg % NXCD, xcd = wgid % NXCD, off = wgid / NXCD; wgid = (xcd < r ? xcd * (q + 1) : r * (q + 1) + (xcd - r) * q) + off; }
        const int nig = WGM * nN, gid = wgid / nig, fm = gid * WGM, gsz = (nM - fm) < WGM ? (nM - fm) : WGM;
        u.pm = fm + ((wgid % nig) % gsz); u.pn = (wgid % nig) / gsz; return true;
    }
    __device__ __forceinline__ void a_ready(const Unit&) const {}
    __device__ __forceinline__ void done(const Unit&) const {}
};

__device__ __forceinline__ unsigned cvt_pk_bf16(float lo, float hi) { unsigned r; asm volatile("v_cvt_pk_bf16_f32 %0, %1, %2" : "=v"(r) : "v"(lo), "v"(hi)); return r; }
typedef float f32x2 __attribute__((ext_vector_type(2)));
typedef unsigned u32x2 __attribute__((ext_vector_type(2)));
constexpr float RMS_EPS = 1e-6f;
__device__ __forceinline__ float row_rstd(const float* ss, int row, int fq) {
    const f32x4* sp = (const f32x4*)(ss + (size_t)row * 32 + fq * 8); const f32x4 a = sp[0], b = sp[1];
    float s = ((a[0] + a[1]) + (a[2] + a[3])) + ((b[0] + b[1]) + (b[2] + b[3]));
    s += __shfl_xor(s, 16); s += __shfl_xor(s, 32);
    return rsqrtf(s * (1.0f / 2048.0f) + RMS_EPS);
}
struct EpiProj {
    static constexpr bool PERM = true, AFTER_DRAIN = false, MIDK = false;
    bf16_t* O; const float* ss; const float* cosT; const float* sinT;
    __device__ __forceinline__ void operator()(const f32x4 (&acc)[2][2][4][2], const Unit& u, int wr, int wc, int fr, int fq) const {
        const int row0 = u.pm * BM + wr * 64 + fr; const int colt = u.pn * BM;
        const bool rope = colt < 2048;
        const float qs = colt < 1024 ? 0.125f * 1.4426950408889634f : 1.f;
        const int g = (wc & 1) * 4 + fq;
        const int pos0 = colt + wc * 32 + 8 * fq;
        const int rbase = colt + 64 * (wc >> 1) + 4 * g;
#pragma unroll
        for (int ai = 0; ai < 2; ++ai)
#pragma unroll
            for (int m = 0; m < 4; ++m) {
                const int row = row0 + ai * HALF + m * 16;
                const float rs = row_rstd(ss, row, fq) * qs;
                bf16_t* rowp = O + (size_t)row * 6144;
                if (rope) {
                    const f32x4 c4 = *(const f32x4*)(cosT + row * 32 + 4 * g), s4 = *(const f32x4*)(sinT + row * 32 + 4 * g);
#pragma unroll
                    for (int bj = 0; bj < 2; ++bj) {
                        const f32x4 v0 = acc[ai][bj][m][0] * rs, v1 = acc[ai][bj][m][1] * rs;
                        const f32x4 o1 = v0 * c4 - v1 * s4, o2 = v1 * c4 + v0 * s4;
                        u32x2 w1, w2; w1.x = cvt_pk_bf16(o1[0], o1[1]); w1.y = cvt_pk_bf16(o1[2], o1[3]); w2.x = cvt_pk_bf16(o2[0], o2[1]); w2.y = cvt_pk_bf16(o2[2], o2[3]);
                        *(u32x2*)(rowp + rbase + bj * HALF) = w1; *(u32x2*)(rowp + rbase + bj * HALF + 32) = w2;
                    }
                } else {
#pragma unroll
                    for (int bj = 0; bj < 2; ++bj) {
                        const f32x4 v0 = acc[ai][bj][m][0] * rs, v1 = acc[ai][bj][m][1] * rs;
                        u32x4 w; w.x = cvt_pk_bf16(v0[0], v0[1]); w.y = cvt_pk_bf16(v0[2], v0[3]); w.z = cvt_pk_bf16(v1[0], v1[1]); w.w = cvt_pk_bf16(v1[2], v1[3]);
                        *(u32x4*)(rowp + pos0 + bj * HALF) = w;
                    }
                }
            }
    }
};
struct EpiRelu2 {
    static constexpr bool PERM = true, AFTER_DRAIN = false, MIDK = false;
    bf16_t* O; const float* ss;
    __device__ __forceinline__ void operator()(const f32x4 (&acc)[2][2][4][2], const Unit& u, int wr, int wc, int fr, int fq) const {
        const int row0 = u.pm * BM + wr * 64 + fr; const int pos0 = u.pn * BM + wc * 32 + 8 * fq;
#pragma unroll
        for (int ai = 0; ai < 2; ++ai)
#pragma unroll
            for (int m = 0; m < 4; ++m) {
                const int row = row0 + ai * HALF + m * 16;
                const float rs = row_rstd(ss, row, fq);
                bf16_t* rowp = O + (size_t)row * 8192 + pos0;
#pragma unroll
                for (int bj = 0; bj < 2; ++bj) {
                    f32x4 v0 = acc[ai][bj][m][0] * rs, v1 = acc[ai][bj][m][1] * rs;
#pragma unroll
                    for (int e = 0; e < 4; ++e) { v0[e] = fmaxf(v0[e], 0.f); v1[e] = fmaxf(v1[e], 0.f); }
                    v0 = v0 * v0; v1 = v1 * v1;
                    u32x4 w; w.x = cvt_pk_bf16(v0[0], v0[1]); w.y = cvt_pk_bf16(v0[2], v0[3]); w.z = cvt_pk_bf16(v1[0], v1[1]); w.w = cvt_pk_bf16(v1[2], v1[3]);
                    *(u32x4*)(rowp + bj * HALF) = w;
                }
            }
    }
};
template <bool MID> struct EpiResidT {
    static constexpr bool PERM = false, AFTER_DRAIN = false, MIDK = MID;
    const float* Xin; float* X; bf16_t* XB; float* ssout; float sign; const float* nass;
    __device__ __forceinline__ void mid(f32x4 (&acc)[2][2][4][2], const Unit& u, int wr, int wc, int fr, int fq) const {
        int t_ = threadIdx.x; asm volatile("" : "+v"(t_));
        const int row0 = u.pm * BM + wr * 64 + (t_ & 15);
#pragma unroll
        for (int ai = 0; ai < 2; ++ai)
#pragma unroll
            for (int m = 0; m < 4; ++m) {
                const f32x4* sp = (const f32x4*)(nass + (size_t)(row0 + ai * HALF + m * 16) * 8); const f32x4 a = sp[0], b = sp[1];
                const float rn = rsqrtf((((a[0] + a[1]) + (a[2] + a[3])) + ((b[0] + b[1]) + (b[2] + b[3]))) * (1.0f / 1024.0f) + RMS_EPS);
#pragma unroll
                for (int bj = 0; bj < 2; ++bj)
#pragma unroll
                    for (int n = 0; n < 2; ++n) acc[ai][bj][m][n] = acc[ai][bj][m][n] * rn;
            }
    }
    __device__ __forceinline__ void operator()(const f32x4 (&acc)[2][2][4][2], const Unit& u, int wr, int wc, int fr, int fq) const {
        const int row0 = u.pm * BM + wr * 64 + fr; const int col0 = u.pn * BM + wc * 32 + 4 * fq;
#pragma unroll
        for (int ai = 0; ai < 2; ++ai)
#pragma unroll
            for (int m = 0; m < 4; ++m) {
                const int row = row0 + ai * HALF + m * 16; float sq = 0.f;
#pragma unroll
                for (int bj = 0; bj < 2; ++bj)
#pragma unroll
                    for (int n = 0; n < 2; ++n) {
                        const size_t off = (size_t)row * 2048 + col0 + bj * HALF + n * 16;
                        const f32x4 xv = *(const f32x4*)(Xin + off) + acc[ai][bj][m][n] * sign;
                        *(f32x4*)(X + off) = xv;
                        u32x2 w; w.x = cvt_pk_bf16(xv[0], xv[1]); w.y = cvt_pk_bf16(xv[2], xv[3]);
                        *(u32x2*)(XB + off) = w;
                        sq += (xv[0] * xv[0] + xv[1] * xv[1]) + (xv[2] * xv[2] + xv[3] * xv[3]);
                    }
                sq += __shfl_xor(sq, 16); sq += __shfl_xor(sq, 32);
                if (fq == 0) ssout[(size_t)row * 32 + u.pn * 4 + wc] = sq;
            }
    }
};
typedef EpiResidT<false> EpiResid; typedef EpiResidT<true> EpiResidMid;
template <class Epi, class Sched, bool ALIGN_EPI = false, bool SP2 = false>
__device__ __forceinline__ void gemm_phase(PG8_LAS unsigned char* lds, const Gemm g, const Sched& S, const Epi& E) {
    int tid_ = threadIdx.x; asm volatile("" : "+v"(tid_));
    const int tid = tid_, wid = __builtin_amdgcn_readfirstlane(tid >> 6), lane = tid & 63, wr = wid >> 2, wc = wid & 3, fr = lane & 15, fq = lane >> 4;
    const int K = g.K, nt = K / BK;
    unsigned voffA[2], voffB[2];
#pragma unroll
    for (int i = 0; i < 2; ++i) { int R, C; stage_rc(tid * 16 + i * 8192, R, C); const int Rb = Epi::PERM ? ((R & ~31) + perm32(R & 31)) : R;
        voffA[i] = (unsigned)(R * K + C) * 2u; voffB[i] = (unsigned)(Rb * K + C) * 2u; }
    const size_t kstep = (size_t)(BK * 2);
    const size_t hstep = (size_t)HALF * K * 2;
    const size_t tstep = 2 * hstep;
    const unsigned ldsw = (unsigned)wid * 1024u;
    const int aoff = lds_byte(wr * 64 + fr, fq * 8), boff = lds_byte(wc * 32 + fr, fq * 8);
#define PG8_SA(b, h) (((b) * 2 + (h)) * HTB)
#define PG8_SB(b, h) ((4 + (b) * 2 + (h)) * HTB)
#define PG8_STAGE(bufoff, gbase, voff) do { _Pragma("unroll") for (int _i = 0; _i < 2; ++_i) \
        __builtin_amdgcn_global_load_lds((const unsigned*)((const char*)(gbase) + (voff)[_i]), (PG8_LAS unsigned*)(lds + (bufoff) + ldsw + _i * 8192), 16, 0, 0); } while (0)
#define PG8_LDA(dst, b, h) do { _Pragma("unroll") for (int m = 0; m < 4; ++m) _Pragma("unroll") for (int k = 0; k < 2; ++k) dst[m][k] = *(const PG8_LAS bf16x8*)(lds + PG8_SA(b, h) + aoff + m * 2048 + k * 1024); } while (0)
#define PG8_LDB(dst, b, h) do { _Pragma("unroll") for (int n = 0; n < 2; ++n) _Pragma("unroll") for (int k = 0; k < 2; ++k) dst[n][k] = *(const PG8_LAS bf16x8*)(lds + PG8_SB(b, h) + boff + n * 2048 + k * 1024); } while (0)
#define PG8_MMA(ai, bj, At, Bt) do { __builtin_amdgcn_s_setprio(1); _Pragma("unroll") for (int m = 0; m < 4; ++m) _Pragma("unroll") for (int n = 0; n < 2; ++n) _Pragma("unroll") for (int k = 0; k < 2; ++k) \
        acc[ai][bj][m][n] = __builtin_amdgcn_mfma_f32_16x16x32_bf16(Bt[n][k], At[m][k], acc[ai][bj][m][n], 0, 0, 0); __builtin_amdgcn_s_setprio(0); } while (0)
#define PG8_WAIT_V(n) asm volatile("s_waitcnt vmcnt(" #n ")" ::: "memory")
#define PG8_WAIT_L(n) asm volatile("s_waitcnt lgkmcnt(" #n ")" ::: "memory")
#define PG8_BAR __builtin_amdgcn_s_barrier()
#define PG8_SCHED __builtin_amdgcn_sched_barrier(0)
    Unit cur, nxt; int ui = 0;
    if (!S.next(0, cur)) return;
    f32x4 acc[2][2][4][2];
#pragma unroll
    for (int a = 0; a < 2; ++a)
#pragma unroll
        for (int b = 0; b < 2; ++b)
#pragma unroll
            for (int m = 0; m < 4; ++m)
#pragma unroll
                for (int n = 0; n < 2; ++n) acc[a][b][m][n] = (f32x4){0.f, 0.f, 0.f, 0.f};
    bf16x8 At[4][2], B0[2][2], B1[2][2];
    const char* cA = (const char*)g.A + (size_t)cur.pm * tstep; const char* cB = (const char*)g.Bt + (size_t)cur.pn * tstep;
    S.a_ready(cur);
    if constexpr (SP2) {
        PG8_STAGE(PG8_SB(0, 0), cB, voffB); PG8_STAGE(PG8_SB(0, 1), cB + hstep, voffB); PG8_STAGE(PG8_SA(0, 0), cA, voffA); PG8_STAGE(PG8_SA(0, 1), cA + hstep, voffA);
        if (wr == 1) PG8_BAR;
        PG8_WAIT_V(2); PG8_BAR;
        PG8_STAGE(PG8_SB(1, 0), cB + kstep, voffB); PG8_STAGE(PG8_SA(1, 0), cA + kstep, voffA); PG8_STAGE(PG8_SB(1, 1), cB + hstep + kstep, voffB);
        PG8_WAIT_V(6); PG8_BAR;
    } else {
        PG8_STAGE(PG8_SB(0, 0), cB, voffB); PG8_STAGE(PG8_SA(0, 0), cA, voffA); PG8_STAGE(PG8_SB(0, 1), cB + hstep, voffB); PG8_STAGE(PG8_SA(0, 1), cA + hstep, voffA);
        if (wr == 1) PG8_BAR;
        PG8_WAIT_V(4); PG8_BAR;
        PG8_STAGE(PG8_SB(1, 0), cB + kstep, voffB); PG8_STAGE(PG8_SA(1, 0), cA + kstep, voffA); PG8_STAGE(PG8_SB(1, 1), cB + hstep + kstep, voffB);
        PG8_WAIT_V(6); PG8_BAR;
    }
    for (;;) {
        const bool has_next = S.next(ui + 1, nxt);
        const char* nA = has_next ? (const char*)g.A + (size_t)nxt.pm * tstep : cA; const char* nB = has_next ? (const char*)g.Bt + (size_t)nxt.pn * tstep : cB;
        for (int t = 0; t < nt; t += 2) {
            if constexpr (Epi::MIDK) { if (t == nt / 2) E.mid(acc, cur, wr, wc, fr, fq); }
            const bool last = (t == nt - 2);
            const char* a1 = cA + (size_t)(t + 1) * kstep;
            const char* a2 = last ? nA : cA + (size_t)(t + 2) * kstep; const char* b2 = last ? nB : cB + (size_t)(t + 2) * kstep;
            const char* a3 = a2 + kstep; const char* b3 = b2 + kstep;
            if (last && has_next) S.a_ready(nxt);
            if constexpr (SP2) {
            PG8_LDB(B0, 0, 0); PG8_LDB(B1, 0, 1); PG8_SCHED; PG8_LDA(At, 0, 0); PG8_STAGE(PG8_SA(1, 1), a1 + hstep, voffA);
            PG8_WAIT_V(8); PG8_WAIT_L(0); PG8_BAR; PG8_MMA(0, 0, At, B0); PG8_MMA(0, 1, At, B1); PG8_BAR; PG8_SCHED;
            PG8_LDA(At, 0, 1); PG8_STAGE(PG8_SB(0, 0), b2, voffB); PG8_STAGE(PG8_SB(0, 1), b2 + hstep, voffB); PG8_STAGE(PG8_SA(0, 0), a2, voffA);
            PG8_WAIT_V(8); PG8_WAIT_L(0); PG8_BAR; PG8_MMA(1, 0, At, B0); PG8_MMA(1, 1, At, B1); PG8_BAR; PG8_SCHED;
            PG8_LDB(B0, 1, 0); PG8_LDB(B1, 1, 1); PG8_SCHED; PG8_LDA(At, 1, 0); PG8_STAGE(PG8_SA(0, 1), a2 + hstep, voffA);
            PG8_WAIT_V(8); PG8_WAIT_L(0); PG8_BAR; PG8_MMA(0, 0, At, B0); PG8_MMA(0, 1, At, B1); PG8_BAR; PG8_SCHED;
            PG8_LDA(At, 1, 1); PG8_STAGE(PG8_SB(1, 0), b3, voffB); PG8_STAGE(PG8_SB(1, 1), b3 + hstep, voffB); PG8_STAGE(PG8_SA(1, 0), a3, voffA);
            PG8_WAIT_V(8); PG8_WAIT_L(0); PG8_BAR; PG8_MMA(1, 0, At, B0); PG8_MMA(1, 1, At, B1); PG8_BAR; PG8_SCHED;
            } else {
            PG8_LDB(B0, 0, 0); PG8_SCHED; PG8_LDA(At, 0, 0); PG8_STAGE(PG8_SA(1, 1), a1 + hstep, voffA);
            PG8_WAIT_L(8); PG8_BAR; PG8_WAIT_L(0); PG8_MMA(0, 0, At, B0); PG8_BAR; PG8_SCHED;
            PG8_LDB(B1, 0, 1); PG8_STAGE(PG8_SB(0, 0), b2, voffB);
            PG8_BAR; PG8_WAIT_L(0); PG8_MMA(0, 1, At, B1); PG8_BAR;
            PG8_LDA(At, 0, 1); PG8_STAGE(PG8_SA(0, 0), a2, voffA);
            PG8_BAR; PG8_WAIT_L(0); PG8_MMA(1, 0, At, B0); PG8_BAR; PG8_SCHED;
            PG8_STAGE(PG8_SB(0, 1), b2 + hstep, voffB);
            PG8_WAIT_V(6); PG8_BAR; PG8_MMA(1, 1, At, B1); PG8_BAR;
            PG8_LDB(B0, 1, 0); PG8_SCHED; PG8_LDA(At, 1, 0); PG8_STAGE(PG8_SA(0, 1), a2 + hstep, voffA);
            PG8_WAIT_L(8); PG8_BAR; PG8_WAIT_L(0); PG8_MMA(0, 0, At, B0); PG8_BAR; PG8_SCHED;
            PG8_LDB(B1, 1, 1); PG8_STAGE(PG8_SB(1, 0), b3, voffB);
            PG8_BAR; PG8_WAIT_L(0); PG8_MMA(0, 1, At, B1); PG8_BAR;
            PG8_LDA(At, 1, 1); PG8_STAGE(PG8_SA(1, 0), a3, voffA);
            PG8_BAR; PG8_WAIT_L(0); PG8_MMA(1, 0, At, B0); PG8_BAR; PG8_SCHED;
            PG8_STAGE(PG8_SB(1, 1), b3 + hstep, voffB);
            PG8_WAIT_V(6); PG8_BAR; PG8_MMA(1, 1, At, B1); PG8_BAR;
            }
        }
        if constexpr (ALIGN_EPI) { if (wr == 0) PG8_BAR; }
        if constexpr (!Epi::AFTER_DRAIN) { E(acc, cur, wr, wc, fr, fq); S.done(cur); }
        if (!has_next) break;
#pragma unroll
        for (int a = 0; a < 2; ++a)
#pragma unroll
            for (int b = 0; b < 2; ++b)
#pragma unroll
                for (int m = 0; m < 4; ++m)
#pragma unroll
                    for (int n = 0; n < 2; ++n) acc[a][b][m][n] = (f32x4){0.f, 0.f, 0.f, 0.f};
        cur = nxt; cA = nA; cB = nB; ++ui;
        if constexpr (ALIGN_EPI) { if (wr == 1) PG8_BAR; }
    }
    PG8_WAIT_V(0);
    if constexpr (!ALIGN_EPI) { if (wr == 0) PG8_BAR; }
    PG8_BAR;
    if constexpr (Epi::AFTER_DRAIN) { E.fused(acc, cur, wr, wc, fr, fq, lds, wid, lane); S.done(cur); }
#undef PG8_SA
#undef PG8_SB
#undef PG8_STAGE
#undef PG8_LDA
#undef PG8_LDB
#undef PG8_MMA
#undef PG8_WAIT_V
#undef PG8_WAIT_L
#undef PG8_BAR
#undef PG8_SCHED
}
}
namespace att {
typedef unsigned short bf16;
using bf16x8 = __attribute__((ext_vector_type(8))) short;
using s16x4  = __attribute__((ext_vector_type(4))) short;
using f32x16 = __attribute__((ext_vector_type(16))) float;
using u32x4  = __attribute__((ext_vector_type(4))) unsigned;
constexpr int LDP = 6144;
constexpr int SHM_V = 64 * 128 * 2, SHM_K = 64 * 128 * 2;
constexpr int OFF_WS = 2 * SHM_V + 2 * SHM_K, OFF_RPB = OFF_WS + 8 * 64 * 4, ATT_LDS = OFF_RPB + 2048;
constexpr float THR = 8.f;
#define KSWZ(row, colB) ((row) * 256 + ((colB) ^ (((row) & 7) << 4)))
#define SBAR() __builtin_amdgcn_sched_barrier(0)
__device__ __forceinline__ int crow(int r, int hi) { return (r & 3) + 8 * (r >> 2) + 4 * hi; }
__device__ __forceinline__ unsigned cvtpk(float lo, float hi) {
  unsigned r; asm volatile("v_cvt_pk_bf16_f32 %0, %1, %2" : "=v"(r) : "v"(lo), "v"(hi)); return r;
}
__device__ __forceinline__ bf16x8 ld8(const bf16* p) { return *reinterpret_cast<const bf16x8*>(p); }

template <int MODE> struct Cfg;
template <> struct Cfg<0> { static constexpr int ND0 = 4; static constexpr float SCALE = 0.125f; };
template <> struct Cfg<1> { static constexpr int ND0 = 8; static constexpr float SCALE = 0.088388347648318440f; };

template <int MODE>
__device__ __forceinline__ void partialSM(f32x16& p0, f32x16& p1, float& m_reg, float& mn, float& alpha) {
  constexpr float SCALE = Cfg<MODE>::SCALE;
  constexpr float C = SCALE * 1.4426950408889634f;
  float pmax = p0[0];
#pragma unroll
  for (int r = 1; r < 16; ++r) pmax = fmaxf(pmax, p0[r]);
#pragma unroll
  for (int r = 0; r < 16; ++r) pmax = fmaxf(pmax, p1[r]);
  { auto rr = __builtin_amdgcn_permlane32_swap(__float_as_uint(pmax), __float_as_uint(pmax), false, false);
    pmax = fmaxf(__uint_as_float(rr[0]), __uint_as_float(rr[1])); }
  if (__builtin_expect(__all(pmax - m_reg <= THR / SCALE), 1)) { mn = m_reg; alpha = 1.f; }
  else { mn = fmaxf(m_reg, pmax); alpha = __builtin_amdgcn_exp2f((m_reg - mn) * C); m_reg = mn; }
  float mnC = -mn * C;
#pragma unroll
  for (int r = 0; r < 16; ++r) p0[r] = fmaf(p0[r], C, mnC);
#pragma unroll
  for (int r = 0; r < 16; ++r) p1[r] = fmaf(p1[r], C, mnC);
#pragma unroll
  for (int r = 0; r < 16; ++r) p0[r] = __builtin_amdgcn_exp2f(p0[r]);
}
__device__ __forceinline__ void finishSM(f32x16& p0, f32x16& p1, float alpha, float& l_reg, bf16x8& pa0, bf16x8& pa1, bf16x8& pa2, bf16x8& pa3) {
#pragma unroll
  for (int r = 0; r < 16; ++r) p1[r] = __builtin_amdgcn_exp2f(p1[r]);
  float ps = 0;
#pragma unroll
  for (int r = 0; r < 16; ++r) ps += p0[r];
#pragma unroll
  for (int r = 0; r < 16; ++r) ps += p1[r];
  { auto rr = __builtin_amdgcn_permlane32_swap(__float_as_uint(ps), __float_as_uint(ps), false, false);
    ps = __uint_as_float(rr[0]) + __uint_as_float(rr[1]); }
  l_reg = l_reg * alpha + ps;
#define PK4(P, BASE, OUT) do { u32x4 w = {cvtpk(P[BASE + 0], P[BASE + 1]), cvtpk(P[BASE + 2], P[BASE + 3]), cvtpk(P[BASE + 4], P[BASE + 5]), cvtpk(P[BASE + 6], P[BASE + 7])}; \
    OUT = *reinterpret_cast<bf16x8*>(&w); } while (0)
  PK4(p0, 0, pa0); PK4(p0, 8, pa1); PK4(p1, 0, pa2); PK4(p1, 8, pa3);
#undef PK4
}
__device__ __forceinline__ void finishSM_ns(f32x16& p0, f32x16& p1, bf16x8& pa0, bf16x8& pa1, bf16x8& pa2, bf16x8& pa3) {
#pragma unroll
  for (int r = 0; r < 16; ++r) p1[r] = __builtin_amdgcn_exp2f(p1[r]);
#define PK4(P, BASE, OUT) do { u32x4 w = {cvtpk(P[BASE + 0], P[BASE + 1]), cvtpk(P[BASE + 2], P[BASE + 3]), cvtpk(P[BASE + 4], P[BASE + 5]), cvtpk(P[BASE + 6], P[BASE + 7])}; \
    OUT = *reinterpret_cast<bf16x8*>(&w); } while (0)
  PK4(p0, 0, pa0); PK4(p0, 8, pa1); PK4(p1, 0, pa2); PK4(p1, 8, pa3);
#undef PK4
}
__device__ __forceinline__ void sm_sum(const f32x16& p0, const f32x16& p1, float& ps) {
  ps = 0;
#pragma unroll
  for (int r = 0; r < 16; ++r) ps += p0[r];
#pragma unroll
  for (int r = 0; r < 16; ++r) ps += p1[r];
}
template <int MODE>
__device__ __forceinline__ void sm_lmax(float ps, float alpha_prev, float& l_reg, const f32x16& p0, const f32x16& p1, float& m_reg, float& mn, float& alpha, float& mnC) {
  constexpr float SCALE = Cfg<MODE>::SCALE; constexpr float C = SCALE * 1.4426950408889634f;
  { auto rr = __builtin_amdgcn_permlane32_swap(__float_as_uint(ps), __float_as_uint(ps), false, false);
    ps = __uint_as_float(rr[0]) + __uint_as_float(rr[1]); }
  l_reg = l_reg * alpha_prev + ps;
  float pmax = p0[0];
#pragma unroll
  for (int r = 1; r < 16; ++r) pmax = fmaxf(pmax, p0[r]);
#pragma unroll
  for (int r = 0; r < 16; ++r) pmax = fmaxf(pmax, p1[r]);
  { auto rr = __builtin_amdgcn_permlane32_swap(__float_as_uint(pmax), __float_as_uint(pmax), false, false);
    pmax = fmaxf(__uint_as_float(rr[0]), __uint_as_float(rr[1])); }
  if (__builtin_expect(__all(pmax - m_reg <= THR / SCALE), 1)) { mn = m_reg; alpha = 1.f; }
  else { mn = fmaxf(m_reg, pmax); alpha = __builtin_amdgcn_exp2f((m_reg - mn) * C); m_reg = mn; }
  mnC = -mn * C;
}
template <int MODE>
__device__ __forceinline__ void sm_fma(f32x16& p0, f32x16& p1, float mnC) {
  constexpr float C = Cfg<MODE>::SCALE * 1.4426950408889634f;
#pragma unroll
  for (int r = 0; r < 16; ++r) p0[r] = fmaf(p0[r], C, mnC);
#pragma unroll
  for (int r = 0; r < 16; ++r) p1[r] = fmaf(p1[r], C, mnC);
}
__device__ __forceinline__ void sm_exp0(f32x16& p0) {
#pragma unroll
  for (int r = 0; r < 16; ++r) p0[r] = __builtin_amdgcn_exp2f(p0[r]);
}
template <int ND0>
__device__ __forceinline__ void qkt(f32x16& p0, f32x16& p1, const bf16* Ks, const bf16x8* qr, int r32, int hi, int kcb) {
  p0 = f32x16{}; p1 = f32x16{};
#pragma unroll
  for (int d0 = 0; d0 < ND0; ++d0) { int cb = kcb + (d0 * 16 + hi * 8) * 2;
    bf16x8 b0 = *reinterpret_cast<const bf16x8*>((const char*)Ks + KSWZ(r32, cb));
    bf16x8 b1 = *reinterpret_cast<const bf16x8*>((const char*)Ks + KSWZ(32 + r32, cb));
    p0 = __builtin_amdgcn_mfma_f32_32x32x16_bf16(b0, qr[d0], p0, 0, 0, 0);
    p1 = __builtin_amdgcn_mfma_f32_32x32x16_bf16(b1, qr[d0], p1, 0, 0, 0); }
}
constexpr float THRL = 8.f * 1.4426950408889634f;
template <int ND0>
__device__ __forceinline__ void qkt_c(f32x16& p0, f32x16& p1, const bf16* Ks, const bf16x8* qr, int r32, int hi, int kcb, const f32x16& negm) {
#pragma unroll
  for (int d0 = 0; d0 < ND0; ++d0) { int cb = kcb + (d0 * 16 + hi * 8) * 2;
    bf16x8 b0 = *reinterpret_cast<const bf16x8*>((const char*)Ks + KSWZ(r32, cb));
    bf16x8 b1 = *reinterpret_cast<const bf16x8*>((const char*)Ks + KSWZ(32 + r32, cb));
    if (d0 == 0) { p0 = __builtin_amdgcn_mfma_f32_32x32x16_bf16(b0, qr[d0], negm, 0, 0, 0); p1 = __builtin_amdgcn_mfma_f32_32x32x16_bf16(b1, qr[d0], negm, 0, 0, 0); }
    else { p0 = __builtin_amdgcn_mfma_f32_32x32x16_bf16(b0, qr[d0], p0, 0, 0, 0); p1 = __builtin_amdgcn_mfma_f32_32x32x16_bf16(b1, qr[d0], p1, 0, 0, 0); } }
}
__device__ __forceinline__ float rowmax32(const f32x16& p0, const f32x16& p1) {
  float pmax = p0[0];
#pragma unroll
  for (int r = 1; r < 16; ++r) pmax = fmaxf(pmax, p0[r]);
#pragma unroll
  for (int r = 0; r < 16; ++r) pmax = fmaxf(pmax, p1[r]);
  auto rr = __builtin_amdgcn_permlane32_swap(__float_as_uint(pmax), __float_as_uint(pmax), false, false);
  return fmaxf(__uint_as_float(rr[0]), __uint_as_float(rr[1]));
}
__device__ __forceinline__ void firstSM_l2(f32x16& p0, f32x16& p1, float& m_reg, f32x16& negm) {
  const float pmax = rowmax32(p0, p1);
  m_reg = pmax;
#pragma unroll
  for (int r = 0; r < 16; ++r) { negm[r] = -pmax; p0[r] -= pmax; p1[r] -= pmax; }
#pragma unroll
  for (int r = 0; r < 16; ++r) p0[r] = __builtin_amdgcn_exp2f(p0[r]);
}
__device__ __forceinline__ void sm_lmax_l2(float ps, float alpha_prev, float& l_reg, f32x16& p0, f32x16& p1, float& m_reg, float& alpha, f32x16& negm) {
  { auto rr = __builtin_amdgcn_permlane32_swap(__float_as_uint(ps), __float_as_uint(ps), false, false);
    ps = __uint_as_float(rr[0]) + __uint_as_float(rr[1]); }
  l_reg = l_reg * alpha_prev + ps;
  const float pmax = rowmax32(p0, p1);
  if (__builtin_expect(__all(pmax <= THRL), 1)) { alpha = 1.f; }
  else { const float dlt = fmaxf(pmax, 0.f); alpha = __builtin_amdgcn_exp2f(-dlt); m_reg += dlt;
#pragma unroll
    for (int r = 0; r < 16; ++r) { negm[r] -= dlt; p0[r] -= dlt; p1[r] -= dlt; } }
}
__device__ __forceinline__ void sm_exp_lo(f32x16& p0) {
#pragma unroll
  for (int r = 0; r < 8; ++r) p0[r] = __builtin_amdgcn_exp2f(p0[r]);
}
__device__ __forceinline__ void sm_exp_hi(f32x16& p0) {
#pragma unroll
  for (int r = 8; r < 16; ++r) p0[r] = __builtin_amdgcn_exp2f(p0[r]);
}
__device__ __forceinline__ int v_st(int k, int c) { return ((k >> 3) * 4 + (c >> 5)) * 512 + ((k & 7) * 32 + (c & 31)) * 2; }
__device__ __forceinline__ int v_rd_base(int lane) { return ((lane & 3) << 3) | (((lane >> 2) & 3) << 6) | (((lane >> 4) & 1) << 5) | (((lane >> 5) & 1) << 8); }
constexpr int v_rd_off(int d0, int ks, int half) { return d0 * 512 + ks * 4096 + half * 2048; }
template <int OFF> __device__ __forceinline__ s16x4 tr_read(int vb) {
  s16x4 r; asm volatile("ds_read_b64_tr_b16 %0, %1 offset:%2" : "=&v"(r) : "v"(vb), "i"(OFF) : "memory"); return r;
}
template <int D0> __device__ __forceinline__ void pv_one(f32x16& od, int vb, bf16x8 pa0, bf16x8 pa1, bf16x8 pa2, bf16x8 pa3) {
  const s16x4 l0 = tr_read<v_rd_off(D0, 0, 0)>(vb), h0 = tr_read<v_rd_off(D0, 0, 1)>(vb), l1 = tr_read<v_rd_off(D0, 1, 0)>(vb), h1 = tr_read<v_rd_off(D0, 1, 1)>(vb);
  const s16x4 l2 = tr_read<v_rd_off(D0, 2, 0)>(vb), h2 = tr_read<v_rd_off(D0, 2, 1)>(vb), l3 = tr_read<v_rd_off(D0, 3, 0)>(vb), h3 = tr_read<v_rd_off(D0, 3, 1)>(vb);
  asm volatile("s_waitcnt lgkmcnt(0)" ::: "memory"); SBAR();
#define PK(L, H) (bf16x8){L[0], L[1], L[2], L[3], H[0], H[1], H[2], H[3]}
  od = __builtin_amdgcn_mfma_f32_32x32x16_bf16(pa0, PK(l0, h0), od, 0, 0, 0);
  od = __builtin_amdgcn_mfma_f32_32x32x16_bf16(pa1, PK(l1, h1), od, 0, 0, 0);
  od = __builtin_amdgcn_mfma_f32_32x32x16_bf16(pa2, PK(l2, h2), od, 0, 0, 0);
  od = __builtin_amdgcn_mfma_f32_32x32x16_bf16(pa3, PK(l3, h3), od, 0, 0, 0);
#undef PK
}
__device__ __forceinline__ void pv_d0(f32x16* o, int vb, bf16x8 pa0, bf16x8 pa1, bf16x8 pa2, bf16x8 pa3) {
  pv_one<0>(o[0], vb, pa0, pa1, pa2, pa3); pv_one<1>(o[1], vb, pa0, pa1, pa2, pa3); pv_one<2>(o[2], vb, pa0, pa1, pa2, pa3); pv_one<3>(o[3], vb, pa0, pa1, pa2, pa3);
}
struct VFrag { s16x4 l0, h0, l1, h1, l2, h2, l3, h3; };
template <int D0> __device__ __forceinline__ void pv_rd(VFrag& f, int vb) {
  f.l0 = tr_read<v_rd_off(D0, 0, 0)>(vb); f.h0 = tr_read<v_rd_off(D0, 0, 1)>(vb); f.l1 = tr_read<v_rd_off(D0, 1, 0)>(vb); f.h1 = tr_read<v_rd_off(D0, 1, 1)>(vb);
  f.l2 = tr_read<v_rd_off(D0, 2, 0)>(vb); f.h2 = tr_read<v_rd_off(D0, 2, 1)>(vb); f.l3 = tr_read<v_rd_off(D0, 3, 0)>(vb); f.h3 = tr_read<v_rd_off(D0, 3, 1)>(vb);
}
__device__ __forceinline__ void pv_mm(f32x16& od, const VFrag& f, bf16x8 pa0, bf16x8 pa1, bf16x8 pa2, bf16x8 pa3) {
  asm volatile("s_waitcnt lgkmcnt(0)" ::: "memory"); SBAR();
#define PK(L, H) (bf16x8){L[0], L[1], L[2], L[3], H[0], H[1], H[2], H[3]}
  od = __builtin_amdgcn_mfma_f32_32x32x16_bf16(pa0, PK(f.l0, f.h0), od, 0, 0, 0);
  od = __builtin_amdgcn_mfma_f32_32x32x16_bf16(pa1, PK(f.l1, f.h1), od, 0, 0, 0);
  od = __builtin_amdgcn_mfma_f32_32x32x16_bf16(pa2, PK(f.l2, f.h2), od, 0, 0, 0);
  od = __builtin_amdgcn_mfma_f32_32x32x16_bf16(pa3, PK(f.l3, f.h3), od, 0, 0, 0);
#undef PK
}
__device__ __forceinline__ void na_fix(f32x16& p0, f32x16& p1, int kr, int qr_, int rs, int qc, int cs, int hi, const float* rpbS) {
  const float NEG = -__builtin_inff();
  if (kr < rs || kr >= rs + 8) {
#pragma unroll
    for (int r = 0; r < 16; ++r) { p0[r] = NEG; p1[r] = NEG; }
  } else {
    const float* brow = rpbS + (kr - qr_ + 7) * 31 + (15 - qc);
#pragma unroll
    for (int g = 0; g < 4; ++g) {
#pragma unroll
      for (int q = 0; q < 4; ++q) { const int r = 4 * g + q;
        const int k0 = crow(r, hi), k1 = 32 + k0;
        const bool v0 = (unsigned)(k0 - cs) < 16u, v1 = (unsigned)(k1 - cs) < 16u;
        const float b0 = brow[v0 ? k0 : qc], b1 = brow[v1 ? k1 : qc];
        p0[r] = (p0[r] + b0) + (v0 ? 0.f : NEG); p1[r] = (p1[r] + b1) + (v1 ? 0.f : NEG);
      }
      SBAR();
    }
  }
}

template <int MODE>
__device__ __forceinline__ void attn_core(const bf16* __restrict__ Qw, const bf16* __restrict__ Kh, const bf16* __restrict__ Vh, const int NT, char* lds, const int kcb,
                                          const int, const int, const int, const int, const int, f32x16 (&o)[4], float& l_reg) {
  constexpr int ND0 = Cfg<MODE>::ND0;
  int tid_ = threadIdx.x; asm volatile("" : "+v"(tid_));
  const int tid = tid_, wid = __builtin_amdgcn_readfirstlane(tid >> 6), lane = tid & 63, r32 = lane & 31, hi = lane >> 5, half = wid >> 2, ht = tid & 255;
  bf16* V_lds = (bf16*)lds; bf16* K_lds = (bf16*)(lds + 2 * SHM_V);
  float* ws = (float*)(lds + OFF_WS) + wid * 64; float* al_l = ws + 32;
  float m_reg = 0.f; l_reg = 0.f; f32x16 negm = f32x16{};
#pragma unroll
  for (int d = 0; d < 4; ++d) o[d] = f32x16{};
  bf16x8 qr[ND0];
#pragma unroll
  for (int d0 = 0; d0 < ND0; ++d0) qr[d0] = ld8(Qw + d0 * 16);
  const int vb0 = (int)(uintptr_t)V_lds + v_rd_base(lane);
  {
    const int sr = tid >> 4, sc = (tid & 15) * 8;
    const bf16x8 v0 = ld8(&Vh[(long)sr * LDP + sc]), v1 = ld8(&Vh[(long)(32 + sr) * LDP + sc]), k0 = ld8(&Kh[(long)sr * LDP + sc]), k1 = ld8(&Kh[(long)(32 + sr) * LDP + sc]);
    *(bf16x8*)((char*)V_lds + v_st(sr, sc)) = v0; *(bf16x8*)((char*)V_lds + v_st(32 + sr, sc)) = v1;
    *(bf16x8*)((char*)K_lds + KSWZ(sr, sc * 2)) = k0; *(bf16x8*)((char*)K_lds + KSWZ(32 + sr, sc * 2)) = k1; }
  const int hr = ht >> 4, hc = (ht & 15) * 8;
  const bf16* Sg = (half == 0 ? Kh : Vh) + (long)hr * LDP + hc;
  char* Sl = half == 0 ? (char*)K_lds : (char*)V_lds;
  int soff[4];
#pragma unroll
  for (int i = 0; i < 4; ++i) soff[i] = half == 0 ? KSWZ(hr + 16 * i, hc * 2) : v_st(hr + 16 * i, hc);
  bf16x8 st[4];
#define HLOAD(t) do { _Pragma("unroll") for (int i = 0; i < 4; ++i) st[i] = ld8(Sg + (long)((t) * 64 + 16 * i) * LDP); } while (0)
#define HWRITE(b) do { _Pragma("unroll") for (int i = 0; i < 4; ++i) *(bf16x8*)(Sl + (b) * SHM_V + soff[i]) = st[i]; } while (0)
#define BAR_P() do { asm volatile("" : "+v"(p0), "+v"(p1)); SBAR(); asm volatile("s_waitcnt lgkmcnt(0)\n\ts_barrier" ::: "memory"); SBAR(); } while (0)
#define BAR_A() do { asm volatile("" : "+v"(pa0), "+v"(pa1), "+v"(pa2), "+v"(pa3)); SBAR(); asm volatile("s_waitcnt lgkmcnt(0)\n\ts_barrier" ::: "memory"); SBAR(); } while (0)
  f32x16 p0 = f32x16{}, p1 = f32x16{}; bf16x8 pa0, pa1, pa2, pa3; float alpha;
#define VSEG(FIRST) do { alpha = 1.f; const float pmax_ = rowmax32(p0, p1); \
    if (FIRST) { m_reg = pmax_; _Pragma("unroll") for (int r = 0; r < 16; ++r) { negm[r] = -pmax_; p0[r] -= pmax_; p1[r] -= pmax_; } } \
    else if (!__builtin_expect(__all(pmax_ <= THRL), 1)) { const float dlt_ = fmaxf(pmax_, 0.f); alpha = __builtin_amdgcn_exp2f(-dlt_); m_reg += dlt_; \
      _Pragma("unroll") for (int r = 0; r < 16; ++r) { negm[r] -= dlt_; p0[r] -= dlt_; p1[r] -= dlt_; } \
      if (hi == 0) al_l[r32] = alpha; asm volatile("s_waitcnt lgkmcnt(0)" ::: "memory"); \
      _Pragma("unroll") for (int d = 0; d < 4; ++d) _Pragma("unroll") for (int r = 0; r < 16; ++r) o[d][r] *= al_l[crow(r, hi)]; } \
    sm_exp0(p0); finishSM(p0, p1, alpha, l_reg, pa0, pa1, pa2, pa3); } while (0)
  __syncthreads();
  HLOAD(1);
  if (half == 1) BAR_P();
  qkt<ND0>(p0, p1, K_lds, qr, r32, hi, kcb);
  BAR_P();
  VSEG(true); HWRITE(1); HLOAD(2); BAR_A();
  pv_d0(o, vb0, pa0, pa1, pa2, pa3); qkt_c<ND0>(p0, p1, (bf16*)((char*)K_lds + SHM_K), qr, r32, hi, kcb, negm); BAR_P();
#pragma unroll 1
  for (int j = 1; j + 1 < NT; j += 2) {
    VSEG(false); HWRITE(0); HLOAD(j + 2); BAR_A();
    pv_d0(o, vb0 + SHM_V, pa0, pa1, pa2, pa3); qkt_c<ND0>(p0, p1, K_lds, qr, r32, hi, kcb, negm); BAR_P();
    VSEG(false); HWRITE(1); if (j + 3 < NT) HLOAD(j + 3); BAR_A();
    pv_d0(o, vb0, pa0, pa1, pa2, pa3); qkt_c<ND0>(p0, p1, (bf16*)((char*)K_lds + SHM_K), qr, r32, hi, kcb, negm); BAR_P();
  }
  VSEG(false); BAR_A();
  pv_d0(o, vb0 + SHM_V, pa0, pa1, pa2, pa3); BAR_P();
  if (half == 0) BAR_P();
#undef VSEG
#undef HLOAD
#undef HWRITE
#undef BAR_P
#undef BAR_A
}
__device__ __forceinline__ float half_sum32(float v) {
#pragma unroll
  for (int o = 1; o < 32; o <<= 1) v += __shfl_xor(v, o);
  return v;
}
__device__ __forceinline__ void diff_unit(const bf16* __restrict__ proj, bf16* __restrict__ mix, int h, int q0, float lam, float oml, const float* __restrict__ subg, char* lds) {
  int tid_ = threadIdx.x; asm volatile("" : "+v"(tid_));
  const int tid = tid_, wid = tid >> 6, lane = tid & 63, r32 = lane & 31, hi = lane >> 5, map = wid >> 2, wq = wid & 3;
  const bf16* Qw = proj + (size_t)(q0 + wq * 32 + r32) * LDP + h * 128 + map * 64 + hi * 8;
  f32x16 o[4]; float l_reg;
  attn_core<0>(Qw, proj + 1024 + h * 128, proj + 2048 + h * 128, 8192 / 64, lds, map * 128, 0, 0, 0, 0, 0, o, l_reg);
  float* ws = (float*)(lds + OFF_WS) + wid * 64;
  if (hi == 0) ws[r32] = l_reg;
  asm volatile("s_waitcnt lgkmcnt(0)" ::: "memory");
  float rli[16];
#pragma unroll
  for (int r = 0; r < 16; ++r) rli[r] = __builtin_amdgcn_rcpf(ws[crow(r, hi)]);
  __syncthreads();
  float* X = (float*)lds + (wq * 64) * 64 + lane;
  if (map == 1) {
#pragma unroll
    for (int d = 0; d < 4; ++d)
#pragma unroll
      for (int r = 0; r < 16; ++r) X[(d * 16 + r) * 64] = o[d][r] * rli[r];
  }
  __syncthreads();
  if (map == 0) {
    float gv[4];
#pragma unroll
    for (int d = 0; d < 4; ++d) gv[d] = subg[32 * d + r32] * oml;
    bf16* Ow = mix + (size_t)(q0 + wq * 32) * 2048 + 1024 + h * 128 + r32;
#pragma unroll
    for (int r = 0; r < 16; ++r) {
      float dv[4]; float sq = 0.f;
#pragma unroll
      for (int d = 0; d < 4; ++d) { dv[d] = o[d][r] * rli[r] - lam * X[(d * 16 + r) * 64]; sq += dv[d] * dv[d]; }
      sq = half_sum32(sq);
      const float rn = rsqrtf(sq * (1.0f / 128.0f) + 1e-6f);
      bf16* orow = Ow + (size_t)crow(r, hi) * 2048;
#pragma unroll
      for (int d = 0; d < 4; ++d) orow[32 * d] = (bf16)(cvtpk(dv[d] * rn * gv[d], 0.f) & 0xffffu);
    }
  }
  __syncthreads();
}
__device__ __forceinline__ void attn_na_core(const bf16* __restrict__ Qw, const bf16* __restrict__ Kh, const bf16* __restrict__ Vh, const int NT, char* lds,
                                             const int na_qr, const int na_rs, const int na_qc, const int na_cs, const int na_k0, f32x16 (&o)[4], float& l_reg) {
  int tid_ = threadIdx.x; asm volatile("" : "+v"(tid_));
  const int tid = tid_, wid = tid >> 6, lane = tid & 63, r32 = lane & 31, hi = lane >> 5;
  bf16* V_lds = (bf16*)lds; bf16* K_lds = (bf16*)(lds + 2 * SHM_V);
  float* ws = (float*)(lds + OFF_WS) + wid * 64; float* al_l = ws + 32;
  const float* rpbS = (const float*)(lds + OFF_RPB);
  float m_reg = -1e30f; l_reg = 0.f;
#pragma unroll
  for (int d = 0; d < 4; ++d) o[d] = f32x16{};
  bf16x8 qr[8];
#pragma unroll
  for (int d0 = 0; d0 < 8; ++d0) qr[d0] = ld8(Qw + d0 * 16);
  const int sr = tid >> 4, sc = (tid & 15) * 8, vst0 = v_st(sr, sc), vst1 = v_st(32 + sr, sc);
  const int vb0 = (int)(uintptr_t)V_lds + v_rd_base(lane);
  bf16x8 vs0, vs1, ks0, ks1;
#define SLOAD(k0) do { vs0 = ld8(&Vh[(long)((k0) + sr) * LDP + sc]); vs1 = ld8(&Vh[(long)((k0) + 32 + sr) * LDP + sc]); \
    ks0 = ld8(&Kh[(long)((k0) + sr) * LDP + sc]); ks1 = ld8(&Kh[(long)((k0) + 32 + sr) * LDP + sc]); } while (0)
  SLOAD(0);
#pragma unroll 1
  for (int j = 0; j < NT; ++j) {
    __syncthreads();
    *(bf16x8*)((char*)V_lds + vst0) = vs0; *(bf16x8*)((char*)V_lds + vst1) = vs1;
    *(bf16x8*)((char*)K_lds + KSWZ(sr, sc * 2)) = ks0; *(bf16x8*)((char*)K_lds + KSWZ(32 + sr, sc * 2)) = ks1;
    if (j + 1 < NT) SLOAD((j + 1) * 64);
    __syncthreads();
    const int kr = na_k0 + j;
    if (kr >= na_rs && kr < na_rs + 8) {
      f32x16 p0, p1; float mn, al; bf16x8 pa0, pa1, pa2, pa3;
      qkt<8>(p0, p1, K_lds, qr, r32, hi, 0);
      na_fix(p0, p1, kr, na_qr, na_rs, na_qc, na_cs, hi, rpbS);
      partialSM<1>(p0, p1, m_reg, mn, al);
      if (__any(al < 1.f)) { if (hi == 0) al_l[r32] = al; asm volatile("s_waitcnt lgkmcnt(0)" ::: "memory");
#pragma unroll
        for (int d = 0; d < 4; ++d)
#pragma unroll
          for (int r = 0; r < 16; ++r) o[d][r] *= al_l[crow(r, hi)]; }
      finishSM(p0, p1, al, l_reg, pa0, pa1, pa2, pa3); SBAR();
      pv_d0(o, vb0, pa0, pa1, pa2, pa3);
    }
  }
#undef SLOAD
}
__device__ __forceinline__ void na_unit(const bf16* __restrict__ proj, bf16* __restrict__ mix, float* __restrict__ nass, int h, int rb, const float* __restrict__ rpb_h, char* lds) {
  int tid_ = threadIdx.x; asm volatile("" : "+v"(tid_));
  const int tid = tid_, wid = tid >> 6, lane = tid & 63, r32 = lane & 31, hi = lane >> 5;
  float* rpbS = (float*)(lds + OFF_RPB);
  if (tid < 15 * 31) rpbS[tid] = rpb_h[tid] * 11.313708498984761f;
  const int q0 = rb * 256; int k0row = rb * 4 - 4; k0row = k0row < 0 ? 0 : (k0row > 116 ? 116 : k0row);
  const int qr_ = rb * 4 + (wid >> 1), qc = (wid & 1) * 32 + r32;
  int rs = qr_ - 4; rs = rs < 0 ? 0 : (rs > 120 ? 120 : rs);
  int cs = qc - 8; cs = cs < 0 ? 0 : (cs > 48 ? 48 : cs);
  const bf16* Qw = proj + (size_t)(q0 + wid * 32 + r32) * LDP + 3072 + h * 128 + hi * 8;
  const bf16* Kh = proj + (size_t)k0row * 64 * LDP + 4096 + h * 128;
  const bf16* Vh = proj + (size_t)k0row * 64 * LDP + 5120 + h * 128;
  f32x16 o[4]; float l_reg;
  attn_na_core(Qw, Kh, Vh, 12, lds, qr_, rs, qc, cs, k0row, o, l_reg);
  int t2 = threadIdx.x; asm volatile("" : "+v"(t2));
  const int wid2 = t2 >> 6, r32b = t2 & 31, hib = (t2 >> 5) & 1;
  float* ws = (float*)(lds + OFF_WS) + wid2 * 64;
  if (hib == 0) ws[r32b] = l_reg;
  asm volatile("s_waitcnt lgkmcnt(0)" ::: "memory");
  bf16* Ow = mix + (size_t)(rb * 256 + wid2 * 32) * 2048 + h * 128 + r32b;
  float* nrow = nass + (size_t)(rb * 256 + wid2 * 32) * 8 + h;
#pragma unroll
  for (int r = 0; r < 16; ++r) {
    const float rl = __builtin_amdgcn_rcpf(ws[crow(r, hib)]);
    bf16* orow = Ow + (size_t)crow(r, hib) * 2048; float sq = 0.f;
#pragma unroll
    for (int d = 0; d < 4; ++d) { const float v = o[d][r] * rl; sq += v * v; orow[32 * d] = (bf16)(cvtpk(v, 0.f) & 0xffffu); }
    sq = half_sum32(sq);
    if (r32b == 0) nrow[(size_t)crow(r, hib) * 8] = sq;
  }
  __syncthreads();
}
#undef KSWZ
#undef SBAR
}
#define LAS __attribute__((address_space(3)))
typedef unsigned short bf16_t;
typedef unsigned v4u __attribute__((ext_vector_type(4)));
typedef unsigned v2u __attribute__((ext_vector_type(2)));
typedef float v4f __attribute__((ext_vector_type(4)));
#define XB_TMO      128
#define XB_XCNT(j)  (256  + 64 * (j))
#define XB_XSUB(j)  (1280 + 64 * (j))
#define XB_XGEN(j)  (2304 + 64 * (j))
#define XB_TOP      3328
#define XB_TOPGEN   3392
#define XCD_BAR_WORDS 3456
#define XB_SPIN_CAP (1u << 18)

__device__ __forceinline__ unsigned xb_ld(unsigned* p)              { return __hip_atomic_load(p, __ATOMIC_RELAXED, __HIP_MEMORY_SCOPE_AGENT); }
__device__ __forceinline__ unsigned xb_add(unsigned* p, unsigned v) { return __hip_atomic_fetch_add(p, v, __ATOMIC_RELAXED, __HIP_MEMORY_SCOPE_AGENT); }
__device__ __forceinline__ unsigned xb_xcc_id() { return (unsigned)__builtin_amdgcn_s_getreg((3 << 11) | 20) & 0xFu; }
#define XB_SPIN(cond, bar) do { unsigned _sp = 0; while (cond) { __builtin_amdgcn_s_sleep(1); \
    if ((++_sp & 255u) == 0u) { if (xb_ld(&(bar)[XB_TMO])) break; if (_sp > XB_SPIN_CAP) { atomicAdd(&(bar)[XB_TMO], 1u); break; } } } } while (0)

struct XcdBarrier {
    unsigned* bar; unsigned x;
    volatile LAS unsigned* st;
};

__device__ __forceinline__ XcdBarrier xcd_barrier_post(unsigned* bar, volatile LAS unsigned* st) {
    XcdBarrier b; b.bar = bar; b.x = xb_xcc_id(); b.st = st;
    if (threadIdx.x == 0) (void)xb_add(&bar[XB_XCNT(b.x)], 1u);
    return b;
}
__device__ __forceinline__ void xcd_barrier_complete(unsigned* bar, unsigned x, unsigned& nloc, unsigned& nx) {
    const unsigned G = gridDim.x * gridDim.y * gridDim.z;
    unsigned sum, cnt, mine, sp = 0u;
    for (;;) {
        sum = 0u; cnt = 0u; mine = 0u;
#pragma unroll
        for (unsigned j = 0; j < 16; ++j) { const unsigned c = xb_ld(&bar[XB_XCNT(j)]); sum += c; cnt += (c > 0u) ? 1u : 0u; mine = (j == x) ? c : mine; }
        if (sum == G) break;
        __builtin_amdgcn_s_sleep(1);
        if ((++sp & 255u) == 0u) { if (xb_ld(&bar[XB_TMO])) break; if (sp > XB_SPIN_CAP) { atomicAdd(&bar[XB_TMO], 1u); break; } }
    }
    nloc = mine > 0u ? mine : 1u; nx = cnt > 0u ? cnt : 1u;
}

__device__ __forceinline__ void xcd_barrier(const XcdBarrier& b) {
    asm volatile("s_waitcnt vmcnt(0)" ::: "memory");
    __syncthreads();
    if (threadIdx.x == 0) {
        unsigned* bar = b.bar;
        __builtin_amdgcn_s_waitcnt(0);
        unsigned nloc = b.st[0], nx = b.st[1];
        if (nloc == 0u) { xcd_barrier_complete(bar, b.x, nloc, nx); b.st[0] = nloc; b.st[1] = nx; }
        const unsigned old = xb_add(&bar[XB_XSUB(b.x)], 1u);
        const unsigned gen = old / nloc;
        if (old + 1u == (gen + 1u) * nloc) {
            __builtin_amdgcn_fence(__ATOMIC_RELEASE, "agent");
            asm volatile("s_waitcnt vmcnt(0)" ::: "memory");
            const unsigned og = xb_add(&bar[XB_TOP], 1u);
            const unsigned tg = og / nx;
            if (og + 1u == (tg + 1u) * nx) xb_add(&bar[XB_TOPGEN], 1u);
            else XB_SPIN(xb_ld(&bar[XB_TOPGEN]) == tg, bar);
            __builtin_amdgcn_fence(__ATOMIC_ACQUIRE, "agent");
            xb_add(&bar[XB_XGEN(b.x)], 1u);
            asm volatile("s_waitcnt vmcnt(0)" ::: "memory");
        } else {
            XB_SPIN(xb_ld(&bar[XB_XGEN(b.x)]) == gen, bar);
            __builtin_amdgcn_fence(__ATOMIC_ACQUIRE, "agent");
            asm volatile("s_waitcnt vmcnt(0)" ::: "memory");
        }
    }
    __syncthreads();
}

constexpr int SEQ = 8192, DM = 2048, INC = 6144, FF = 8192, DEPTH = 4, NTHR = 512;
constexpr size_t SZ_WIN = (size_t)INC * DM * 2, SZ_WOUT = (size_t)DM * DM * 2, SZ_WMI = (size_t)FF * DM * 2, SZ_WMO = (size_t)DM * FF * 2;
constexpr size_t WS_WIN = 0, WS_WOUT = WS_WIN + DEPTH * SZ_WIN, WS_WMI = WS_WOUT + DEPTH * SZ_WOUT, WS_WMO = WS_WMI + DEPTH * SZ_WMI;
constexpr size_t WS_X = WS_WMO + DEPTH * SZ_WMO, WS_XB = WS_X + (size_t)SEQ * DM * 4, WS_PROJ = WS_XB + (size_t)SEQ * DM * 2, WS_MIX = WS_PROJ + (size_t)SEQ * INC * 2;
constexpr size_t WS_U = WS_MIX + (size_t)SEQ * DM * 2, WS_SS = WS_U + (size_t)SEQ * FF * 2, WS_COS = WS_SS + 9 * (size_t)SEQ * 32 * 4, WS_SIN = WS_COS + (size_t)SEQ * 32 * 4;
constexpr size_t WS_LAM = WS_SIN + (size_t)SEQ * 32 * 4, WS_BAR = WS_LAM + 256, WS_NASS = WS_BAR + 16384, WS_END = WS_NASS + (size_t)SEQ * 8 * 4;
#ifndef REP_P0
#define REP_P0 1
#endif
#ifndef REP_P1
#define REP_P1 1
#endif
#ifndef REP_P2
#define REP_P2 1
#endif
#ifndef REP_P3
#define REP_P3 1
#endif
#ifndef REP_P4
#define REP_P4 1
#endif
#ifndef REP_P6
#define REP_P6 1
#endif
#ifndef REP_P5
#define REP_P5 1
#endif
constexpr int LDS_BYTES = 139264;
static_assert(att::ATT_LDS <= LDS_BYTES && pg8::STAGE_BYTES <= LDS_BYTES, "LDS map");

struct Args {
    const float* in[15]; float* out; unsigned char* ws;
    double invf[32];
    float lam_init[4]; int pad[2];
};

__device__ __forceinline__ float wave_sum(float v) {
#pragma unroll
    for (int o = 1; o < 64; o <<= 1) v += __shfl_xor(v, o);
    return v;
}
__device__ __forceinline__ unsigned pk2(float lo, float hi) { return pg8::cvt_pk_bf16(lo, hi); }

struct TpItem { const float* W; bf16_t* WT; const float* gv; int K, N, k0, n0, krot; bool perm; };
__device__ __forceinline__ void tp_load(const TpItem& d, int lane, float (&w)[32]) {
    const float* wp = d.W + (size_t)(d.k0 + (lane >> 5)) * d.N + d.n0 + (lane & 31);
#pragma unroll
    for (int i = 0; i < 32; ++i) w[i] = wp[(size_t)(2 * i) * d.N];
}
__device__ __forceinline__ void tp_store(const TpItem& d, int lane, const float (&w)[32], LAS float* scr) {
    const int c = lane & 7;
    v4f g0 = {1.f, 1.f, 1.f, 1.f}, g1 = {1.f, 1.f, 1.f, 1.f};
    if (d.gv) { g0 = *(const v4f*)(d.gv + d.k0 + 8 * c); g1 = *(const v4f*)(d.gv + d.k0 + 8 * c + 4); }
#pragma unroll
    for (int i = 0; i < 32; ++i) scr[(2 * i + (lane >> 5)) * 33 + (lane & 31)] = w[i];
    asm volatile("s_waitcnt lgkmcnt(0)" ::: "memory");
#pragma unroll
    for (int j = 0; j < 4; ++j) { const int n = (lane >> 3) + 8 * j; const LAS float* s = scr + (8 * c) * 33 + n;
        v4u o; o.x = pk2(s[0 * 33] * g0.x, s[1 * 33] * g0.y); o.y = pk2(s[2 * 33] * g0.z, s[3 * 33] * g0.w); o.z = pk2(s[4 * 33] * g1.x, s[5 * 33] * g1.y); o.w = pk2(s[6 * 33] * g1.z, s[7 * 33] * g1.w);
        const int no = d.n0 + n; int dst = no;
        if (d.perm && no < 2048) { const int q = no & 63; dst = (no & ~63) + 8 * ((q & 31) >> 2) + 4 * (q >> 5) + (q & 3); }
        *(v4u*)(d.WT + (size_t)dst * d.K + ((d.k0 + d.krot) & (d.K - 1)) + 8 * c) = o; }
    asm volatile("s_waitcnt lgkmcnt(0)" ::: "memory");
}

__global__ void __launch_bounds__(NTHR, 2) fwd_megakernel(Args a) {
    extern __shared__ __attribute__((aligned(16))) unsigned char lds[];
    cg::grid_group grid = cg::this_grid();
#define GRID_SYNC() do { asm volatile("s_waitcnt vmcnt(0) lgkmcnt(0)" ::: "memory"); grid.sync(); __builtin_amdgcn_fence(__ATOMIC_ACQUIRE, "agent"); asm volatile("s_waitcnt vmcnt(0)" ::: "memory"); } while (0)
    const int tid = threadIdx.x, lane = tid & 63, wave = __builtin_amdgcn_readfirstlane(tid >> 6);
    const int G = gridDim.x, bx = blockIdx.x;
    const int gw = bx * 8 + wave, NGW = G * 8;
    unsigned char* ws = a.ws;
    bf16_t* WinT = (bf16_t*)(ws + WS_WIN); bf16_t* WoutT = (bf16_t*)(ws + WS_WOUT); bf16_t* WmiT = (bf16_t*)(ws + WS_WMI); bf16_t* WmoT = (bf16_t*)(ws + WS_WMO);
    float* X = (float*)(ws + WS_X); bf16_t* XB = (bf16_t*)(ws + WS_XB); bf16_t* PROJ = (bf16_t*)(ws + WS_PROJ); bf16_t* MIX = (bf16_t*)(ws + WS_MIX); bf16_t* U = (bf16_t*)(ws + WS_U);
    float* SS = (float*)(ws + WS_SS); float* COS = (float*)(ws + WS_COS); float* SIN = (float*)(ws + WS_SIN); float* LAM = (float*)(ws + WS_LAM); float* NASS = (float*)(ws + WS_NASS);
    LAS unsigned char* ldsl = (LAS unsigned char*)lds;
    volatile LAS unsigned* bst = (volatile LAS unsigned*)(ldsl + 135168);
    if (tid < 2) bst[tid] = 0u;
    __syncthreads();
    const XcdBarrier xbar = xcd_barrier_post((unsigned*)(ws + WS_BAR), bst);

    for (int rep = 0; rep < REP_P0; ++rep) {
        LAS float* scr = (LAS float*)(ldsl + wave * 16384);
        constexpr int I_IN = (DM / 64) * (INC / 32), I_OUT = (DM / 64) * (DM / 32), I_MI = (DM / 64) * (FF / 32), I_MO = (FF / 64) * (DM / 32), I_L = I_IN + I_OUT + I_MI + I_MO;
        auto mk = [&](int it) {
            TpItem d; const int l = it / I_L; int r = it % I_L; d.gv = nullptr; d.perm = false; d.krot = 0;
            if (r < I_IN) { d.W = a.in[2] + (size_t)l * DM * INC; d.K = DM; d.N = INC; d.WT = WinT + (size_t)l * INC * DM; d.gv = a.in[1] + l * DM; d.perm = true; }
            else if ((r -= I_IN) < I_OUT) {
                d.W = a.in[10] + (size_t)l * DM * DM; d.K = DM; d.N = DM; d.WT = WoutT + (size_t)l * DM * DM; d.krot = 1024; if (r / (DM / 32) >= 16) d.gv = a.in[8] + l * 1024 - 1024; }
            else if ((r -= I_OUT) < I_MI) { d.W = a.in[12] + (size_t)l * DM * FF; d.K = DM; d.N = FF; d.WT = WmiT + (size_t)l * FF * DM; d.gv = a.in[11] + l * DM; }
            else { r -= I_MI; d.W = a.in[13] + (size_t)l * FF * DM; d.K = FF; d.N = DM; d.WT = WmoT + (size_t)l * DM * FF; }
            const int nblk = d.N / 32; d.k0 = 64 * (r / nblk); d.n0 = 32 * (r % nblk);
            return d; };
        {
            constexpr int NIT = DEPTH * I_L; float wa[32], wb[32]; int it = gw;
            TpItem da = mk(it < NIT ? it : 0), db = da;
            if (it < NIT) tp_load(da, lane, wa);
            while (it < NIT) {
                const int itb = it + NGW; if (itb < NIT) { db = mk(itb); tp_load(db, lane, wb); }
                tp_store(da, lane, wa, scr);
                if (itb >= NIT) break;
                const int ita = itb + NGW; if (ita < NIT) { da = mk(ita); tp_load(da, lane, wa); }
                tp_store(db, lane, wb, scr);
                it = ita;
            }
        }
        for (int m = gw; m < SEQ; m += NGW) {
            const v4f* xr = (const v4f*)(a.in[0] + (size_t)m * DM) + lane; v2u* bo = (v2u*)(XB + (size_t)m * DM) + lane;
            float s = 0.f;
#pragma unroll
            for (int j = 0; j < 8; ++j) { const v4f v = xr[64 * j]; v2u w; w.x = pk2(v.x, v.y); w.y = pk2(v.z, v.w); bo[64 * j] = w; s += (v.x * v.x + v.y * v.y) + (v.z * v.z + v.w * v.w); }
            s = wave_sum(s);
            if (lane < 32) SS[(size_t)m * 32 + lane] = lane == 0 ? s : 0.f;
        }
        for (int i = bx * NTHR + tid; i < SEQ * 32; i += G * NTHR) {
            const int t = i >> 5, j = i & 31; double rev = (double)t * a.invf[j] * 0.15915494309189535; rev -= floor(rev);
            const float rf = (float)rev; COS[i] = __builtin_amdgcn_cosf(rf); SIN[i] = __builtin_amdgcn_sinf(rf);
        }
        if (bx == 0 && wave < DEPTH) {
            const int l = wave;
            const float p1 = wave_sum(a.in[3][l * 64 + lane] * a.in[4][l * 64 + lane]), p2 = wave_sum(a.in[5][l * 64 + lane] * a.in[6][l * 64 + lane]);
            if (lane == 0) LAM[l] = expf(p1) - expf(p2) + a.lam_init[l];
        }
    }
    GRID_SYNC();

#pragma unroll 1
    for (int l = 0; l < DEPTH; ++l) {
        const float* ss1 = SS + (size_t)(2 * l) * SEQ * 32; float* ss2 = SS + (size_t)(2 * l + 1) * SEQ * 32; float* ss3 = SS + (size_t)(2 * l + 2) * SEQ * 32;
        for (int rep = 0; rep < REP_P1; ++rep) {
            pg8::Gemm g{XB, WinT + (size_t)l * INC * DM, SEQ, INC, DM}; pg8::StaticOrder S; S.init(SEQ, INC, G, bx);
            pg8::EpiProj E{PROJ, ss1, COS, SIN};
            pg8::gemm_phase<pg8::EpiProj, pg8::StaticOrder, true, true>(ldsl, g, S, E);
        }
        xcd_barrier(xbar);
        {
            for (int rep = 0; rep < REP_P2; ++rep)
            for (int u = bx; u < 8 * 32; u += G) { const int h = u >> 5, rb = u & 31;
                att::na_unit(PROJ, MIX, NASS, h, rb, a.in[9] + ((size_t)l * 8 + h) * 15 * 31, (char*)lds); }
            const float lam = LAM[l], oml = 1.0f - a.lam_init[l];
            for (int rep = 0; rep < REP_P3; ++rep)
            for (int u = bx; u < 8 * 64; u += G) { const int h = u & 7, qb = u >> 3;
                att::diff_unit(PROJ, MIX, h, qb * 128, lam, oml, a.in[7] + l * 128, (char*)lds); }
        }
        xcd_barrier(xbar);
        for (int rep = 0; rep < REP_P4; ++rep) {
            pg8::Gemm g{MIX, WoutT + (size_t)l * DM * DM, SEQ, DM, DM}; pg8::StaticOrder S; S.init(SEQ, DM, G, bx);
            pg8::EpiResidMid E{(l == 0 && rep == 0) ? a.in[0] : (const float*)X, X, XB, ss2, (rep & 1) ? -1.f : 1.f, NASS};
            pg8::gemm_phase<pg8::EpiResidMid, pg8::StaticOrder, true, true>(ldsl, g, S, E);
        }
        xcd_barrier(xbar);
        for (int rep = 0; rep < REP_P5; ++rep) {
            pg8::Gemm g{XB, WmiT + (size_t)l * FF * DM, SEQ, FF, DM}; pg8::StaticOrder S; S.init(SEQ, FF, G, bx);
            pg8::EpiRelu2 E{U, ss2};
            pg8::gemm_phase<pg8::EpiRelu2, pg8::StaticOrder, true, true>(ldsl, g, S, E);
        }
        xcd_barrier(xbar);
        for (int rep = 0; rep < REP_P6; ++rep) {
            pg8::Gemm g{U, WmoT + (size_t)l * DM * FF, SEQ, DM, FF}; pg8::StaticOrder S; S.init(SEQ, DM, G, bx);
            pg8::EpiResid E{X, X, XB, ss3, (rep & 1) ? -1.f : 1.f, nullptr};
            pg8::gemm_phase<pg8::EpiResid, pg8::StaticOrder, true, true>(ldsl, g, S, E);
        }
        xcd_barrier(xbar);
    }
    {
        const float* fg = a.in[14]; const float* ssf = SS + (size_t)8 * SEQ * 32;
        int lnf = threadIdx.x; asm volatile("" : "+v"(lnf)); lnf &= 63;
        for (int m = gw; m < SEQ; m += NGW) {
            const float rn = rsqrtf(wave_sum(lnf < 32 ? ssf[(size_t)m * 32 + lnf] : 0.f) * (1.0f / 2048.0f) + 1e-6f);
            const v4f* xr = (const v4f*)(X + (size_t)m * DM) + lnf; v4f* xo = (v4f*)(a.out + (size_t)m * DM) + lnf; const v4f* gp = (const v4f*)fg + lnf;
#pragma unroll
            for (int j = 0; j < 8; ++j) xo[64 * j] = xr[64 * j] * rn * gp[64 * j];
        }
    }
}

extern "C" void kernel_launch(void* const* d_in, const int* in_sizes, int n_in, void* d_out, int out_size, void* d_ws, size_t ws_size, hipStream_t stream) {
    static int grid_blocks = 0;
    if (grid_blocks == 0) {
        if (n_in != 15 || out_size != SEQ * DM || ws_size < WS_END) { fprintf(stderr, "kernel_launch: unexpected shapes (n_in %d out %d ws %zu, need %zu)\n", n_in, out_size, ws_size, (size_t)WS_END); grid_blocks = -1; return; }
        int dev = 0, cus = 0, per_cu = 0;
        hipGetDevice(&dev); hipDeviceGetAttribute(&cus, hipDeviceAttributeMultiprocessorCount, dev);
        if (hipFuncSetAttribute((const void*)fwd_megakernel, hipFuncAttributeMaxDynamicSharedMemorySize, LDS_BYTES) != hipSuccess) { fprintf(stderr, "kernel_launch: hipFuncSetAttribute failed\n"); grid_blocks = -1; return; }
        if (hipOccupancyMaxActiveBlocksPerMultiprocessor(&per_cu, (const void*)fwd_megakernel, NTHR, LDS_BYTES) != hipSuccess || per_cu < 1) { fprintf(stderr, "kernel_launch: occupancy query gave %d\n", per_cu); per_cu = 1; (void)hipGetLastError(); }
        grid_blocks = cus * per_cu;
    }
    if (grid_blocks < 0) return;
    Args a{};
    for (int i = 0; i < 15; ++i) a.in[i] = (const float*)d_in[i];
    a.out = (float*)d_out; a.ws = (unsigned char*)d_ws;
    for (int j = 0; j < 32; ++j) a.invf[j] = 1.0 / pow(10000.0, (double)(2 * j) / 64.0);
    for (int l = 0; l < 4; ++l) a.lam_init[l] = (float)(0.8 - 0.6 * exp(-0.3 * l));
    if (hipMemsetAsync((char*)d_ws + WS_BAR, 0, XCD_BAR_WORDS * 4, stream) != hipSuccess) { fprintf(stderr, "kernel_launch: hipMemsetAsync of the barrier words failed\n"); return; }
    void* args[] = {&a};
    hipError_t e = hipLaunchCooperativeKernel((void*)fwd_megakernel, dim3(grid_blocks), dim3(NTHR), args, LDS_BYTES, stream);
    if (e != hipSuccess) fprintf(stderr, "cooperative launch failed: %s (grid %d)\n", hipGetErrorString(e), grid_blocks);
}
```

```cpp
#include <hip/hip_runtime.h>
#include <hip/hip_cooperative_groups.h>
#include <cstdio>
#include <cstdint>
namespace cg = cooperative_groups;
namespace pg8 {
#define PG8_LAS __attribute__((address_space(3)))
typedef unsigned short bf16_t;
typedef short bf16x8 __attribute__((ext_vector_type(8)));
typedef float f32x4 __attribute__((ext_vector_type(4)));
typedef unsigned u32x4 __attribute__((ext_vector_type(4)));
constexpr int BM = 256, BK = 64, HALF = 128, HTB = HALF * BK * 2  , STAGE_BYTES = 8 * HTB, NXCD = 8, WGM = 8;

__host__ __device__ __forceinline__ int lds_byte(int r, int c) { const int st = (r >> 4) * 2 + (c >> 5), rr = r & 15, cc = c & 31, ob = rr * 64 + cc * 2; return st * 1024 + (ob ^ (((ob >> 9) & 1) << 5)); }
__host__ __device__ __forceinline__ void stage_rc(int b, int& R, int& C) { const int st = b / 1024, sb = b % 1024, swz = sb ^ (((sb >> 9) & 1) << 5); R = (st >> 1) * 16 + swz / 64; C = (st & 1) * 32 + (swz % 64) / 2; }
__host__ __device__ __forceinline__ int perm32(int rho) { const int n = rho >> 4, i = rho & 15; return 8 * (i >> 2) + 4 * n + (i & 3); }

struct Unit { int pm, pn; };
struct Gemm { const bf16_t* A; const bf16_t* Bt; int M, N, K; };

struct StaticOrder {
    int nM, nN, nwg, G, c;
    __host__ __device__ void init(int M, int N, int G_, int c_) { nM = M / BM; nN = N / BM; nwg = nM * nN; G = G_; c = c_; }
    __host__ __device__ bool next(int i, Unit& u) const {
        const long L = (long)i * G + c; if (L >= nwg) return false;
        int wgid = (int)L; { const int q = nwg / NXCD, r = nwg % NXCD, xcd = wgid % NXCD, off = wgid / NXCD; wgid = (xcd < r ? xcd * (q + 1) : r * (q + 1) + (xcd - r) * q) + off; }
        const int nig = WGM * nN, gid = wgid / nig, fm = gid * WGM, gsz = (nM - fm) < WGM ? (nM - fm) : WGM;
        u.pm = fm + ((wgid % nig) % gsz); u.pn = (wgid % nig) / gsz; return true;
    }
    __device__ __forceinline__ void a_ready(const Unit&) const {}
    __device__ __forceinline__ void done(const Unit&) const {}
};

__device__ __forceinline__ unsigned cvt_pk_bf16(float lo, float hi) { unsigned r; asm volatile("v_cvt_pk_bf16_f32 %0, %1, %2" : "=v"(r) : "v"(lo), "v"(hi)); return r; }
typedef float f32x2 __attribute__((ext_vector_type(2)));
typedef unsigned u32x2 __attribute__((ext_vector_type(2)));
constexpr float RMS_EPS = 1e-6f;
__device__ __forceinline__ float row_rstd(const float* ss, int row, int fq) {
    const f32x4* sp = (const f32x4*)(ss + (size_t)row * 32 + fq * 8); const f32x4 a = sp[0], b = sp[1];
    float s = ((a[0] + a[1]) + (a[2] + a[3])) + ((b[0] + b[1]) + (b[2] + b[3]));
    s += __shfl_xor(s, 16); s += __shfl_xor(s, 32);
    return rsqrtf(s * (1.0f / 2048.0f) + RMS_EPS);
}
struct EpiProj {
    static constexpr bool PERM = true, AFTER_DRAIN = false, MIDK = false;
    bf16_t* O; const float* ss; const float* cosT; const float* sinT;
    __device__ __forceinline__ void operator()(const f32x4 (&acc)[2][2][4][2], const Unit& u, int wr, int wc, int fr, int fq) const {
        const int row0 = u.pm * BM + wr * 64 + fr; const int colt = u.pn * BM;
        const bool rope = colt < 2048;
        const float qs = colt < 1024 ? 0.125f * 1.4426950408889634f : 1.f;
        const int g = (wc & 1) * 4 + fq;
        const int pos0 = colt + wc * 32 + 8 * fq;
        const int rbase = colt + 64 * (wc >> 1) + 4 * g;
#pragma unroll
        for (int ai = 0; ai < 2; ++ai)
#pragma unroll
            for (int m = 0; m < 4; ++m) {
                const int row = row0 + ai * HALF + m * 16;
                const float rs = row_rstd(ss, row, fq) * qs;
                bf16_t* rowp = O + (size_t)row * 6144;
                if (rope) {
                    const f32x4 c4 = *(const f32x4*)(cosT + row * 32 + 4 * g), s4 = *(const f32x4*)(sinT + row * 32 + 4 * g);
#pragma unroll
                    for (int bj = 0; bj < 2; ++bj) {
                        const f32x4 v0 = acc[ai][bj][m][0] * rs, v1 = acc[ai][bj][m][1] * rs;
                        const f32x4 o1 = v0 * c4 - v1 * s4, o2 = v1 * c4 + v0 * s4;
                        u32x2 w1, w2; w1.x = cvt_pk_bf16(o1[0], o1[1]); w1.y = cvt_pk_bf16(o1[2], o1[3]); w2.x = cvt_pk_bf16(o2[0], o2[1]); w2.y = cvt_pk_bf16(o2[2], o2[3]);
                        *(u32x2*)(rowp + rbase + bj * HALF) = w1; *(u32x2*)(rowp + rbase + bj * HALF + 32) = w2;
                    }
                } else {
#pragma unroll
                    for (int bj = 0; bj < 2; ++bj) {
                        const f32x4 v0 = acc[ai][bj][m][0] * rs, v1 = acc[ai][bj][m][1] * rs;
                        u32x4 w; w.x = cvt_pk_bf16(v0[0], v0[1]); w.y = cvt_pk_bf16(v0[2], v0[3]); w.z = cvt_pk_bf16(v1[0], v1[1]); w.w = cvt_pk_bf16(v1[2], v1[3]);
                        *(u32x4*)(rowp + pos0 + bj * HALF) = w;
                    }
                }
            }
    }
};
struct EpiRelu2 {
    static constexpr bool PERM = true, AFTER_DRAIN = false, MIDK = false;
    bf16_t* O; const float* ss;
    __device__ __forceinline__ void operator()(const f32x4 (&acc)[2][2][4][2], const Unit& u, int wr, int wc, int fr, int fq) const {
        const int row0 = u.pm * BM + wr * 64 + fr; const int pos0 = u.pn * BM + wc * 32 + 8 * fq;
#pragma unroll
        for (int ai = 0; ai < 2; ++ai)
#pragma unroll
            for (int m = 0; m < 4; ++m) {
                const int row = row0 + ai * HALF + m * 16;
                const float rs = row_rstd(ss, row, fq);
                bf16_t* rowp = O + (size_t)row * 8192 + pos0;
#pragma unroll
                for (int bj = 0; bj < 2; ++bj) {
                    f32x4 v0 = acc[ai][bj][m][0] * rs, v1 = acc[ai][bj][m][1] * rs;
#pragma unroll
                    for (int e = 0; e < 4; ++e) { v0[e] = fmaxf(v0[e], 0.f); v1[e] = fmaxf(v1[e], 0.f); }
                    v0 = v0 * v0; v1 = v1 * v1;
                    u32x4 w; w.x = cvt_pk_bf16(v0[0], v0[1]); w.y = cvt_pk_bf16(v0[2], v0[3]); w.z = cvt_pk_bf16(v1[0], v1[1]); w.w = cvt_pk_bf16(v1[2], v1[3]);
                    *(u32x4*)(rowp + bj * HALF) = w;
                }
            }
    }
};
template <bool MID> struct EpiResidT {
    static constexpr bool PERM = false, AFTER_DRAIN = false, MIDK = MID;
    const float* Xin; float* X; bf16_t* XB; float* ssout; float sign; const float* nass;
    __device__ __forceinline__ void mid(f32x4 (&acc)[2][2][4][2], const Unit& u, int wr, int wc, int fr, int fq) const {
        int t_ = threadIdx.x; asm volatile("" : "+v"(t_));
        const int row0 = u.pm * BM + wr * 64 + (t_ & 15);
#pragma unroll
        for (int ai = 0; ai < 2; ++ai)
#pragma unroll
            for (int m = 0; m < 4; ++m) {
                const f32x4* sp = (const f32x4*)(nass + (size_t)(row0 + ai * HALF + m * 16) * 8); const f32x4 a = sp[0], b = sp[1];
                const float rn = rsqrtf((((a[0] + a[1]) + (a[2] + a[3])) + ((b[0] + b[1]) + (b[2] + b[3]))) * (1.0f / 1024.0f) + RMS_EPS);
#pragma unroll
                for (int bj = 0; bj < 2; ++bj)
#pragma unroll
                    for (int n = 0; n < 2; ++n) acc[ai][bj][m][n] = acc[ai][bj][m][n] * rn;
            }
    }
    __device__ __forceinline__ void operator()(const f32x4 (&acc)[2][2][4][2], const Unit& u, int wr, int wc, int fr, int fq) const {
        const int row0 = u.pm * BM + wr * 64 + fr; const int col0 = u.pn * BM + wc * 32 + 4 * fq;
#pragma unroll
        for (int ai = 0; ai < 2; ++ai)
#pragma unroll
            for (int m = 0; m < 4; ++m) {
                const int row = row0 + ai * HALF + m * 16; float sq = 0.f;
#pragma unroll
                for (int bj = 0; bj < 2; ++bj)
#pragma unroll
                    for (int n = 0; n < 2; ++n) {
                        const size_t off = (size_t)row * 2048 + col0 + bj * HALF + n * 16;
                        const f32x4 xv = *(const f32x4*)(Xin + off) + acc[ai][bj][m][n] * sign;
                        *(f32x4*)(X + off) = xv;
                        u32x2 w; w.x = cvt_pk_bf16(xv[0], xv[1]); w.y = cvt_pk_bf16(xv[2], xv[3]);
                        *(u32x2*)(XB + off) = w;
                        sq += (xv[0] * xv[0] + xv[1] * xv[1]) + (xv[2] * xv[2] + xv[3] * xv[3]);
                    }
                sq += __shfl_xor(sq, 16); sq += __shfl_xor(sq, 32);
                if (fq == 0) ssout[(size_t)row * 32 + u.pn * 4 + wc] = sq;
            }
    }
};
typedef EpiResidT<false> EpiResid; typedef EpiResidT<true> EpiResidMid;
template <class Epi, class Sched, bool ALIGN_EPI = false, bool SP2 = false>
__device__ __forceinline__ void gemm_phase(PG8_LAS unsigned char* lds, const Gemm g, const Sched& S, const Epi& E) {
    int tid_ = threadIdx.x; asm volatile("" : "+v"(tid_));
    const int tid = tid_, wid = __builtin_amdgcn_readfirstlane(tid >> 6), lane = tid & 63, wr = wid >> 2, wc = wid & 3, fr = lane & 15, fq = lane >> 4;
    const int K = g.K, nt = K / BK;
    unsigned voffA[2], voffB[2];
#pragma unroll
    for (int i = 0; i < 2; ++i) { int R, C; stage_rc(tid * 16 + i * 8192, R, C); const int Rb = Epi::PERM ? ((R & ~31) + perm32(R & 31)) : R;
        voffA[i] = (unsigned)(R * K + C) * 2u; voffB[i] = (unsigned)(Rb * K + C) * 2u; }
    const size_t kstep = (size_t)(BK * 2);
    const size_t hstep = (size_t)HALF * K * 2;
    const size_t tstep = 2 * hstep;
    const unsigned ldsw = (unsigned)wid * 1024u;
    const int aoff = lds_byte(wr * 64 + fr, fq * 8), boff = lds_byte(wc * 32 + fr, fq * 8);
#define PG8_SA(b, h) (((b) * 2 + (h)) * HTB)
#define PG8_SB(b, h) ((4 + (b) * 2 + (h)) * HTB)
#define PG8_STAGE(bufoff, gbase, voff) do { _Pragma("unroll") for (int _i = 0; _i < 2; ++_i) \
        __builtin_amdgcn_global_load_lds((const unsigned*)((const char*)(gbase) + (voff)[_i]), (PG8_LAS unsigned*)(lds + (bufoff) + ldsw + _i * 8192), 16, 0, 0); } while (0)
#define PG8_LDA(dst, b, h) do { _Pragma("unroll") for (int m = 0; m < 4; ++m) _Pragma("unroll") for (int k = 0; k < 2; ++k) dst[m][k] = *(const PG8_LAS bf16x8*)(lds + PG8_SA(b, h) + aoff + m * 2048 + k * 1024); } while (0)
#define PG8_LDB(dst, b, h) do { _Pragma("unroll") for (int n = 0; n < 2; ++n) _Pragma("unroll") for (int k = 0; k < 2; ++k) dst[n][k] = *(const PG8_LAS bf16x8*)(lds + PG8_SB(b, h) + boff + n * 2048 + k * 1024); } while (0)
#define PG8_MMA(ai, bj, At, Bt) do { __builtin_amdgcn_s_setprio(1); _Pragma("unroll") for (int m = 0; m < 4; ++m) _Pragma("unroll") for (int n = 0; n < 2; ++n) _Pragma("unroll") for (int k = 0; k < 2; ++k) \
        acc[ai][bj][m][n] = __builtin_amdgcn_mfma_f32_16x16x32_bf16(Bt[n][k], At[m][k], acc[ai][bj][m][n], 0, 0, 0); __builtin_amdgcn_s_setprio(0); } while (0)
#define PG8_WAIT_V(n) asm volatile("s_waitcnt vmcnt(" #n ")" ::: "memory")
#define PG8_WAIT_L(n) asm volatile("s_waitcnt lgkmcnt(" #n ")" ::: "memory")
#define PG8_BAR __builtin_amdgcn_s_barrier()
#define PG8_SCHED __builtin_amdgcn_sched_barrier(0)
    Unit cur, nxt; int ui = 0;
    if (!S.next(0, cur)) return;
    f32x4 acc[2][2][4][2];
#pragma unroll
    for (int a = 0; a < 2; ++a)
#pragma unroll
        for (int b = 0; b < 2; ++b)
#pragma unroll
            for (int m = 0; m < 4; ++m)
#pragma unroll
                for (int n = 0; n < 2; ++n) acc[a][b][m][n] = (f32x4){0.f, 0.f, 0.f, 0.f};
    bf16x8 At[4][2], B0[2][2], B1[2][2];
    const char* cA = (const char*)g.A + (size_t)cur.pm * tstep; const char* cB = (const char*)g.Bt + (size_t)cur.pn * tstep;
    S.a_ready(cur);
    if constexpr (SP2) {
        PG8_STAGE(PG8_SB(0, 0), cB, voffB); PG8_STAGE(PG8_SB(0, 1), cB + hstep, voffB); PG8_STAGE(PG8_SA(0, 0), cA, voffA); PG8_STAGE(PG8_SA(0, 1), cA + hstep, voffA);
        if (wr == 1) PG8_BAR;
        PG8_WAIT_V(2); PG8_BAR;
        PG8_STAGE(PG8_SB(1, 0), cB + kstep, voffB); PG8_STAGE(PG8_SA(1, 0), cA + kstep, voffA); PG8_STAGE(PG8_SB(1, 1), cB + hstep + kstep, voffB);
        PG8_WAIT_V(6); PG8_BAR;
    } else {
        PG8_STAGE(PG8_SB(0, 0), cB, voffB); PG8_STAGE(PG8_SA(0, 0), cA, voffA); PG8_STAGE(PG8_SB(0, 1), cB + hstep, voffB); PG8_STAGE(PG8_SA(0, 1), cA + hstep, voffA);
        if (wr == 1) PG8_BAR;
        PG8_WAIT_V(4); PG8_BAR;
        PG8_STAGE(PG8_SB(1, 0), cB + kstep, voffB); PG8_STAGE(PG8_SA(1, 0), cA + kstep, voffA); PG8_STAGE(PG8_SB(1, 1), cB + hstep + kstep, voffB);
        PG8_WAIT_V(6); PG8_BAR;
    }
    for (;;) {
        const bool has_next = S.next(ui + 1, nxt);
        const char* nA = has_next ? (const char*)g.A + (size_t)nxt.pm * tstep : cA; const char* nB = has_next ? (const char*)g.Bt + (size_t)nxt.pn * tstep : cB;
        for (int t = 0; t < nt; t += 2) {
            if constexpr (Epi::MIDK) { if (t == nt / 2) E.mid(acc, cur, wr, wc, fr, fq); }
            const bool last = (t == nt - 2);
            const char* a1 = cA + (size_t)(t + 1) * kstep;
            const char* a2 = last ? nA : cA + (size_t)(t + 2) * kstep; const char* b2 = last ? nB : cB + (size_t)(t + 2) * kstep;
            const char* a3 = a2 + kstep; const char* b3 = b2 + kstep;
            if (last && has_next) S.a_ready(nxt);
            if constexpr (SP2) {
            PG8_LDB(B0, 0, 0); PG8_LDB(B1, 0, 1); PG8_SCHED; PG8_LDA(At, 0, 0); PG8_STAGE(PG8_SA(1, 1), a1 + hstep, voffA);
            PG8_WAIT_V(8); PG8_WAIT_L(0); PG8_BAR; PG8_MMA(0, 0, At, B0); PG8_MMA(0, 1, At, B1); PG8_BAR; PG8_SCHED;
            PG8_LDA(At, 0, 1); PG8_STAGE(PG8_SB(0, 0), b2, voffB); PG8_STAGE(PG8_SB(0, 1), b2 + hstep, voffB); PG8_STAGE(PG8_SA(0, 0), a2, voffA);
            PG8_WAIT_V(8); PG8_WAIT_L(0); PG8_BAR; PG8_MMA(1, 0, At, B0); PG8_MMA(1, 1, At, B1); PG8_BAR; PG8_SCHED;
            PG8_LDB(B0, 1, 0); PG8_LDB(B1, 1, 1); PG8_SCHED; PG8_LDA(At, 1, 0); PG8_STAGE(PG8_SA(0, 1), a2 + hstep, voffA);
            PG8_WAIT_V(8); PG8_WAIT_L(0); PG8_BAR; PG8_MMA(0, 0, At, B0); PG8_MMA(0, 1, At, B1); PG8_BAR; PG8_SCHED;
            PG8_LDA(At, 1, 1); PG8_STAGE(PG8_SB(1, 0), b3, voffB); PG8_STAGE(PG8_SB(1, 1), b3 + hstep, voffB); PG8_STAGE(PG8_SA(1, 0), a3, voffA);
            PG8_WAIT_V(8); PG8_WAIT_L(0); PG8_BAR; PG8_MMA(1, 0, At, B0); PG8_MMA(1, 1, At, B1); PG8_BAR; PG8_SCHED;
            } else {
            PG8_LDB(B0, 0, 0); PG8_SCHED; PG8_LDA(At, 0, 0); PG8_STAGE(PG8_SA(1, 1), a1 + hstep, voffA);
            PG8_WAIT_L(8); PG8_BAR; PG8_WAIT_L(0); PG8_MMA(0, 0, At, B0); PG8_BAR; PG8_SCHED;
            PG8_LDB(B1, 0, 1); PG8_STAGE(PG8_SB(0, 0), b2, voffB);
            PG8_BAR; PG8_WAIT_L(0); PG8_MMA(0, 1, At, B1); PG8_BAR;
            PG8_LDA(At, 0, 1); PG8_STAGE(PG8_SA(0, 0), a2, voffA);
            PG8_BAR; PG8_WAIT_L(0); PG8_MMA(1, 0, At, B0); PG8_BAR; PG8_SCHED;
            PG8_STAGE(PG8_SB(0, 1), b2 + hstep, voffB);
            PG8_WAIT_V(6); PG8_BAR; PG8_MMA(1, 1, At, B1); PG8_BAR;
            PG8_LDB(B0, 1, 0); PG8_SCHED; PG8_LDA(At, 1, 0); PG8_STAGE(PG8_SA(0, 1), a2 + hstep, voffA);
            PG8_WAIT_L(8); PG8_BAR; PG8_WAIT_L(0); PG8_MMA(0, 0, At, B0); PG8_BAR; PG8_SCHED;
            PG8_LDB(B1, 1, 1); PG8_STAGE(PG8_SB(1, 0), b3, voffB);
            PG8_BAR; PG8_WAIT_L(0); PG8_MMA(0, 1, At, B1); PG8_BAR;
            PG8_LDA(At, 1, 1); PG8_STAGE(PG8_SA(1, 0), a3, voffA);
            PG8_BAR; PG8_WAIT_L(0); PG8_MMA(1, 0, At, B0); PG8_BAR; PG8_SCHED;
            PG8_STAGE(PG8_SB(1, 1), b3 + hstep, voffB);
            PG8_WAIT_V(6); PG8_BAR; PG8_MMA(1, 1, At, B1); PG8_BAR;
            }
        }
        if constexpr (ALIGN_EPI) { if (wr == 0) PG8_BAR; }
        if constexpr (!Epi::AFTER_DRAIN) { E(acc, cur, wr, wc, fr, fq); S.done(cur); }
        if (!has_next) break;
#pragma unroll
        for (int a = 0; a < 2; ++a)
#pragma unroll
            for (int b = 0; b < 2; ++b)
#pragma unroll
                for (int m = 0; m < 4; ++m)
#pragma unroll
                    for (int n = 0; n < 2; ++n) acc[a][b][m][n] = (f32x4){0.f, 0.f, 0.f, 0.f};
        cur = nxt; cA = nA; cB = nB; ++ui;
        if constexpr (ALIGN_EPI) { if (wr == 1) PG8_BAR; }
    }
    PG8_WAIT_V(0);
    if constexpr (!ALIGN_EPI) { if (wr == 0) PG8_BAR; }
    PG8_BAR;
    if constexpr (Epi::AFTER_DRAIN) { E.fused(acc, cur, wr, wc, fr, fq, lds, wid, lane); S.done(cur); }
#undef PG8_SA
#undef PG8_SB
#undef PG8_STAGE
#undef PG8_LDA
#undef PG8_LDB
#undef PG8_MMA
#undef PG8_WAIT_V
#undef PG8_WAIT_L
#undef PG8_BAR
#undef PG8_SCHED
}
}
namespace att {
typedef unsigned short bf16;
using bf16x8 = __attribute__((ext_vector_type(8))) short;
using s16x4  = __attribute__((ext_vector_type(4))) short;
using f32x16 = __attribute__((ext_vector_type(16))) float;
using u32x4  = __attribute__((ext_vector_type(4))) unsigned;
constexpr int LDP = 6144;
constexpr int SHM_V = 64 * 128 * 2, SHM_K = 64 * 128 * 2;
constexpr int OFF_WS = 2 * SHM_V + 2 * SHM_K, OFF_RPB = OFF_WS + 8 * 64 * 4, ATT_LDS = OFF_RPB + 2048;
constexpr float THR = 8.f;
#define KSWZ(row, colB) ((row) * 256 + ((colB) ^ (((row) & 7) << 4)))
#define SBAR() __builtin_amdgcn_sched_barrier(0)
__device__ __forceinline__ int crow(int r, int hi) { return (r & 3) + 8 * (r >> 2) + 4 * hi; }
__device__ __forceinline__ unsigned cvtpk(float lo, float hi) {
  unsigned r; asm volatile("v_cvt_pk_bf16_f32 %0, %1, %2" : "=v"(r) : "v"(lo), "v"(hi)); return r;
}
__device__ __forceinline__ bf16x8 ld8(const bf16* p) { return *reinterpret_cast<const bf16x8*>(p); }

template <int MODE> struct Cfg;
template <> struct Cfg<0> { static constexpr int ND0 = 4; static constexpr float SCALE = 0.125f; };
template <> struct Cfg<1> { static constexpr int ND0 = 8; static constexpr float SCALE = 0.088388347648318440f; };

template <int MODE>
__device__ __forceinline__ void partialSM(f32x16& p0, f32x16& p1, float& m_reg, float& mn, float& alpha) {
  constexpr float SCALE = Cfg<MODE>::SCALE;
  constexpr float C = SCALE * 1.4426950408889634f;
  float pmax = p0[0];
#pragma unroll
  for (int r = 1; r < 16; ++r) pmax = fmaxf(pmax, p0[r]);
#pragma unroll
  for (int r = 0; r < 16; ++r) pmax = fmaxf(pmax, p1[r]);
  { auto rr = __builtin_amdgcn_permlane32_swap(__float_as_uint(pmax), __float_as_uint(pmax), false, false);
    pmax = fmaxf(__uint_as_float(rr[0]), __uint_as_float(rr[1])); }
  if (__builtin_expect(__all(pmax - m_reg <= THR / SCALE), 1)) { mn = m_reg; alpha = 1.f; }
  else { mn = fmaxf(m_reg, pmax); alpha = __builtin_amdgcn_exp2f((m_reg - mn) * C); m_reg = mn; }
  float mnC = -mn * C;
#pragma unroll
  for (int r = 0; r < 16; ++r) p0[r] = fmaf(p0[r], C, mnC);
#pragma unroll
  for (int r = 0; r < 16; ++r) p1[r] = fmaf(p1[r], C, mnC);
#pragma unroll
  for (int r = 0; r < 16; ++r) p0[r] = __builtin_amdgcn_exp2f(p0[r]);
}
__device__ __forceinline__ void finishSM(f32x16& p0, f32x16& p1, float alpha, float& l_reg, bf16x8& pa0, bf16x8& pa1, bf16x8& pa2, bf16x8& pa3) {
#pragma unroll
  for (int r = 0; r < 16; ++r) p1[r] = __builtin_amdgcn_exp2f(p1[r]);
  float ps = 0;
#pragma unroll
  for (int r = 0; r < 16; ++r) ps += p0[r];
#pragma unroll
  for (int r = 0; r < 16; ++r) ps += p1[r];
  { auto rr = __builtin_amdgcn_permlane32_swap(__float_as_uint(ps), __float_as_uint(ps), false, false);
    ps = __uint_as_float(rr[0]) + __uint_as_float(rr[1]); }
  l_reg = l_reg * alpha + ps;
#define PK4(P, BASE, OUT) do { u32x4 w = {cvtpk(P[BASE + 0], P[BASE + 1]), cvtpk(P[BASE + 2], P[BASE + 3]), cvtpk(P[BASE + 4], P[BASE + 5]), cvtpk(P[BASE + 6], P[BASE + 7])}; \
    OUT = *reinterpret_cast<bf16x8*>(&w); } while (0)
  PK4(p0, 0, pa0); PK4(p0, 8, pa1); PK4(p1, 0, pa2); PK4(p1, 8, pa3);
#undef PK4
}
__device__ __forceinline__ void finishSM_ns(f32x16& p0, f32x16& p1, bf16x8& pa0, bf16x8& pa1, bf16x8& pa2, bf16x8& pa3) {
#pragma unroll
  for (int r = 0; r < 16; ++r) p1[r] = __builtin_amdgcn_exp2f(p1[r]);
#define PK4(P, BASE, OUT) do { u32x4 w = {cvtpk(P[BASE + 0], P[BASE + 1]), cvtpk(P[BASE + 2], P[BASE + 3]), cvtpk(P[BASE + 4], P[BASE + 5]), cvtpk(P[BASE + 6], P[BASE + 7])}; \
    OUT = *reinterpret_cast<bf16x8*>(&w); } while (0)
  PK4(p0, 0, pa0); PK4(p0, 8, pa1); PK4(p1, 0, pa2); PK4(p1, 8, pa3);
#undef PK4
}
__device__ __forceinline__ void sm_sum(const f32x16& p0, const f32x16& p1, float& ps) {
  ps = 0;
#pragma unroll
  for (int r = 0; r < 16; ++r) ps += p0[r];
#pragma unroll
  for (int r = 0; r < 16; ++r) ps += p1[r];
}
template <int MODE>
__device__ __forceinline__ void sm_lmax(float ps, float alpha_prev, float& l_reg, const f32x16& p0, const f32x16& p1, float& m_reg, float& mn, float& alpha, float& mnC) {
  constexpr float SCALE = Cfg<MODE>::SCALE; constexpr float C = SCALE * 1.4426950408889634f;
  { auto rr = __builtin_amdgcn_permlane32_swap(__float_as_uint(ps), __float_as_uint(ps), false, false);
    ps = __uint_as_float(rr[0]) + __uint_as_float(rr[1]); }
  l_reg = l_reg * alpha_prev + ps;
  float pmax = p0[0];
#pragma unroll
  for (int r = 1; r < 16; ++r) pmax = fmaxf(pmax, p0[r]);
#pragma unroll
  for (int r = 0; r < 16; ++r) pmax = fmaxf(pmax, p1[r]);
  { auto rr = __builtin_amdgcn_permlane32_swap(__float_as_uint(pmax), __float_as_uint(pmax), false, false);
    pmax = fmaxf(__uint_as_float(rr[0]), __uint_as_float(rr[1])); }
  if (__builtin_expect(__all(pmax - m_reg <= THR / SCALE), 1)) { mn = m_reg; alpha = 1.f; }
  else { mn = fmaxf(m_reg, pmax); alpha = __builtin_amdgcn_exp2f((m_reg - mn) * C); m_reg = mn; }
  mnC = -mn * C;
}
template <int MODE>
__device__ __forceinline__ void sm_fma(f32x16& p0, f32x16& p1, float mnC) {
  constexpr float C = Cfg<MODE>::SCALE * 1.4426950408889634f;
#pragma unroll
  for (int r = 0; r < 16; ++r) p0[r] = fmaf(p0[r], C, mnC);
#pragma unroll
  for (int r = 0; r < 16; ++r) p1[r] = fmaf(p1[r], C, mnC);
}
__device__ __forceinline__ void sm_exp0(f32x16& p0) {
#pragma unroll
  for (int r = 0; r < 16; ++r) p0[r] = __builtin_amdgcn_exp2f(p0[r]);
}
template <int ND0>
__device__ __forceinline__ void qkt(f32x16& p0, f32x16& p1, const bf16* Ks, const bf16x8* qr, int r32, int hi, int kcb) {
  p0 = f32x16{}; p1 = f32x16{};
#pragma unroll
  for (int d0 = 0; d0 < ND0; ++d0) { int cb = kcb + (d0 * 16 + hi * 8) * 2;
    bf16x8 b0 = *reinterpret_cast<const bf16x8*>((const char*)Ks + KSWZ(r32, cb));
    bf16x8 b1 = *reinterpret_cast<const bf16x8*>((const char*)Ks + KSWZ(32 + r32, cb));
    p0 = __builtin_amdgcn_mfma_f32_32x32x16_bf16(b0, qr[d0], p0, 0, 0, 0);
    p1 = __builtin_amdgcn_mfma_f32_32x32x16_bf16(b1, qr[d0], p1, 0, 0, 0); }
}
constexpr float THRL = 8.f * 1.4426950408889634f;
template <int ND0>
__device__ __forceinline__ void qkt_c(f32x16& p0, f32x16& p1, const bf16* Ks, const bf16x8* qr, int r32, int hi, int kcb, const f32x16& negm) {
  bf16x8 kb0[ND0], kb1[ND0];
#pragma unroll
  for (int d0 = 0; d0 < ND0; ++d0) { int cb = kcb + (d0 * 16 + hi * 8) * 2;
    kb0[d0] = *reinterpret_cast<const bf16x8*>((const char*)Ks + KSWZ(r32, cb));
    kb1[d0] = *reinterpret_cast<const bf16x8*>((const char*)Ks + KSWZ(32 + r32, cb)); }
  SBAR();
#pragma unroll
  for (int d0 = 0; d0 < ND0; ++d0) { const bf16x8 b0 = kb0[d0], b1 = kb1[d0];
    if (d0 == 0) { p0 = __builtin_amdgcn_mfma_f32_32x32x16_bf16(b0, qr[d0], negm, 0, 0, 0); p1 = __builtin_amdgcn_mfma_f32_32x32x16_bf16(b1, qr[d0], negm, 0, 0, 0); }
    else { p0 = __builtin_amdgcn_mfma_f32_32x32x16_bf16(b0, qr[d0], p0, 0, 0, 0); p1 = __builtin_amdgcn_mfma_f32_32x32x16_bf16(b1, qr[d0], p1, 0, 0, 0); } }
}
__device__ __forceinline__ float rowmax32(const f32x16& p0, const f32x16& p1) {
  float pmax = p0[0];
#pragma unroll
  for (int r = 1; r < 16; ++r) pmax = fmaxf(pmax, p0[r]);
#pragma unroll
  for (int r = 0; r < 16; ++r) pmax = fmaxf(pmax, p1[r]);
  auto rr = __builtin_amdgcn_permlane32_swap(__float_as_uint(pmax), __float_as_uint(pmax), false, false);
  return fmaxf(__uint_as_float(rr[0]), __uint_as_float(rr[1]));
}
__device__ __forceinline__ void firstSM_l2(f32x16& p0, f32x16& p1, float& m_reg, f32x16& negm) {
  const float pmax = rowmax32(p0, p1);
  m_reg = pmax;
#pragma unroll
  for (int r = 0; r < 16; ++r) { negm[r] = -pmax; p0[r] -= pmax; p1[r] -= pmax; }
#pragma unroll
  for (int r = 0; r < 16; ++r) p0[r] = __builtin_amdgcn_exp2f(p0[r]);
}
__device__ __forceinline__ void sm_lmax_l2(float ps, float alpha_prev, float& l_reg, f32x16& p0, f32x16& p1, float& m_reg, float& alpha, f32x16& negm) {
  { auto rr = __builtin_amdgcn_permlane32_swap(__float_as_uint(ps), __float_as_uint(ps), false, false);
    ps = __uint_as_float(rr[0]) + __uint_as_float(rr[1]); }
  l_reg = l_reg * alpha_prev + ps;
  const float pmax = rowmax32(p0, p1);
  if (__builtin_expect(__all(pmax <= THRL), 1)) { alpha = 1.f; }
  else { const float dlt = fmaxf(pmax, 0.f); alpha = __builtin_amdgcn_exp2f(-dlt); m_reg += dlt;
#pragma unroll
    for (int r = 0; r < 16; ++r) { negm[r] -= dlt; p0[r] -= dlt; p1[r] -= dlt; } }
}
__device__ __forceinline__ void sm_exp_lo(f32x16& p0) {
#pragma unroll
  for (int r = 0; r < 8; ++r) p0[r] = __builtin_amdgcn_exp2f(p0[r]);
}
__device__ __forceinline__ void sm_exp_hi(f32x16& p0) {
#pragma unroll
  for (int r = 8; r < 16; ++r) p0[r] = __builtin_amdgcn_exp2f(p0[r]);
}
__device__ __forceinline__ int v_st(int k, int c) { return ((k >> 3) * 4 + (c >> 5)) * 512 + ((k & 7) * 32 + (c & 31)) * 2; }
__device__ __forceinline__ int v_rd_base(int lane) { return ((lane & 3) << 3) | (((lane >> 2) & 3) << 6) | (((lane >> 4) & 1) << 5) | (((lane >> 5) & 1) << 8); }
constexpr int v_rd_off(int d0, int ks, int half) { return d0 * 512 + ks * 4096 + half * 2048; }
template <int OFF> __device__ __forceinline__ s16x4 tr_read(int vb) {
  s16x4 r; asm volatile("ds_read_b64_tr_b16 %0, %1 offset:%2" : "=&v"(r) : "v"(vb), "i"(OFF) : "memory"); return r;
}
template <int D0> __device__ __forceinline__ void pv_one(f32x16& od, int vb, bf16x8 pa0, bf16x8 pa1, bf16x8 pa2, bf16x8 pa3) {
  const s16x4 l0 = tr_read<v_rd_off(D0, 0, 0)>(vb), h0 = tr_read<v_rd_off(D0, 0, 1)>(vb), l1 = tr_read<v_rd_off(D0, 1, 0)>(vb), h1 = tr_read<v_rd_off(D0, 1, 1)>(vb);
  const s16x4 l2 = tr_read<v_rd_off(D0, 2, 0)>(vb), h2 = tr_read<v_rd_off(D0, 2, 1)>(vb), l3 = tr_read<v_rd_off(D0, 3, 0)>(vb), h3 = tr_read<v_rd_off(D0, 3, 1)>(vb);
  asm volatile("s_waitcnt lgkmcnt(0)" ::: "memory"); SBAR();
#define PK(L, H) (bf16x8){L[0], L[1], L[2], L[3], H[0], H[1], H[2], H[3]}
  od = __builtin_amdgcn_mfma_f32_32x32x16_bf16(pa0, PK(l0, h0), od, 0, 0, 0);
  od = __builtin_amdgcn_mfma_f32_32x32x16_bf16(pa1, PK(l1, h1), od, 0, 0, 0);
  od = __builtin_amdgcn_mfma_f32_32x32x16_bf16(pa2, PK(l2, h2), od, 0, 0, 0);
  od = __builtin_amdgcn_mfma_f32_32x32x16_bf16(pa3, PK(l3, h3), od, 0, 0, 0);
#undef PK
}
__device__ __forceinline__ void pv_d0(f32x16* o, int vb, bf16x8 pa0, bf16x8 pa1, bf16x8 pa2, bf16x8 pa3) {
  pv_one<0>(o[0], vb, pa0, pa1, pa2, pa3); pv_one<1>(o[1], vb, pa0, pa1, pa2, pa3); pv_one<2>(o[2], vb, pa0, pa1, pa2, pa3); pv_one<3>(o[3], vb, pa0, pa1, pa2, pa3);
}
struct VFrag { s16x4 l0, h0, l1, h1, l2, h2, l3, h3; };
template <int D0> __device__ __forceinline__ void pv_rd(VFrag& f, int vb) {
  f.l0 = tr_read<v_rd_off(D0, 0, 0)>(vb); f.h0 = tr_read<v_rd_off(D0, 0, 1)>(vb); f.l1 = tr_read<v_rd_off(D0, 1, 0)>(vb); f.h1 = tr_read<v_rd_off(D0, 1, 1)>(vb);
  f.l2 = tr_read<v_rd_off(D0, 2, 0)>(vb); f.h2 = tr_read<v_rd_off(D0, 2, 1)>(vb); f.l3 = tr_read<v_rd_off(D0, 3, 0)>(vb); f.h3 = tr_read<v_rd_off(D0, 3, 1)>(vb);
}
__device__ __forceinline__ void pv_mm(f32x16& od, const VFrag& f, bf16x8 pa0, bf16x8 pa1, bf16x8 pa2, bf16x8 pa3) {
  asm volatile("s_waitcnt lgkmcnt(0)" ::: "memory"); SBAR();
#define PK(L, H) (bf16x8){L[0], L[1], L[2], L[3], H[0], H[1], H[2], H[3]}
  od = __builtin_amdgcn_mfma_f32_32x32x16_bf16(pa0, PK(f.l0, f.h0), od, 0, 0, 0);
  od = __builtin_amdgcn_mfma_f32_32x32x16_bf16(pa1, PK(f.l1, f.h1), od, 0, 0, 0);
  od = __builtin_amdgcn_mfma_f32_32x32x16_bf16(pa2, PK(f.l2, f.h2), od, 0, 0, 0);
  od = __builtin_amdgcn_mfma_f32_32x32x16_bf16(pa3, PK(f.l3, f.h3), od, 0, 0, 0);
#undef PK
}
__device__ __forceinline__ void na_fix(f32x16& p0, f32x16& p1, int kr, int qr_, int rs, int qc, int cs, int hi, const float* rpbS) {
  const float NEG = -__builtin_inff();
  if (kr < rs || kr >= rs + 8) {
#pragma unroll
    for (int r = 0; r < 16; ++r) { p0[r] = NEG; p1[r] = NEG; }
  } else {
    const float* brow = rpbS + (kr - qr_ + 7) * 31 + (15 - qc);
#pragma unroll
    for (int g = 0; g < 4; ++g) {
#pragma unroll
      for (int q = 0; q < 4; ++q) { const int r = 4 * g + q;
        const int k0 = crow(r, hi), k1 = 32 + k0;
        const bool v0 = (unsigned)(k0 - cs) < 16u, v1 = (unsigned)(k1 - cs) < 16u;
        const float b0 = brow[v0 ? k0 : qc], b1 = brow[v1 ? k1 : qc];
        p0[r] = (p0[r] + b0) + (v0 ? 0.f : NEG); p1[r] = (p1[r] + b1) + (v1 ? 0.f : NEG);
      }
      SBAR();
    }
  }
}

template <int MODE>
__device__ __forceinline__ void attn_core(const bf16* __restrict__ Qw, const bf16* __restrict__ Kh, const bf16* __restrict__ Vh, const int NT, char* lds, const int kcb,
                                          const int, const int, const int, const int, const int, f32x16 (&o)[4], float& l_reg) {
  constexpr int ND0 = Cfg<MODE>::ND0;
  int tid_ = threadIdx.x; asm volatile("" : "+v"(tid_));
  const int tid = tid_, wid = __builtin_amdgcn_readfirstlane(tid >> 6), lane = tid & 63, r32 = lane & 31, hi = lane >> 5, half = wid >> 2, ht = tid & 255;
  bf16* V_lds = (bf16*)lds; bf16* K_lds = (bf16*)(lds + 2 * SHM_V);
  float* ws = (float*)(lds + OFF_WS) + wid * 64; float* al_l = ws + 32;
  float m_reg = 0.f; l_reg = 0.f; f32x16 negm = f32x16{};
#pragma unroll
  for (int d = 0; d < 4; ++d) o[d] = f32x16{};
  bf16x8 qr[ND0];
#pragma unroll
  for (int d0 = 0; d0 < ND0; ++d0) qr[d0] = ld8(Qw + d0 * 16);
  const int vb0 = (int)(uintptr_t)V_lds + v_rd_base(lane);
  {
    const int sr = tid >> 4, sc = (tid & 15) * 8;
    const bf16x8 v0 = ld8(&Vh[(long)sr * LDP + sc]), v1 = ld8(&Vh[(long)(32 + sr) * LDP + sc]), k0 = ld8(&Kh[(long)sr * LDP + sc]), k1 = ld8(&Kh[(long)(32 + sr) * LDP + sc]);
    *(bf16x8*)((char*)V_lds + v_st(sr, sc)) = v0; *(bf16x8*)((char*)V_lds + v_st(32 + sr, sc)) = v1;
    *(bf16x8*)((char*)K_lds + KSWZ(sr, sc * 2)) = k0; *(bf16x8*)((char*)K_lds + KSWZ(32 + sr, sc * 2)) = k1; }
  const int hr = ht >> 4, hc = (ht & 15) * 8;
  const bf16* Sg = (half == 0 ? Kh : Vh) + (long)hr * LDP + hc;
  char* Sl = half == 0 ? (char*)K_lds : (char*)V_lds;
  int soff[4];
#pragma unroll
  for (int i = 0; i < 4; ++i) soff[i] = half == 0 ? KSWZ(hr + 16 * i, hc * 2) : v_st(hr + 16 * i, hc);
  bf16x8 st[4];
#define HLOAD(t) do { _Pragma("unroll") for (int i = 0; i < 4; ++i) st[i] = ld8(Sg + (long)((t) * 64 + 16 * i) * LDP); } while (0)
#define HWRITE(b) do { _Pragma("unroll") for (int i = 0; i < 4; ++i) *(bf16x8*)(Sl + (b) * SHM_V + soff[i]) = st[i]; } while (0)
#define BAR_P() do { asm volatile("" : "+v"(p0), "+v"(p1)); SBAR(); asm volatile("s_waitcnt lgkmcnt(0)\n\ts_barrier" ::: "memory"); SBAR(); } while (0)
#define BAR_A() do { asm volatile("" : "+v"(pa0), "+v"(pa1), "+v"(pa2), "+v"(pa3)); SBAR(); asm volatile("s_waitcnt lgkmcnt(0)\n\ts_barrier" ::: "memory"); SBAR(); } while (0)
  f32x16 p0 = f32x16{}, p1 = f32x16{}; bf16x8 pa0, pa1, pa2, pa3; float alpha;
#define VSEG(FIRST) do { alpha = 1.f; const float pmax_ = rowmax32(p0, p1); \
    if (FIRST) { m_reg = pmax_; _Pragma("unroll") for (int r = 0; r < 16; ++r) { negm[r] = -pmax_; p0[r] -= pmax_; p1[r] -= pmax_; } } \
    else if (!__builtin_expect(__all(pmax_ <= THRL), 1)) { const float dlt_ = fmaxf(pmax_, 0.f); alpha = __builtin_amdgcn_exp2f(-dlt_); m_reg += dlt_; \
      _Pragma("unroll") for (int r = 0; r < 16; ++r) { negm[r] -= dlt_; p0[r] -= dlt_; p1[r] -= dlt_; } \
      if (hi == 0) al_l[r32] = alpha; asm volatile("s_waitcnt lgkmcnt(0)" ::: "memory"); \
      _Pragma("unroll") for (int d = 0; d < 4; ++d) _Pragma("unroll") for (int r = 0; r < 16; ++r) o[d][r] *= al_l[crow(r, hi)]; } \
    sm_exp0(p0); finishSM(p0, p1, alpha, l_reg, pa0, pa1, pa2, pa3); } while (0)
  __syncthreads();
  HLOAD(1);
  if (half == 1) BAR_P();
  qkt<ND0>(p0, p1, K_lds, qr, r32, hi, kcb);
  BAR_P();
  VSEG(true); HWRITE(1); HLOAD(2); BAR_A();
  pv_d0(o, vb0, pa0, pa1, pa2, pa3); qkt_c<ND0>(p0, p1, (bf16*)((char*)K_lds + SHM_K), qr, r32, hi, kcb, negm); BAR_P();
#pragma unroll 1
  for (int j = 1; j + 1 < NT; j += 2) {
    VSEG(false); HWRITE(0); HLOAD(j + 2); BAR_A();
    pv_d0(o, vb0 + SHM_V, pa0, pa1, pa2, pa3); qkt_c<ND0>(p0, p1, K_lds, qr, r32, hi, kcb, negm); BAR_P();
    VSEG(false); HWRITE(1); if (j + 3 < NT) HLOAD(j + 3); BAR_A();
    pv_d0(o, vb0, pa0, pa1, pa2, pa3); qkt_c<ND0>(p0, p1, (bf16*)((char*)K_lds + SHM_K), qr, r32, hi, kcb, negm); BAR_P();
  }
  VSEG(false); BAR_A();
  pv_d0(o, vb0 + SHM_V, pa0, pa1, pa2, pa3); BAR_P();
  if (half == 0) BAR_P();
#undef VSEG
#undef HLOAD
#undef HWRITE
#undef BAR_P
#undef BAR_A
}
__device__ __forceinline__ float half_sum32(float v) {
#pragma unroll
  for (int o = 1; o < 32; o <<= 1) v += __shfl_xor(v, o);
  return v;
}
__device__ __forceinline__ void diff_unit(const bf16* __restrict__ proj, bf16* __restrict__ mix, int h, int q0, float lam, float oml, const float* __restrict__ subg, char* lds) {
  int tid_ = threadIdx.x; asm volatile("" : "+v"(tid_));
  const int tid = tid_, wid = tid >> 6, lane = tid & 63, r32 = lane & 31, hi = lane >> 5, map = wid >> 2, wq = wid & 3;
  const bf16* Qw = proj + (size_t)(q0 + wq * 32 + r32) * LDP + h * 128 + map * 64 + hi * 8;
  f32x16 o[4]; float l_reg;
  attn_core<0>(Qw, proj + 1024 + h * 128, proj + 2048 + h * 128, 8192 / 64, lds, map * 128, 0, 0, 0, 0, 0, o, l_reg);
  float* ws = (float*)(lds + OFF_WS) + wid * 64;
  if (hi == 0) ws[r32] = l_reg;
  asm volatile("s_waitcnt lgkmcnt(0)" ::: "memory");
  float rli[16];
#pragma unroll
  for (int r = 0; r < 16; ++r) rli[r] = __builtin_amdgcn_rcpf(ws[crow(r, hi)]);
  __syncthreads();
  float* X = (float*)lds + (wq * 64) * 64 + lane;
  if (map == 1) {
#pragma unroll
    for (int d = 0; d < 4; ++d)
#pragma unroll
      for (int r = 0; r < 16; ++r) X[(d * 16 + r) * 64] = o[d][r] * rli[r];
  }
  __syncthreads();
  if (map == 0) {
    float gv[4];
#pragma unroll
    for (int d = 0; d < 4; ++d) gv[d] = subg[32 * d + r32] * oml;
    bf16* Ow = mix + (size_t)(q0 + wq * 32) * 2048 + 1024 + h * 128 + r32;
#pragma unroll
    for (int r = 0; r < 16; ++r) {
      float dv[4]; float sq = 0.f;
#pragma unroll
      for (int d = 0; d < 4; ++d) { dv[d] = o[d][r] * rli[r] - lam * X[(d * 16 + r) * 64]; sq += dv[d] * dv[d]; }
      sq = half_sum32(sq);
      const float rn = rsqrtf(sq * (1.0f / 128.0f) + 1e-6f);
      bf16* orow = Ow + (size_t)crow(r, hi) * 2048;
#pragma unroll
      for (int d = 0; d < 4; ++d) orow[32 * d] = (bf16)(cvtpk(dv[d] * rn * gv[d], 0.f) & 0xffffu);
    }
  }
  __syncthreads();
}
__device__ __forceinline__ void attn_na_core(const bf16* __restrict__ Qw, const bf16* __restrict__ Kh, const bf16* __restrict__ Vh, const int NT, char* lds,
                                             const int na_qr, const int na_rs, const int na_qc, const int na_cs, const int na_k0, f32x16 (&o)[4], float& l_reg) {
  int tid_ = threadIdx.x; asm volatile("" : "+v"(tid_));
  const int tid = tid_, wid = tid >> 6, lane = tid & 63, r32 = lane & 31, hi = lane >> 5;
  bf16* V_lds = (bf16*)lds; bf16* K_lds = (bf16*)(lds + 2 * SHM_V);
  float* ws = (float*)(lds + OFF_WS) + wid * 64; float* al_l = ws + 32;
  const float* rpbS = (const float*)(lds + OFF_RPB);
  float m_reg = -1e30f; l_reg = 0.f;
#pragma unroll
  for (int d = 0; d < 4; ++d) o[d] = f32x16{};
  bf16x8 qr[8];
#pragma unroll
  for (int d0 = 0; d0 < 8; ++d0) qr[d0] = ld8(Qw + d0 * 16);
  const int sr = tid >> 4, sc = (tid & 15) * 8, vst0 = v_st(sr, sc), vst1 = v_st(32 + sr, sc);
  const int vb0 = (int)(uintptr_t)V_lds + v_rd_base(lane);
  bf16x8 vs0, vs1, ks0, ks1;
#define SLOAD(k0) do { vs0 = ld8(&Vh[(long)((k0) + sr) * LDP + sc]); vs1 = ld8(&Vh[(long)((k0) + 32 + sr) * LDP + sc]); \
    ks0 = ld8(&Kh[(long)((k0) + sr) * LDP + sc]); ks1 = ld8(&Kh[(long)((k0) + 32 + sr) * LDP + sc]); } while (0)
  SLOAD(0);
#pragma unroll 1
  for (int j = 0; j < NT; ++j) {
    __syncthreads();
    *(bf16x8*)((char*)V_lds + vst0) = vs0; *(bf16x8*)((char*)V_lds + vst1) = vs1;
    *(bf16x8*)((char*)K_lds + KSWZ(sr, sc * 2)) = ks0; *(bf16x8*)((char*)K_lds + KSWZ(32 + sr, sc * 2)) = ks1;
    if (j + 1 < NT) SLOAD((j + 1) * 64);
    __syncthreads();
    const int kr = na_k0 + j;
    if (kr >= na_rs && kr < na_rs + 8) {
      f32x16 p0, p1; float mn, al; bf16x8 pa0, pa1, pa2, pa3;
      qkt<8>(p0, p1, K_lds, qr, r32, hi, 0);
      na_fix(p0, p1, kr, na_qr, na_rs, na_qc, na_cs, hi, rpbS);
      partialSM<1>(p0, p1, m_reg, mn, al);
      if (__any(al < 1.f)) { if (hi == 0) al_l[r32] = al; asm volatile("s_waitcnt lgkmcnt(0)" ::: "memory");
#pragma unroll
        for (int d = 0; d < 4; ++d)
#pragma unroll
          for (int r = 0; r < 16; ++r) o[d][r] *= al_l[crow(r, hi)]; }
      finishSM(p0, p1, al, l_reg, pa0, pa1, pa2, pa3); SBAR();
      pv_d0(o, vb0, pa0, pa1, pa2, pa3);
    }
  }
#undef SLOAD
}
__device__ __forceinline__ void na_unit(const bf16* __restrict__ proj, bf16* __restrict__ mix, float* __restrict__ nass, int h, int rb, const float* __restrict__ rpb_h, char* lds) {
  int tid_ = threadIdx.x; asm volatile("" : "+v"(tid_));
  const int tid = tid_, wid = tid >> 6, lane = tid & 63, r32 = lane & 31, hi = lane >> 5;
  float* rpbS = (float*)(lds + OFF_RPB);
  if (tid < 15 * 31) rpbS[tid] = rpb_h[tid] * 11.313708498984761f;
  const int q0 = rb * 256; int k0row = rb * 4 - 4; k0row = k0row < 0 ? 0 : (k0row > 116 ? 116 : k0row);
  const int qr_ = rb * 4 + (wid >> 1), qc = (wid & 1) * 32 + r32;
  int rs = qr_ - 4; rs = rs < 0 ? 0 : (rs > 120 ? 120 : rs);
  int cs = qc - 8; cs = cs < 0 ? 0 : (cs > 48 ? 48 : cs);
  const bf16* Qw = proj + (size_t)(q0 + wid * 32 + r32) * LDP + 3072 + h * 128 + hi * 8;
  const bf16* Kh = proj + (size_t)k0row * 64 * LDP + 4096 + h * 128;
  const bf16* Vh = proj + (size_t)k0row * 64 * LDP + 5120 + h * 128;
  f32x16 o[4]; float l_reg;
  attn_na_core(Qw, Kh, Vh, 12, lds, qr_, rs, qc, cs, k0row, o, l_reg);
  int t2 = threadIdx.x; asm volatile("" : "+v"(t2));
  const int wid2 = t2 >> 6, r32b = t2 & 31, hib = (t2 >> 5) & 1;
  float* ws = (float*)(lds + OFF_WS) + wid2 * 64;
  if (hib == 0) ws[r32b] = l_reg;
  asm volatile("s_waitcnt lgkmcnt(0)" ::: "memory");
  bf16* Ow = mix + (size_t)(rb * 256 + wid2 * 32) * 2048 + h * 128 + r32b;
  float* nrow = nass + (size_t)(rb * 256 + wid2 * 32) * 8 + h;
#pragma unroll
  for (int r = 0; r < 16; ++r) {
    const float rl = __builtin_amdgcn_rcpf(ws[crow(r, hib)]);
    bf16* orow = Ow + (size_t)crow(r, hib) * 2048; float sq = 0.f;
#pragma unroll
    for (int d = 0; d < 4; ++d) { const float v = o[d][r] * rl; sq += v * v; orow[32 * d] = (bf16)(cvtpk(v, 0.f) & 0xffffu); }
    sq = half_sum32(sq);
    if (r32b == 0) nrow[(size_t)crow(r, hib) * 8] = sq;
  }
  __syncthreads();
}
#undef KSWZ
#undef SBAR
}
#define LAS __attribute__((address_space(3)))
typedef unsigned short bf16_t;
typedef unsigned v4u __attribute__((ext_vector_type(4)));
typedef unsigned v2u __attribute__((ext_vector_type(2)));
typedef float v4f __attribute__((ext_vector_type(4)));
#define XB_TMO      128
#define XB_XCNT(j)  (256  + 64 * (j))
#define XB_XSUB(j)  (1280 + 64 * (j))
#define XB_XGEN(j)  (2304 + 64 * (j))
#define XB_TOP      3328
#define XB_TOPGEN   3392
#define XCD_BAR_WORDS 3456
#define XB_SPIN_CAP (1u << 18)

__device__ __forceinline__ unsigned xb_ld(unsigned* p)              { return __hip_atomic_load(p, __ATOMIC_RELAXED, __HIP_MEMORY_SCOPE_AGENT); }
__device__ __forceinline__ unsigned xb_add(unsigned* p, unsigned v) { return __hip_atomic_fetch_add(p, v, __ATOMIC_RELAXED, __HIP_MEMORY_SCOPE_AGENT); }
__device__ __forceinline__ unsigned xb_xcc_id() { return (unsigned)__builtin_amdgcn_s_getreg((3 << 11) | 20) & 0xFu; }
#define XB_SPIN(cond, bar) do { unsigned _sp = 0; while (cond) { __builtin_amdgcn_s_sleep(1); \
    if ((++_sp & 255u) == 0u) { if (xb_ld(&(bar)[XB_TMO])) break; if (_sp > XB_SPIN_CAP) { atomicAdd(&(bar)[XB_TMO], 1u); break; } } } } while (0)

struct XcdBarrier {
    unsigned* bar; unsigned x;
    volatile LAS unsigned* st;
};

__device__ __forceinline__ XcdBarrier xcd_barrier_post(unsigned* bar, volatile LAS unsigned* st) {
    XcdBarrier b; b.bar = bar; b.x = xb_xcc_id(); b.st = st;
    if (threadIdx.x == 0) (void)xb_add(&bar[XB_XCNT(b.x)], 1u);
    return b;
}
__device__ __forceinline__ void xcd_barrier_complete(unsigned* bar, unsigned x, unsigned& nloc, unsigned& nx) {
    const unsigned G = gridDim.x * gridDim.y * gridDim.z;
    unsigned sum, cnt, mine, sp = 0u;
    for (;;) {
        sum = 0u; cnt = 0u; mine = 0u;
#pragma unroll
        for (unsigned j = 0; j < 16; ++j) { const unsigned c = xb_ld(&bar[XB_XCNT(j)]); sum += c; cnt += (c > 0u) ? 1u : 0u; mine = (j == x) ? c : mine; }
        if (sum == G) break;
        __builtin_amdgcn_s_sleep(1);
        if ((++sp & 255u) == 0u) { if (xb_ld(&bar[XB_TMO])) break; if (sp > XB_SPIN_CAP) { atomicAdd(&bar[XB_TMO], 1u); break; } }
    }
    nloc = mine > 0u ? mine : 1u; nx = cnt > 0u ? cnt : 1u;
}

__device__ __forceinline__ void xcd_barrier(const XcdBarrier& b) {
    asm volatile("s_waitcnt vmcnt(0)" ::: "memory");
    __syncthreads();
    if (threadIdx.x == 0) {
        unsigned* bar = b.bar;
        __builtin_amdgcn_s_waitcnt(0);
        unsigned nloc = b.st[0], nx = b.st[1];
        if (nloc == 0u) { xcd_barrier_complete(bar, b.x, nloc, nx); b.st[0] = nloc; b.st[1] = nx; }
        const unsigned old = xb_add(&bar[XB_XSUB(b.x)], 1u);
        const unsigned gen = old / nloc;
        if (old + 1u == (gen + 1u) * nloc) {
            __builtin_amdgcn_fence(__ATOMIC_RELEASE, "agent");
            asm volatile("s_waitcnt vmcnt(0)" ::: "memory");
            const unsigned og = xb_add(&bar[XB_TOP], 1u);
            const unsigned tg = og / nx;
            if (og + 1u == (tg + 1u) * nx) xb_add(&bar[XB_TOPGEN], 1u);
            else XB_SPIN(xb_ld(&bar[XB_TOPGEN]) == tg, bar);
            __builtin_amdgcn_fence(__ATOMIC_ACQUIRE, "agent");
            xb_add(&bar[XB_XGEN(b.x)], 1u);
            asm volatile("s_waitcnt vmcnt(0)" ::: "memory");
        } else {
            XB_SPIN(xb_ld(&bar[XB_XGEN(b.x)]) == gen, bar);
            __builtin_amdgcn_fence(__ATOMIC_ACQUIRE, "agent");
            asm volatile("s_waitcnt vmcnt(0)" ::: "memory");
        }
    }
    __syncthreads();
}

constexpr int SEQ = 8192, DM = 2048, INC = 6144, FF = 8192, DEPTH = 4, NTHR = 512;
constexpr size_t SZ_WIN = (size_t)INC * DM * 2, SZ_WOUT = (size_t)DM * DM * 2, SZ_WMI = (size_t)FF * DM * 2, SZ_WMO = (size_t)DM * FF * 2;
constexpr size_t WS_WIN = 0, WS_WOUT = WS_WIN + DEPTH * SZ_WIN, WS_WMI = WS_WOUT + DEPTH * SZ_WOUT, WS_WMO = WS_WMI + DEPTH * SZ_WMI;
constexpr size_t WS_X = WS_WMO + DEPTH * SZ_WMO, WS_XB = WS_X + (size_t)SEQ * DM * 4, WS_PROJ = WS_XB + (size_t)SEQ * DM * 2, WS_MIX = WS_PROJ + (size_t)SEQ * INC * 2;
constexpr size_t WS_U = WS_MIX + (size_t)SEQ * DM * 2, WS_SS = WS_U + (size_t)SEQ * FF * 2, WS_COS = WS_SS + 9 * (size_t)SEQ * 32 * 4, WS_SIN = WS_COS + (size_t)SEQ * 32 * 4;
constexpr size_t WS_LAM = WS_SIN + (size_t)SEQ * 32 * 4, WS_BAR = WS_LAM + 256, WS_NASS = WS_BAR + 16384, WS_END = WS_NASS + (size_t)SEQ * 8 * 4;
#ifndef REP_P0
#define REP_P0 1
#endif
#ifndef REP_P1
#define REP_P1 1
#endif
#ifndef REP_P2
#define REP_P2 1
#endif
#ifndef REP_P3
#define REP_P3 1
#endif
#ifndef REP_P4
#define REP_P4 1
#endif
#ifndef REP_P6
#define REP_P6 1
#endif
#ifndef REP_P5
#define REP_P5 1
#endif
constexpr int LDS_BYTES = 139264;
static_assert(att::ATT_LDS <= LDS_BYTES && pg8::STAGE_BYTES <= LDS_BYTES, "LDS map");

struct Args {
    const float* in[15]; float* out; unsigned char* ws;
    double invf[32];
    float lam_init[4]; int pad[2];
};

__device__ __forceinline__ float wave_sum(float v) {
#pragma unroll
    for (int o = 1; o < 64; o <<= 1) v += __shfl_xor(v, o);
    return v;
}
__device__ __forceinline__ unsigned pk2(float lo, float hi) { return pg8::cvt_pk_bf16(lo, hi); }

struct TpItem { const float* W; bf16_t* WT; const float* gv; int K, N, k0, n0, krot; bool perm; };
__device__ __forceinline__ void tp_load(const TpItem& d, int lane, float (&w)[32]) {
    const float* wp = d.W + (size_t)(d.k0 + (lane >> 5)) * d.N + d.n0 + (lane & 31);
#pragma unroll
    for (int i = 0; i < 32; ++i) w[i] = wp[(size_t)(2 * i) * d.N];
}
__device__ __forceinline__ void tp_store(const TpItem& d, int lane, const float (&w)[32], LAS float* scr) {
    const int c = lane & 7;
    v4f g0 = {1.f, 1.f, 1.f, 1.f}, g1 = {1.f, 1.f, 1.f, 1.f};
    if (d.gv) { g0 = *(const v4f*)(d.gv + d.k0 + 8 * c); g1 = *(const v4f*)(d.gv + d.k0 + 8 * c + 4); }
#pragma unroll
    for (int i = 0; i < 32; ++i) scr[(2 * i + (lane >> 5)) * 33 + (lane & 31)] = w[i];
    asm volatile("s_waitcnt lgkmcnt(0)" ::: "memory");
#pragma unroll
    for (int j = 0; j < 4; ++j) { const int n = (lane >> 3) + 8 * j; const LAS float* s = scr + (8 * c) * 33 + n;
        v4u o; o.x = pk2(s[0 * 33] * g0.x, s[1 * 33] * g0.y); o.y = pk2(s[2 * 33] * g0.z, s[3 * 33] * g0.w); o.z = pk2(s[4 * 33] * g1.x, s[5 * 33] * g1.y); o.w = pk2(s[6 * 33] * g1.z, s[7 * 33] * g1.w);
        const int no = d.n0 + n; int dst = no;
        if (d.perm && no < 2048) { const int q = no & 63; dst = (no & ~63) + 8 * ((q & 31) >> 2) + 4 * (q >> 5) + (q & 3); }
        *(v4u*)(d.WT + (size_t)dst * d.K + ((d.k0 + d.krot) & (d.K - 1)) + 8 * c) = o; }
    asm volatile("s_waitcnt lgkmcnt(0)" ::: "memory");
}

__global__ void __launch_bounds__(NTHR, 2) fwd_megakernel(Args a) {
    extern __shared__ __attribute__((aligned(16))) unsigned char lds[];
    cg::grid_group grid = cg::this_grid();
#define GRID_SYNC() do { asm volatile("s_waitcnt vmcnt(0) lgkmcnt(0)" ::: "memory"); grid.sync(); __builtin_amdgcn_fence(__ATOMIC_ACQUIRE, "agent"); asm volatile("s_waitcnt vmcnt(0)" ::: "memory"); } while (0)
    const int tid = threadIdx.x, lane = tid & 63, wave = __builtin_amdgcn_readfirstlane(tid >> 6);
    const int G = gridDim.x, bx = blockIdx.x;
    const int gw = bx * 8 + wave, NGW = G * 8;
    unsigned char* ws = a.ws;
    bf16_t* WinT = (bf16_t*)(ws + WS_WIN); bf16_t* WoutT = (bf16_t*)(ws + WS_WOUT); bf16_t* WmiT = (bf16_t*)(ws + WS_WMI); bf16_t* WmoT = (bf16_t*)(ws + WS_WMO);
    float* X = (float*)(ws + WS_X); bf16_t* XB = (bf16_t*)(ws + WS_XB); bf16_t* PROJ = (bf16_t*)(ws + WS_PROJ); bf16_t* MIX = (bf16_t*)(ws + WS_MIX); bf16_t* U = (bf16_t*)(ws + WS_U);
    float* SS = (float*)(ws + WS_SS); float* COS = (float*)(ws + WS_COS); float* SIN = (float*)(ws + WS_SIN); float* LAM = (float*)(ws + WS_LAM); float* NASS = (float*)(ws + WS_NASS);
    LAS unsigned char* ldsl = (LAS unsigned char*)lds;
    volatile LAS unsigned* bst = (volatile LAS unsigned*)(ldsl + 135168);
    if (tid < 2) bst[tid] = 0u;
    __syncthreads();
    const XcdBarrier xbar = xcd_barrier_post((unsigned*)(ws + WS_BAR), bst);

    for (int rep = 0; rep < REP_P0; ++rep) {
        LAS float* scr = (LAS float*)(ldsl + wave * 16384);
        constexpr int I_IN = (DM / 64) * (INC / 32), I_OUT = (DM / 64) * (DM / 32), I_MI = (DM / 64) * (FF / 32), I_MO = (FF / 64) * (DM / 32), I_L = I_IN + I_OUT + I_MI + I_MO;
        auto mk = [&](int it) {
            TpItem d; const int l = it / I_L; int r = it % I_L; d.gv = nullptr; d.perm = false; d.krot = 0;
            if (r < I_IN) { d.W = a.in[2] + (size_t)l * DM * INC; d.K = DM; d.N = INC; d.WT = WinT + (size_t)l * INC * DM; d.gv = a.in[1] + l * DM; d.perm = true; }
            else if ((r -= I_IN) < I_OUT) {
                d.W = a.in[10] + (size_t)l * DM * DM; d.K = DM; d.N = DM; d.WT = WoutT + (size_t)l * DM * DM; d.krot = 1024; if (r / (DM / 32) >= 16) d.gv = a.in[8] + l * 1024 - 1024; }
            else if ((r -= I_OUT) < I_MI) { d.W = a.in[12] + (size_t)l * DM * FF; d.K = DM; d.N = FF; d.WT = WmiT + (size_t)l * FF * DM; d.gv = a.in[11] + l * DM; }
            else { r -= I_MI; d.W = a.in[13] + (size_t)l * FF * DM; d.K = FF; d.N = DM; d.WT = WmoT + (size_t)l * DM * FF; }
            const int nblk = d.N / 32; d.k0 = 64 * (r / nblk); d.n0 = 32 * (r % nblk);
            return d; };
        {
            constexpr int NIT = DEPTH * I_L; float wa[32], wb[32]; int it = gw;
            TpItem da = mk(it < NIT ? it : 0), db = da;
            if (it < NIT) tp_load(da, lane, wa);
            while (it < NIT) {
                const int itb = it + NGW; if (itb < NIT) { db = mk(itb); tp_load(db, lane, wb); }
                tp_store(da, lane, wa, scr);
                if (itb >= NIT) break;
                const int ita = itb + NGW; if (ita < NIT) { da = mk(ita); tp_load(da, lane, wa); }
                tp_store(db, lane, wb, scr);
                it = ita;
            }
        }
        for (int m = gw; m < SEQ; m += NGW) {
            const v4f* xr = (const v4f*)(a.in[0] + (size_t)m * DM) + lane; v2u* bo = (v2u*)(XB + (size_t)m * DM) + lane;
            float s = 0.f;
#pragma unroll
            for (int j = 0; j < 8; ++j) { const v4f v = xr[64 * j]; v2u w; w.x = pk2(v.x, v.y); w.y = pk2(v.z, v.w); bo[64 * j] = w; s += (v.x * v.x + v.y * v.y) + (v.z * v.z + v.w * v.w); }
            s = wave_sum(s);
            if (lane < 32) SS[(size_t)m * 32 + lane] = lane == 0 ? s : 0.f;
        }
        for (int i = bx * NTHR + tid; i < SEQ * 32; i += G * NTHR) {
            const int t = i >> 5, j = i & 31; double rev = (double)t * a.invf[j] * 0.15915494309189535; rev -= floor(rev);
            const float rf = (float)rev; COS[i] = __builtin_amdgcn_cosf(rf); SIN[i] = __builtin_amdgcn_sinf(rf);
        }
        if (bx == 0 && wave < DEPTH) {
            const int l = wave;
            const float p1 = wave_sum(a.in[3][l * 64 + lane] * a.in[4][l * 64 + lane]), p2 = wave_sum(a.in[5][l * 64 + lane] * a.in[6][l * 64 + lane]);
            if (lane == 0) LAM[l] = expf(p1) - expf(p2) + a.lam_init[l];
        }
    }
    GRID_SYNC();

#pragma unroll 1
    for (int l = 0; l < DEPTH; ++l) {
        const float* ss1 = SS + (size_t)(2 * l) * SEQ * 32; float* ss2 = SS + (size_t)(2 * l + 1) * SEQ * 32; float* ss3 = SS + (size_t)(2 * l + 2) * SEQ * 32;
        for (int rep = 0; rep < REP_P1; ++rep) {
            pg8::Gemm g{XB, WinT + (size_t)l * INC * DM, SEQ, INC, DM}; pg8::StaticOrder S; S.init(SEQ, INC, G, bx);
            pg8::EpiProj E{PROJ, ss1, COS, SIN};
            pg8::gemm_phase<pg8::EpiProj, pg8::StaticOrder, true, true>(ldsl, g, S, E);
        }
        xcd_barrier(xbar);
        {
            for (int rep = 0; rep < REP_P2; ++rep)
            for (int u = bx; u < 8 * 32; u += G) { const int h = u >> 5, rb = u & 31;
                att::na_unit(PROJ, MIX, NASS, h, rb, a.in[9] + ((size_t)l * 8 + h) * 15 * 31, (char*)lds); }
            const float lam = LAM[l], oml = 1.0f - a.lam_init[l];
            for (int rep = 0; rep < REP_P3; ++rep)
            for (int u = bx; u < 8 * 64; u += G) { const int h = u & 7, qb = u >> 3;
                att::diff_unit(PROJ, MIX, h, qb * 128, lam, oml, a.in[7] + l * 128, (char*)lds); }
        }
        xcd_barrier(xbar);
        for (int rep = 0; rep < REP_P4; ++rep) {
            pg8::Gemm g{MIX, WoutT + (size_t)l * DM * DM, SEQ, DM, DM}; pg8::StaticOrder S; S.init(SEQ, DM, G, bx);
            pg8::EpiResidMid E{(l == 0 && rep == 0) ? a.in[0] : (const float*)X, X, XB, ss2, (rep & 1) ? -1.f : 1.f, NASS};
            pg8::gemm_phase<pg8::EpiResidMid, pg8::StaticOrder, true, true>(ldsl, g, S, E);
        }
        xcd_barrier(xbar);
        for (int rep = 0; rep < REP_P5; ++rep) {
            pg8::Gemm g{XB, WmiT + (size_t)l * FF * DM, SEQ, FF, DM}; pg8::StaticOrder S; S.init(SEQ, FF, G, bx);
            pg8::EpiRelu2 E{U, ss2};
            pg8::gemm_phase<pg8::EpiRelu2, pg8::StaticOrder, true, true>(ldsl, g, S, E);
        }
        xcd_barrier(xbar);
        for (int rep = 0; rep < REP_P6; ++rep) {
            pg8::Gemm g{U, WmoT + (size_t)l * DM * FF, SEQ, DM, FF}; pg8::StaticOrder S; S.init(SEQ, DM, G, bx);
            pg8::EpiResid E{X, X, XB, ss3, (rep & 1) ? -1.f : 1.f, nullptr};
            pg8::gemm_phase<pg8::EpiResid, pg8::StaticOrder, true, true>(ldsl, g, S, E);
        }
        xcd_barrier(xbar);
    }
    {
        const float* fg = a.in[14]; const float* ssf = SS + (size_t)8 * SEQ * 32;
        int lnf = threadIdx.x; asm volatile("" : "+v"(lnf)); lnf &= 63;
        for (int m = gw; m < SEQ; m += NGW) {
            const float rn = rsqrtf(wave_sum(lnf < 32 ? ssf[(size_t)m * 32 + lnf] : 0.f) * (1.0f / 2048.0f) + 1e-6f);
            const v4f* xr = (const v4f*)(X + (size_t)m * DM) + lnf; v4f* xo = (v4f*)(a.out + (size_t)m * DM) + lnf; const v4f* gp = (const v4f*)fg + lnf;
#pragma unroll
            for (int j = 0; j < 8; ++j) xo[64 * j] = xr[64 * j] * rn * gp[64 * j];
        }
    }
}

extern "C" void kernel_launch(void* const* d_in, const int* in_sizes, int n_in, void* d_out, int out_size, void* d_ws, size_t ws_size, hipStream_t stream) {
    static int grid_blocks = 0;
    if (grid_blocks == 0) {
        if (n_in != 15 || out_size != SEQ * DM || ws_size < WS_END) { fprintf(stderr, "kernel_launch: unexpected shapes (n_in %d out %d ws %zu, need %zu)\n", n_in, out_size, ws_size, (size_t)WS_END); grid_blocks = -1; return; }
        int dev = 0, cus = 0, per_cu = 0;
        hipGetDevice(&dev); hipDeviceGetAttribute(&cus, hipDeviceAttributeMultiprocessorCount, dev);
        if (hipFuncSetAttribute((const void*)fwd_megakernel, hipFuncAttributeMaxDynamicSharedMemorySize, LDS_BYTES) != hipSuccess) { fprintf(stderr, "kernel_launch: hipFuncSetAttribute failed\n"); grid_blocks = -1; return; }
        if (hipOccupancyMaxActiveBlocksPerMultiprocessor(&per_cu, (const void*)fwd_megakernel, NTHR, LDS_BYTES) != hipSuccess || per_cu < 1) { fprintf(stderr, "kernel_launch: occupancy query gave %d\n", per_cu); per_cu = 1; (void)hipGetLastError(); }
        grid_blocks = cus * per_cu;
    }
    if (grid_blocks < 0) return;
    Args a{};
    for (int i = 0; i < 15; ++i) a.in[i] = (const float*)d_in[i];
    a.out = (float*)d_out; a.ws = (unsigned char*)d_ws;
    for (int j = 0; j < 32; ++j) a.invf[j] = 1.0 / pow(10000.0, (double)(2 * j) / 64.0);
    for (int l = 0; l < 4; ++l) a.lam_init[l] = (float)(0.8 - 0.6 * exp(-0.3 * l));
    if (hipMemsetAsync((char*)d_ws + WS_BAR, 0, XCD_BAR_WORDS * 4, stream) != hipSuccess) { fprintf(stderr, "kernel_launch: hipMemsetAsync of the barrier words failed\n"); return; }
    void* args[] = {&a};
    hipError_t e = hipLaunchCooperativeKernel((void*)fwd_megakernel, dim3(grid_blocks), dim3(NTHR), args, LDS_BYTES, stream);
    if (e != hipSuccess) fprintf(stderr, "cooperative launch failed: %s (grid %d)\n", hipGetErrorString(e), grid_blocks);
}
```

```cpp
#include <hip/hip_runtime.h>
#include <hip/hip_cooperative_groups.h>
#include <cstdio>
#include <cstdint>
namespace cg = cooperative_groups;
namespace pg8 {
#define PG8_LAS __attribute__((address_space(3)))
typedef unsigned short bf16_t;
typedef short bf16x8 __attribute__((ext_vector_type(8)));
typedef float f32x4 __attribute__((ext_vector_type(4)));
typedef unsigned u32x4 __attribute__((ext_vector_type(4)));
constexpr int BM = 256, BK = 64, HALF = 128, HTB = HALF * BK * 2  , STAGE_BYTES = 8 * HTB, NXCD = 8, WGM = 8;

__host__ __device__ __forceinline__ int lds_byte(int r, int c) { const int st = (r >> 4) * 2 + (c >> 5), rr = r & 15, cc = c & 31, ob = rr * 64 + cc * 2; return st * 1024 + (ob ^ (((ob >> 9) & 1) << 5)); }
__host__ __device__ __forceinline__ void stage_rc(int b, int& R, int& C) { const int st = b / 1024, sb = b % 1024, swz = sb ^ (((sb >> 9) & 1) << 5); R = (st >> 1) * 16 + swz / 64; C = (st & 1) * 32 + (swz % 64) / 2; }
__host__ __device__ __forceinline__ int perm32(int rho) { const int n = rho >> 4, i = rho & 15; return 8 * (i >> 2) + 4 * n + (i & 3); }

struct Unit { int pm, pn; };
struct Gemm { const bf16_t* A; const bf16_t* Bt; int M, N, K; };

struct StaticOrder {
    int nM, nN, nwg, G, c;
    __host__ __device__ void init(int M, int N, int G_, int c_) { nM = M / BM; nN = N / BM; nwg = nM * nN; G = G_; c = c_; }
    __host__ __device__ bool next(int i, Unit& u) const {
        const long L = (long)i * G + c; if (L >= nwg) return false;
        int wgid = (int)L; { const int q = nwg / NXCD, r = nwg % NXCD, xcd = wgid % NXCD, off = wgid / NXCD; wgid = (xcd < r ? xcd * (q + 1) : r * (q + 1) + (xcd - r) * q) + off; }
        const int nig = WGM * nN, gid = wgid / nig, fm = gid * WGM, gsz = (nM - fm) < WGM ? (nM - fm) : WGM;
        u.pm = fm + ((wgid % nig) % gsz); u.pn = (wgid % nig) / gsz; return true;
    }
    __device__ __forceinline__ void a_ready(const Unit&) const {}
    __device__ __forceinline__ void done(const Unit&) const {}
};

__device__ __forceinline__ unsigned cvt_pk_bf16(float lo, float hi) { unsigned r; asm volatile("v_cvt_pk_bf16_f32 %0, %1, %2" : "=v"(r) : "v"(lo), "v"(hi)); return r; }
typedef float f32x2 __attribute__((ext_vector_type(2)));
typedef unsigned u32x2 __attribute__((ext_vector_type(2)));
constexpr float RMS_EPS = 1e-6f;
__device__ __forceinline__ float row_rstd(const float* ss, int row, int fq) {
    const f32x4* sp = (const f32x4*)(ss + (size_t)row * 32 + fq * 8); const f32x4 a = sp[0], b = sp[1];
    float s = ((a[0] + a[1]) + (a[2] + a[3])) + ((b[0] + b[1]) + (b[2] + b[3]));
    s += __shfl_xor(s, 16); s += __shfl_xor(s, 32);
    return rsqrtf(s * (1.0f / 2048.0f) + RMS_EPS);
}
struct EpiProj {
    static constexpr bool PERM = true, AFTER_DRAIN = false, MIDK = false;
    bf16_t* O; const float* ss; const float* cosT; const float* sinT;
    __device__ __forceinline__ void operator()(const f32x4 (&acc)[2][2][4][2], const Unit& u, int wr, int wc, int fr, int fq) const {
        const int row0 = u.pm * BM + wr * 64 + fr; const int colt = u.pn * BM;
        const bool rope = colt < 2048;
        const float qs = colt < 1024 ? 0.125f * 1.4426950408889634f : 1.f;
        const int g = (wc & 1) * 4 + fq;
        const int pos0 = colt + wc * 32 + 8 * fq;
        const int rbase = colt + 64 * (wc >> 1) + 4 * g;
#pragma unroll
        for (int ai = 0; ai < 2; ++ai)
#pragma unroll
            for (int m = 0; m < 4; ++m) {
                const int row = row0 + ai * HALF + m * 16;
                const float rs = row_rstd(ss, row, fq) * qs;
                bf16_t* rowp = O + (size_t)row * 6144;
                if (rope) {
                    const f32x4 c4 = *(const f32x4*)(cosT + row * 32 + 4 * g), s4 = *(const f32x4*)(sinT + row * 32 + 4 * g);
#pragma unroll
                    for (int bj = 0; bj < 2; ++bj) {
                        const f32x4 v0 = acc[ai][bj][m][0] * rs, v1 = acc[ai][bj][m][1] * rs;
                        const f32x4 o1 = v0 * c4 - v1 * s4, o2 = v1 * c4 + v0 * s4;
                        u32x2 w1, w2; w1.x = cvt_pk_bf16(o1[0], o1[1]); w1.y = cvt_pk_bf16(o1[2], o1[3]); w2.x = cvt_pk_bf16(o2[0], o2[1]); w2.y = cvt_pk_bf16(o2[2], o2[3]);
                        *(u32x2*)(rowp + rbase + bj * HALF) = w1; *(u32x2*)(rowp + rbase + bj * HALF + 32) = w2;
                    }
                } else {
#pragma unroll
                    for (int bj = 0; bj < 2; ++bj) {
                        const f32x4 v0 = acc[ai][bj][m][0] * rs, v1 = acc[ai][bj][m][1] * rs;
                        u32x4 w; w.x = cvt_pk_bf16(v0[0], v0[1]); w.y = cvt_pk_bf16(v0[2], v0[3]); w.z = cvt_pk_bf16(v1[0], v1[1]); w.w = cvt_pk_bf16(v1[2], v1[3]);
                        *(u32x4*)(rowp + pos0 + bj * HALF) = w;
                    }
                }
            }
    }
};
struct EpiRelu2 {
    static constexpr bool PERM = true, AFTER_DRAIN = false, MIDK = false;
    bf16_t* O; const float* ss;
    __device__ __forceinline__ void operator()(const f32x4 (&acc)[2][2][4][2], const Unit& u, int wr, int wc, int fr, int fq) const {
        const int row0 = u.pm * BM + wr * 64 + fr; const int pos0 = u.pn * BM + wc * 32 + 8 * fq;
#pragma unroll
        for (int ai = 0; ai < 2; ++ai)
#pragma unroll
            for (int m = 0; m < 4; ++m) {
                const int row = row0 + ai * HALF + m * 16;
                const float rs = row_rstd(ss, row, fq);
                bf16_t* rowp = O + (size_t)row * 8192 + pos0;
#pragma unroll
                for (int bj = 0; bj < 2; ++bj) {
                    f32x4 v0 = acc[ai][bj][m][0] * rs, v1 = acc[ai][bj][m][1] * rs;
#pragma unroll
                    for (int e = 0; e < 4; ++e) { v0[e] = fmaxf(v0[e], 0.f); v1[e] = fmaxf(v1[e], 0.f); }
                    v0 = v0 * v0; v1 = v1 * v1;
                    u32x4 w; w.x = cvt_pk_bf16(v0[0], v0[1]); w.y = cvt_pk_bf16(v0[2], v0[3]); w.z = cvt_pk_bf16(v1[0], v1[1]); w.w = cvt_pk_bf16(v1[2], v1[3]);
                    *(u32x4*)(rowp + bj * HALF) = w;
                }
            }
    }
};
template <bool MID> struct EpiResidT {
    static constexpr bool PERM = false, AFTER_DRAIN = false, MIDK = MID;
    const float* Xin; float* X; bf16_t* XB; float* ssout; float sign; const float* nass;
    __device__ __forceinline__ void mid(f32x4 (&acc)[2][2][4][2], const Unit& u, int wr, int wc, int fr, int fq) const {
        int t_ = threadIdx.x; asm volatile("" : "+v"(t_));
        const int row0 = u.pm * BM + wr * 64 + (t_ & 15);
#pragma unroll
        for (int ai = 0; ai < 2; ++ai)
#pragma unroll
            for (int m = 0; m < 4; ++m) {
                const f32x4* sp = (const f32x4*)(nass + (size_t)(row0 + ai * HALF + m * 16) * 8); const f32x4 a = sp[0], b = sp[1];
                const float rn = rsqrtf((((a[0] + a[1]) + (a[2] + a[3])) + ((b[0] + b[1]) + (b[2] + b[3]))) * (1.0f / 1024.0f) + RMS_EPS);
#pragma unroll
                for (int bj = 0; bj < 2; ++bj)
#pragma unroll
                    for (int n = 0; n < 2; ++n) acc[ai][bj][m][n] = acc[ai][bj][m][n] * rn;
            }
    }
    __device__ __forceinline__ void operator()(const f32x4 (&acc)[2][2][4][2], const Unit& u, int wr, int wc, int fr, int fq) const {
        const int row0 = u.pm * BM + wr * 64 + fr; const int col0 = u.pn * BM + wc * 32 + 4 * fq;
#pragma unroll
        for (int ai = 0; ai < 2; ++ai)
#pragma unroll
            for (int m = 0; m < 4; ++m) {
                const int row = row0 + ai * HALF + m * 16; float sq = 0.f;
#pragma unroll
                for (int bj = 0; bj < 2; ++bj)
#pragma unroll
                    for (int n = 0; n < 2; ++n) {
                        const size_t off = (size_t)row * 2048 + col0 + bj * HALF + n * 16;
                        const f32x4 xv = *(const f32x4*)(Xin + off) + acc[ai][bj][m][n] * sign;
                        *(f32x4*)(X + off) = xv;
                        u32x2 w; w.x = cvt_pk_bf16(xv[0], xv[1]); w.y = cvt_pk_bf16(xv[2], xv[3]);
                        *(u32x2*)(XB + off) = w;
                        sq += (xv[0] * xv[0] + xv[1] * xv[1]) + (xv[2] * xv[2] + xv[3] * xv[3]);
                    }
                sq += __shfl_xor(sq, 16); sq += __shfl_xor(sq, 32);
                if (fq == 0) ssout[(size_t)row * 32 + u.pn * 4 + wc] = sq;
            }
    }
};
typedef EpiResidT<false> EpiResid; typedef EpiResidT<true> EpiResidMid;
template <class Epi, class Sched, bool ALIGN_EPI = false, bool SP2 = false>
__device__ __forceinline__ void gemm_phase(PG8_LAS unsigned char* lds, const Gemm g, const Sched& S, const Epi& E) {
    int tid_ = threadIdx.x; asm volatile("" : "+v"(tid_));
    const int tid = tid_, wid = __builtin_amdgcn_readfirstlane(tid >> 6), lane = tid & 63, wr = wid >> 2, wc = wid & 3, fr = lane & 15, fq = lane >> 4;
    const int K = g.K, nt = K / BK;
    unsigned voffA[2], voffB[2];
#pragma unroll
    for (int i = 0; i < 2; ++i) { int R, C; stage_rc(tid * 16 + i * 8192, R, C); const int Rb = Epi::PERM ? ((R & ~31) + perm32(R & 31)) : R;
        voffA[i] = (unsigned)(R * K + C) * 2u; voffB[i] = (unsigned)(Rb * K + C) * 2u; }
    const size_t kstep = (size_t)(BK * 2);
    const size_t hstep = (size_t)HALF * K * 2;
    const size_t tstep = 2 * hstep;
    const unsigned ldsw = (unsigned)wid * 1024u;
    const int aoff = lds_byte(wr * 64 + fr, fq * 8), boff = lds_byte(wc * 32 + fr, fq * 8);
#define PG8_SA(b, h) (((b) * 2 + (h)) * HTB)
#define PG8_SB(b, h) ((4 + (b) * 2 + (h)) * HTB)
#define PG8_STAGE(bufoff, gbase, voff) do { _Pragma("unroll") for (int _i = 0; _i < 2; ++_i) \
        __builtin_amdgcn_global_load_lds((const unsigned*)((const char*)(gbase) + (voff)[_i]), (PG8_LAS unsigned*)(lds + (bufoff) + ldsw + _i * 8192), 16, 0, 0); } while (0)
#define PG8_LDA(dst, b, h) do { _Pragma("unroll") for (int m = 0; m < 4; ++m) _Pragma("unroll") for (int k = 0; k < 2; ++k) dst[m][k] = *(const PG8_LAS bf16x8*)(lds + PG8_SA(b, h) + aoff + m * 2048 + k * 1024); } while (0)
#define PG8_LDB(dst, b, h) do { _Pragma("unroll") for (int n = 0; n < 2; ++n) _Pragma("unroll") for (int k = 0; k < 2; ++k) dst[n][k] = *(const PG8_LAS bf16x8*)(lds + PG8_SB(b, h) + boff + n * 2048 + k * 1024); } while (0)
#define PG8_MMA(ai, bj, At, Bt) do { __builtin_amdgcn_s_setprio(1); _Pragma("unroll") for (int m = 0; m < 4; ++m) _Pragma("unroll") for (int n = 0; n < 2; ++n) _Pragma("unroll") for (int k = 0; k < 2; ++k) \
        acc[ai][bj][m][n] = __builtin_amdgcn_mfma_f32_16x16x32_bf16(Bt[n][k], At[m][k], acc[ai][bj][m][n], 0, 0, 0); __builtin_amdgcn_s_setprio(0); } while (0)
#define PG8_WAIT_V(n) asm volatile("s_waitcnt vmcnt(" #n ")" ::: "memory")
#define PG8_WAIT_L(n) asm volatile("s_waitcnt lgkmcnt(" #n ")" ::: "memory")
#define PG8_BAR __builtin_amdgcn_s_barrier()
#define PG8_SCHED __builtin_amdgcn_sched_barrier(0)
    Unit cur, nxt; int ui = 0;
    if (!S.next(0, cur)) return;
    f32x4 acc[2][2][4][2];
#pragma unroll
    for (int a = 0; a < 2; ++a)
#pragma unroll
        for (int b = 0; b < 2; ++b)
#pragma unroll
            for (int m = 0; m < 4; ++m)
#pragma unroll
                for (int n = 0; n < 2; ++n) acc[a][b][m][n] = (f32x4){0.f, 0.f, 0.f, 0.f};
    bf16x8 At[4][2], B0[2][2], B1[2][2];
    const char* cA = (const char*)g.A + (size_t)cur.pm * tstep; const char* cB = (const char*)g.Bt + (size_t)cur.pn * tstep;
    S.a_ready(cur);
    if constexpr (SP2) {
        PG8_STAGE(PG8_SB(0, 0), cB, voffB); PG8_STAGE(PG8_SB(0, 1), cB + hstep, voffB); PG8_STAGE(PG8_SA(0, 0), cA, voffA); PG8_STAGE(PG8_SA(0, 1), cA + hstep, voffA);
        if (wr == 1) PG8_BAR;
        PG8_WAIT_V(2); PG8_BAR;
        PG8_STAGE(PG8_SB(1, 0), cB + kstep, voffB); PG8_STAGE(PG8_SA(1, 0), cA + kstep, voffA); PG8_STAGE(PG8_SB(1, 1), cB + hstep + kstep, voffB);
        PG8_WAIT_V(6); PG8_BAR;
    } else {
        PG8_STAGE(PG8_SB(0, 0), cB, voffB); PG8_STAGE(PG8_SA(0, 0), cA, voffA); PG8_STAGE(PG8_SB(0, 1), cB + hstep, voffB); PG8_STAGE(PG8_SA(0, 1), cA + hstep, voffA);
        if (wr == 1) PG8_BAR;
        PG8_WAIT_V(4); PG8_BAR;
        PG8_STAGE(PG8_SB(1, 0), cB + kstep, voffB); PG8_STAGE(PG8_SA(1, 0), cA + kstep, voffA); PG8_STAGE(PG8_SB(1, 1), cB + hstep + kstep, voffB);
        PG8_WAIT_V(6); PG8_BAR;
    }
    for (;;) {
        const bool has_next = S.next(ui + 1, nxt);
        const char* nA = has_next ? (const char*)g.A + (size_t)nxt.pm * tstep : cA; const char* nB = has_next ? (const char*)g.Bt + (size_t)nxt.pn * tstep : cB;
        for (int t = 0; t < nt; t += 2) {
            if constexpr (Epi::MIDK) { if (t == nt / 2) E.mid(acc, cur, wr, wc, fr, fq); }
            const bool last = (t == nt - 2);
            const char* a1 = cA + (size_t)(t + 1) * kstep;
            const char* a2 = last ? nA : cA + (size_t)(t + 2) * kstep; const char* b2 = last ? nB : cB + (size_t)(t + 2) * kstep;
            const char* a3 = a2 + kstep; const char* b3 = b2 + kstep;
            if (last && has_next) S.a_ready(nxt);
            if constexpr (SP2) {
            PG8_LDB(B0, 0, 0); PG8_LDB(B1, 0, 1); PG8_SCHED; PG8_LDA(At, 0, 0); PG8_STAGE(PG8_SA(1, 1), a1 + hstep, voffA);
            PG8_WAIT_V(8); PG8_WAIT_L(0); PG8_BAR; PG8_MMA(0, 0, At, B0); PG8_MMA(0, 1, At, B1); PG8_BAR; PG8_SCHED;
            PG8_LDA(At, 0, 1); PG8_STAGE(PG8_SB(0, 0), b2, voffB); PG8_STAGE(PG8_SB(0, 1), b2 + hstep, voffB); PG8_STAGE(PG8_SA(0, 0), a2, voffA);
            PG8_WAIT_V(8); PG8_WAIT_L(0); PG8_BAR; PG8_MMA(1, 0, At, B0); PG8_MMA(1, 1, At, B1); PG8_BAR; PG8_SCHED;
            PG8_LDB(B0, 1, 0); PG8_LDB(B1, 1, 1); PG8_SCHED; PG8_LDA(At, 1, 0); PG8_STAGE(PG8_SA(0, 1), a2 + hstep, voffA);
            PG8_WAIT_V(8); PG8_WAIT_L(0); PG8_BAR; PG8_MMA(0, 0, At, B0); PG8_MMA(0, 1, At, B1); PG8_BAR; PG8_SCHED;
            PG8_LDA(At, 1, 1); PG8_STAGE(PG8_SB(1, 0), b3, voffB); PG8_STAGE(PG8_SB(1, 1), b3 + hstep, voffB); PG8_STAGE(PG8_SA(1, 0), a3, voffA);
            PG8_WAIT_V(8); PG8_WAIT_L(0); PG8_BAR; PG8_MMA(1, 0, At, B0); PG8_MMA(1, 1, At, B1); PG8_BAR; PG8_SCHED;
            } else {
            PG8_LDB(B0, 0, 0); PG8_SCHED; PG8_LDA(At, 0, 0); PG8_STAGE(PG8_SA(1, 1), a1 + hstep, voffA);
            PG8_WAIT_L(8); PG8_BAR; PG8_WAIT_L(0); PG8_MMA(0, 0, At, B0); PG8_BAR; PG8_SCHED;
            PG8_LDB(B1, 0, 1); PG8_STAGE(PG8_SB(0, 0), b2, voffB);
            PG8_BAR; PG8_WAIT_L(0); PG8_MMA(0, 1, At, B1); PG8_BAR;
            PG8_LDA(At, 0, 1); PG8_STAGE(PG8_SA(0, 0), a2, voffA);
            PG8_BAR; PG8_WAIT_L(0); PG8_MMA(1, 0, At, B0); PG8_BAR; PG8_SCHED;
            PG8_STAGE(PG8_SB(0, 1), b2 + hstep, voffB);
            PG8_WAIT_V(6); PG8_BAR; PG8_MMA(1, 1, At, B1); PG8_BAR;
            PG8_LDB(B0, 1, 0); PG8_SCHED; PG8_LDA(At, 1, 0); PG8_STAGE(PG8_SA(0, 1), a2 + hstep, voffA);
            PG8_WAIT_L(8); PG8_BAR; PG8_WAIT_L(0); PG8_MMA(0, 0, At, B0); PG8_BAR; PG8_SCHED;
            PG8_LDB(B1, 1, 1); PG8_STAGE(PG8_SB(1, 0), b3, voffB);
            PG8_BAR; PG8_WAIT_L(0); PG8_MMA(0, 1, At, B1); PG8_BAR;
            PG8_LDA(At, 1, 1); PG8_STAGE(PG8_SA(1, 0), a3, voffA);
            PG8_BAR; PG8_WAIT_L(0); PG8_MMA(1, 0, At, B0); PG8_BAR; PG8_SCHED;
            PG8_STAGE(PG8_SB(1, 1), b3 + hstep, voffB);
            PG8_WAIT_V(6); PG8_BAR; PG8_MMA(1, 1, At, B1); PG8_BAR;
            }
        }
        if constexpr (ALIGN_EPI) { if (wr == 0) PG8_BAR; }
        if constexpr (!Epi::AFTER_DRAIN) { E(acc, cur, wr, wc, fr, fq); S.done(cur); }
        if (!has_next) break;
#pragma unroll
        for (int a = 0; a < 2; ++a)
#pragma unroll
            for (int b = 0; b < 2; ++b)
#pragma unroll
                for (int m = 0; m < 4; ++m)
#pragma unroll
                    for (int n = 0; n < 2; ++n) acc[a][b][m][n] = (f32x4){0.f, 0.f, 0.f, 0.f};
        cur = nxt; cA = nA; cB = nB; ++ui;
        if constexpr (ALIGN_EPI) { if (wr == 1) PG8_BAR; }
    }
    PG8_WAIT_V(0);
    if constexpr (!ALIGN_EPI) { if (wr == 0) PG8_BAR; }
    PG8_BAR;
    if constexpr (Epi::AFTER_DRAIN) { E.fused(acc, cur, wr, wc, fr, fq, lds, wid, lane); S.done(cur); }
#undef PG8_SA
#undef PG8_SB
#undef PG8_STAGE
#undef PG8_LDA
#undef PG8_LDB
#undef PG8_MMA
#undef PG8_WAIT_V
#undef PG8_WAIT_L
#undef PG8_BAR
#undef PG8_SCHED
}
}
namespace att {
typedef unsigned short bf16;
using bf16x8 = __attribute__((ext_vector_type(8))) short;
using s16x4  = __attribute__((ext_vector_type(4))) short;
using f32x16 = __attribute__((ext_vector_type(16))) float;
using u32x4  = __attribute__((ext_vector_type(4))) unsigned;
constexpr int LDP = 6144;
constexpr int SHM_V = 64 * 128 * 2, SHM_K = 64 * 128 * 2;
constexpr int OFF_WS = 2 * SHM_V + 2 * SHM_K, OFF_RPB = OFF_WS + 8 * 64 * 4, ATT_LDS = OFF_RPB + 2048;
constexpr float THR = 8.f;
#define KSWZ(row, colB) ((row) * 256 + ((colB) ^ (((row) & 7) << 4)))
#define SBAR() __builtin_amdgcn_sched_barrier(0)
__device__ __forceinline__ int crow(int r, int hi) { return (r & 3) + 8 * (r >> 2) + 4 * hi; }
__device__ __forceinline__ unsigned cvtpk(float lo, float hi) {
  unsigned r; asm volatile("v_cvt_pk_bf16_f32 %0, %1, %2" : "=v"(r) : "v"(lo), "v"(hi)); return r;
}
__device__ __forceinline__ bf16x8 ld8(const bf16* p) { return *reinterpret_cast<const bf16x8*>(p); }

template <int MODE> struct Cfg;
template <> struct Cfg<0> { static constexpr int ND0 = 4; static constexpr float SCALE = 0.125f; };
template <> struct Cfg<1> { static constexpr int ND0 = 8; static constexpr float SCALE = 0.088388347648318440f; };

template <int MODE>
__device__ __forceinline__ void partialSM(f32x16& p0, f32x16& p1, float& m_reg, float& mn, float& alpha) {
  constexpr float SCALE = Cfg<MODE>::SCALE;
  constexpr float C = SCALE * 1.4426950408889634f;
  float pmax = p0[0];
#pragma unroll
  for (int r = 1; r < 16; ++r) pmax = fmaxf(pmax, p0[r]);
#pragma unroll
  for (int r = 0; r < 16; ++r) pmax = fmaxf(pmax, p1[r]);
  { auto rr = __builtin_amdgcn_permlane32_swap(__float_as_uint(pmax), __float_as_uint(pmax), false, false);
    pmax = fmaxf(__uint_as_float(rr[0]), __uint_as_float(rr[1])); }
  if (__builtin_expect(__all(pmax - m_reg <= THR / SCALE), 1)) { mn = m_reg; alpha = 1.f; }
  else { mn = fmaxf(m_reg, pmax); alpha = __builtin_amdgcn_exp2f((m_reg - mn) * C); m_reg = mn; }
  float mnC = -mn * C;
#pragma unroll
  for (int r = 0; r < 16; ++r) p0[r] = fmaf(p0[r], C, mnC);
#pragma unroll
  for (int r = 0; r < 16; ++r) p1[r] = fmaf(p1[r], C, mnC);
#pragma unroll
  for (int r = 0; r < 16; ++r) p0[r] = __builtin_amdgcn_exp2f(p0[r]);
}
__device__ __forceinline__ void finishSM(f32x16& p0, f32x16& p1, float alpha, float& l_reg, bf16x8& pa0, bf16x8& pa1, bf16x8& pa2, bf16x8& pa3) {
#pragma unroll
  for (int r = 0; r < 16; ++r) p1[r] = __builtin_amdgcn_exp2f(p1[r]);
  float ps = 0;
#pragma unroll
  for (int r = 0; r < 16; ++r) ps += p0[r];
#pragma unroll
  for (int r = 0; r < 16; ++r) ps += p1[r];
  { auto rr = __builtin_amdgcn_permlane32_swap(__float_as_uint(ps), __float_as_uint(ps), false, false);
    ps = __uint_as_float(rr[0]) + __uint_as_float(rr[1]); }
  l_reg = l_reg * alpha + ps;
#define PK4(P, BASE, OUT) do { u32x4 w = {cvtpk(P[BASE + 0], P[BASE + 1]), cvtpk(P[BASE + 2], P[BASE + 3]), cvtpk(P[BASE + 4], P[BASE + 5]), cvtpk(P[BASE + 6], P[BASE + 7])}; \
    OUT = *reinterpret_cast<bf16x8*>(&w); } while (0)
  PK4(p0, 0, pa0); PK4(p0, 8, pa1); PK4(p1, 0, pa2); PK4(p1, 8, pa3);
#undef PK4
}
__device__ __forceinline__ void finishSM_ns(f32x16& p0, f32x16& p1, bf16x8& pa0, bf16x8& pa1, bf16x8& pa2, bf16x8& pa3) {
#pragma unroll
  for (int r = 0; r < 16; ++r) p1[r] = __builtin_amdgcn_exp2f(p1[r]);
#define PK4(P, BASE, OUT) do { u32x4 w = {cvtpk(P[BASE + 0], P[BASE + 1]), cvtpk(P[BASE + 2], P[BASE + 3]), cvtpk(P[BASE + 4], P[BASE + 5]), cvtpk(P[BASE + 6], P[BASE + 7])}; \
    OUT = *reinterpret_cast<bf16x8*>(&w); } while (0)
  PK4(p0, 0, pa0); PK4(p0, 8, pa1); PK4(p1, 0, pa2); PK4(p1, 8, pa3);
#undef PK4
}
__device__ __forceinline__ void sm_sum(const f32x16& p0, const f32x16& p1, float& ps) {
  ps = 0;
#pragma unroll
  for (int r = 0; r < 16; ++r) ps += p0[r];
#pragma unroll
  for (int r = 0; r < 16; ++r) ps += p1[r];
}
template <int MODE>
__device__ __forceinline__ void sm_lmax(float ps, float alpha_prev, float& l_reg, const f32x16& p0, const f32x16& p1, float& m_reg, float& mn, float& alpha, float& mnC) {
  constexpr float SCALE = Cfg<MODE>::SCALE; constexpr float C = SCALE * 1.4426950408889634f;
  { auto rr = __builtin_amdgcn_permlane32_swap(__float_as_uint(ps), __float_as_uint(ps), false, false);
    ps = __uint_as_float(rr[0]) + __uint_as_float(rr[1]); }
  l_reg = l_reg * alpha_prev + ps;
  float pmax = p0[0];
#pragma unroll
  for (int r = 1; r < 16; ++r) pmax = fmaxf(pmax, p0[r]);
#pragma unroll
  for (int r = 0; r < 16; ++r) pmax = fmaxf(pmax, p1[r]);
  { auto rr = __builtin_amdgcn_permlane32_swap(__float_as_uint(pmax), __float_as_uint(pmax), false, false);
    pmax = fmaxf(__uint_as_float(rr[0]), __uint_as_float(rr[1])); }
  if (__builtin_expect(__all(pmax - m_reg <= THR / SCALE), 1)) { mn = m_reg; alpha = 1.f; }
  else { mn = fmaxf(m_reg, pmax); alpha = __builtin_amdgcn_exp2f((m_reg - mn) * C); m_reg = mn; }
  mnC = -mn * C;
}
template <int MODE>
__device__ __forceinline__ void sm_fma(f32x16& p0, f32x16& p1, float mnC) {
  constexpr float C = Cfg<MODE>::SCALE * 1.4426950408889634f;
#pragma unroll
  for (int r = 0; r < 16; ++r) p0[r] = fmaf(p0[r], C, mnC);
#pragma unroll
  for (int r = 0; r < 16; ++r) p1[r] = fmaf(p1[r], C, mnC);
}
__device__ __forceinline__ void sm_exp0(f32x16& p0) {
#pragma unroll
  for (int r = 0; r < 16; ++r) p0[r] = __builtin_amdgcn_exp2f(p0[r]);
}
template <int ND0>
__device__ __forceinline__ void qkt(f32x16& p0, f32x16& p1, const bf16* Ks, const bf16x8* qr, int r32, int hi, int kcb) {
  p0 = f32x16{}; p1 = f32x16{};
#pragma unroll
  for (int d0 = 0; d0 < ND0; ++d0) { int cb = kcb + (d0 * 16 + hi * 8) * 2;
    bf16x8 b0 = *reinterpret_cast<const bf16x8*>((const char*)Ks + KSWZ(r32, cb));
    bf16x8 b1 = *reinterpret_cast<const bf16x8*>((const char*)Ks + KSWZ(32 + r32, cb));
    p0 = __builtin_amdgcn_mfma_f32_32x32x16_bf16(b0, qr[d0], p0, 0, 0, 0);
    p1 = __builtin_amdgcn_mfma_f32_32x32x16_bf16(b1, qr[d0], p1, 0, 0, 0); }
}
constexpr float THRL = 8.f * 1.4426950408889634f;
template <int ND0>
__device__ __forceinline__ void qk_rd(bf16x8 (&kb0)[ND0], bf16x8 (&kb1)[ND0], const bf16* Ks, int r32, int hi, int kcb) {
#pragma unroll
  for (int d0 = 0; d0 < ND0; ++d0) { int cb = kcb + (d0 * 16 + hi * 8) * 2;
    kb0[d0] = *reinterpret_cast<const bf16x8*>((const char*)Ks + KSWZ(r32, cb));
    kb1[d0] = *reinterpret_cast<const bf16x8*>((const char*)Ks + KSWZ(32 + r32, cb)); }
}
template <int ND0>
__device__ __forceinline__ void qk_mm(f32x16& p0, f32x16& p1, const bf16x8 (&kb0)[ND0], const bf16x8 (&kb1)[ND0], const bf16x8* qr, const f32x16& negm) {
#pragma unroll
  for (int d0 = 0; d0 < ND0; ++d0) {
    if (d0 == 0) { p0 = __builtin_amdgcn_mfma_f32_32x32x16_bf16(kb0[d0], qr[d0], negm, 0, 0, 0); p1 = __builtin_amdgcn_mfma_f32_32x32x16_bf16(kb1[d0], qr[d0], negm, 0, 0, 0); }
    else { p0 = __builtin_amdgcn_mfma_f32_32x32x16_bf16(kb0[d0], qr[d0], p0, 0, 0, 0); p1 = __builtin_amdgcn_mfma_f32_32x32x16_bf16(kb1[d0], qr[d0], p1, 0, 0, 0); } }
}
template <int ND0>
__device__ __forceinline__ void qkt_c(f32x16& p0, f32x16& p1, const bf16* Ks, const bf16x8* qr, int r32, int hi, int kcb, const f32x16& negm) {
  bf16x8 kb0[ND0], kb1[ND0];
#pragma unroll
  for (int d0 = 0; d0 < ND0; ++d0) { int cb = kcb + (d0 * 16 + hi * 8) * 2;
    kb0[d0] = *reinterpret_cast<const bf16x8*>((const char*)Ks + KSWZ(r32, cb));
    kb1[d0] = *reinterpret_cast<const bf16x8*>((const char*)Ks + KSWZ(32 + r32, cb)); }
  SBAR();
#pragma unroll
  for (int d0 = 0; d0 < ND0; ++d0) { const bf16x8 b0 = kb0[d0], b1 = kb1[d0];
    if (d0 == 0) { p0 = __builtin_amdgcn_mfma_f32_32x32x16_bf16(b0, qr[d0], negm, 0, 0, 0); p1 = __builtin_amdgcn_mfma_f32_32x32x16_bf16(b1, qr[d0], negm, 0, 0, 0); }
    else { p0 = __builtin_amdgcn_mfma_f32_32x32x16_bf16(b0, qr[d0], p0, 0, 0, 0); p1 = __builtin_amdgcn_mfma_f32_32x32x16_bf16(b1, qr[d0], p1, 0, 0, 0); } }
}
__device__ __forceinline__ float rowmax32(const f32x16& p0, const f32x16& p1) {
  float pmax = p0[0];
#pragma unroll
  for (int r = 1; r < 16; ++r) pmax = fmaxf(pmax, p0[r]);
#pragma unroll
  for (int r = 0; r < 16; ++r) pmax = fmaxf(pmax, p1[r]);
  auto rr = __builtin_amdgcn_permlane32_swap(__float_as_uint(pmax), __float_as_uint(pmax), false, false);
  return fmaxf(__uint_as_float(rr[0]), __uint_as_float(rr[1]));
}
__device__ __forceinline__ void firstSM_l2(f32x16& p0, f32x16& p1, float& m_reg, f32x16& negm) {
  const float pmax = rowmax32(p0, p1);
  m_reg = pmax;
#pragma unroll
  for (int r = 0; r < 16; ++r) { negm[r] = -pmax; p0[r] -= pmax; p1[r] -= pmax; }
#pragma unroll
  for (int r = 0; r < 16; ++r) p0[r] = __builtin_amdgcn_exp2f(p0[r]);
}
__device__ __forceinline__ void sm_lmax_l2(float ps, float alpha_prev, float& l_reg, f32x16& p0, f32x16& p1, float& m_reg, float& alpha, f32x16& negm) {
  { auto rr = __builtin_amdgcn_permlane32_swap(__float_as_uint(ps), __float_as_uint(ps), false, false);
    ps = __uint_as_float(rr[0]) + __uint_as_float(rr[1]); }
  l_reg = l_reg * alpha_prev + ps;
  const float pmax = rowmax32(p0, p1);
  if (__builtin_expect(__all(pmax <= THRL), 1)) { alpha = 1.f; }
  else { const float dlt = fmaxf(pmax, 0.f); alpha = __builtin_amdgcn_exp2f(-dlt); m_reg += dlt;
#pragma unroll
    for (int r = 0; r < 16; ++r) { negm[r] -= dlt; p0[r] -= dlt; p1[r] -= dlt; } }
}
__device__ __forceinline__ void sm_exp_lo(f32x16& p0) {
#pragma unroll
  for (int r = 0; r < 8; ++r) p0[r] = __builtin_amdgcn_exp2f(p0[r]);
}
__device__ __forceinline__ void sm_exp_hi(f32x16& p0) {
#pragma unroll
  for (int r = 8; r < 16; ++r) p0[r] = __builtin_amdgcn_exp2f(p0[r]);
}
__device__ __forceinline__ int v_st(int k, int c) { return ((k >> 3) * 4 + (c >> 5)) * 512 + ((k & 7) * 32 + (c & 31)) * 2; }
__device__ __forceinline__ int v_rd_base(int lane) { return ((lane & 3) << 3) | (((lane >> 2) & 3) << 6) | (((lane >> 4) & 1) << 5) | (((lane >> 5) & 1) << 8); }
constexpr int v_rd_off(int d0, int ks, int half) { return d0 * 512 + ks * 4096 + half * 2048; }
template <int OFF> __device__ __forceinline__ s16x4 tr_read(int vb) {
  s16x4 r; asm volatile("ds_read_b64_tr_b16 %0, %1 offset:%2" : "=&v"(r) : "v"(vb), "i"(OFF) : "memory"); return r;
}
template <int D0> __device__ __forceinline__ void pv_one(f32x16& od, int vb, bf16x8 pa0, bf16x8 pa1, bf16x8 pa2, bf16x8 pa3) {
  const s16x4 l0 = tr_read<v_rd_off(D0, 0, 0)>(vb), h0 = tr_read<v_rd_off(D0, 0, 1)>(vb), l1 = tr_read<v_rd_off(D0, 1, 0)>(vb), h1 = tr_read<v_rd_off(D0, 1, 1)>(vb);
  const s16x4 l2 = tr_read<v_rd_off(D0, 2, 0)>(vb), h2 = tr_read<v_rd_off(D0, 2, 1)>(vb), l3 = tr_read<v_rd_off(D0, 3, 0)>(vb), h3 = tr_read<v_rd_off(D0, 3, 1)>(vb);
  asm volatile("s_waitcnt lgkmcnt(0)" ::: "memory"); SBAR();
#define PK(L, H) (bf16x8){L[0], L[1], L[2], L[3], H[0], H[1], H[2], H[3]}
  od = __builtin_amdgcn_mfma_f32_32x32x16_bf16(pa0, PK(l0, h0), od, 0, 0, 0);
  od = __builtin_amdgcn_mfma_f32_32x32x16_bf16(pa1, PK(l1, h1), od, 0, 0, 0);
  od = __builtin_amdgcn_mfma_f32_32x32x16_bf16(pa2, PK(l2, h2), od, 0, 0, 0);
  od = __builtin_amdgcn_mfma_f32_32x32x16_bf16(pa3, PK(l3, h3), od, 0, 0, 0);
#undef PK
}
__device__ __forceinline__ void pv_d0(f32x16* o, int vb, bf16x8 pa0, bf16x8 pa1, bf16x8 pa2, bf16x8 pa3) {
  pv_one<0>(o[0], vb, pa0, pa1, pa2, pa3); pv_one<1>(o[1], vb, pa0, pa1, pa2, pa3); pv_one<2>(o[2], vb, pa0, pa1, pa2, pa3); pv_one<3>(o[3], vb, pa0, pa1, pa2, pa3);
}
struct VFrag { s16x4 l0, h0, l1, h1, l2, h2, l3, h3; };
template <int D0> __device__ __forceinline__ void pv_rd(VFrag& f, int vb) {
  f.l0 = tr_read<v_rd_off(D0, 0, 0)>(vb); f.h0 = tr_read<v_rd_off(D0, 0, 1)>(vb); f.l1 = tr_read<v_rd_off(D0, 1, 0)>(vb); f.h1 = tr_read<v_rd_off(D0, 1, 1)>(vb);
  f.l2 = tr_read<v_rd_off(D0, 2, 0)>(vb); f.h2 = tr_read<v_rd_off(D0, 2, 1)>(vb); f.l3 = tr_read<v_rd_off(D0, 3, 0)>(vb); f.h3 = tr_read<v_rd_off(D0, 3, 1)>(vb);
}
template <int NW_>
__device__ __forceinline__ void pv_mm(f32x16& od, const VFrag& f, bf16x8 pa0, bf16x8 pa1, bf16x8 pa2, bf16x8 pa3) {
  if (NW_ == 8) asm volatile("s_waitcnt lgkmcnt(8)" ::: "memory"); else asm volatile("s_waitcnt lgkmcnt(0)" ::: "memory");
  SBAR();
#define PK(L, H) (bf16x8){L[0], L[1], L[2], L[3], H[0], H[1], H[2], H[3]}
  od = __builtin_amdgcn_mfma_f32_32x32x16_bf16(pa0, PK(f.l0, f.h0), od, 0, 0, 0);
  od = __builtin_amdgcn_mfma_f32_32x32x16_bf16(pa1, PK(f.l1, f.h1), od, 0, 0, 0);
  od = __builtin_amdgcn_mfma_f32_32x32x16_bf16(pa2, PK(f.l2, f.h2), od, 0, 0, 0);
  od = __builtin_amdgcn_mfma_f32_32x32x16_bf16(pa3, PK(f.l3, f.h3), od, 0, 0, 0);
#undef PK
}
__device__ __forceinline__ void na_fix(f32x16& p0, f32x16& p1, int kr, int qr_, int rs, int qc, int cs, int hi, const float* rpbS) {
  const float NEG = -__builtin_inff();
  if (kr < rs || kr >= rs + 8) {
#pragma unroll
    for (int r = 0; r < 16; ++r) { p0[r] = NEG; p1[r] = NEG; }
  } else {
    const float* brow = rpbS + (kr - qr_ + 7) * 31 + (15 - qc);
#pragma unroll
    for (int g = 0; g < 4; ++g) {
#pragma unroll
      for (int q = 0; q < 4; ++q) { const int r = 4 * g + q;
        const int k0 = crow(r, hi), k1 = 32 + k0;
        const bool v0 = (unsigned)(k0 - cs) < 16u, v1 = (unsigned)(k1 - cs) < 16u;
        const float b0 = brow[v0 ? k0 : qc], b1 = brow[v1 ? k1 : qc];
        p0[r] = (p0[r] + b0) + (v0 ? 0.f : NEG); p1[r] = (p1[r] + b1) + (v1 ? 0.f : NEG);
      }
      SBAR();
    }
  }
}

template <int MODE>
__device__ __forceinline__ void attn_core(const bf16* __restrict__ Qw, const bf16* __restrict__ Kh, const bf16* __restrict__ Vh, const int NT, char* lds, const int kcb,
                                          const int, const int, const int, const int, const int, f32x16 (&o)[4], float& l_reg) {
  constexpr int ND0 = Cfg<MODE>::ND0;
  int tid_ = threadIdx.x; asm volatile("" : "+v"(tid_));
  const int tid = tid_, wid = __builtin_amdgcn_readfirstlane(tid >> 6), lane = tid & 63, r32 = lane & 31, hi = lane >> 5, half = wid >> 2, ht = tid & 255;
  bf16* V_lds = (bf16*)lds; bf16* K_lds = (bf16*)(lds + 2 * SHM_V);
  float* ws = (float*)(lds + OFF_WS) + wid * 64; float* al_l = ws + 32;
  float m_reg = 0.f; l_reg = 0.f; f32x16 negm = f32x16{};
#pragma unroll
  for (int d = 0; d < 4; ++d) o[d] = f32x16{};
  bf16x8 qr[ND0];
#pragma unroll
  for (int d0 = 0; d0 < ND0; ++d0) qr[d0] = ld8(Qw + d0 * 16);
  const int vb0 = (int)(uintptr_t)V_lds + v_rd_base(lane);
  {
    const int sr = tid >> 4, sc = (tid & 15) * 8;
    const bf16x8 v0 = ld8(&Vh[(long)sr * LDP + sc]), v1 = ld8(&Vh[(long)(32 + sr) * LDP + sc]), k0 = ld8(&Kh[(long)sr * LDP + sc]), k1 = ld8(&Kh[(long)(32 + sr) * LDP + sc]);
    *(bf16x8*)((char*)V_lds + v_st(sr, sc)) = v0; *(bf16x8*)((char*)V_lds + v_st(32 + sr, sc)) = v1;
    *(bf16x8*)((char*)K_lds + KSWZ(sr, sc * 2)) = k0; *(bf16x8*)((char*)K_lds + KSWZ(32 + sr, sc * 2)) = k1; }
  const int hr = ht >> 4, hc = (ht & 15) * 8;
  const bf16* Sg = (half == 0 ? Kh : Vh) + (long)hr * LDP + hc;
  char* Sl = half == 0 ? (char*)K_lds : (char*)V_lds;
  int soff[4];
#pragma unroll
  for (int i = 0; i < 4; ++i) soff[i] = half == 0 ? KSWZ(hr + 16 * i, hc * 2) : v_st(hr + 16 * i, hc);
  bf16x8 st[4];
#define HLOAD(t) do { _Pragma("unroll") for (int i = 0; i < 4; ++i) st[i] = ld8(Sg + (long)((t) * 64 + 16 * i) * LDP); } while (0)
#define HWRITE(b) do { _Pragma("unroll") for (int i = 0; i < 4; ++i) *(bf16x8*)(Sl + (b) * SHM_V + soff[i]) = st[i]; } while (0)
#define BAR_P() do { asm volatile("" : "+v"(p0), "+v"(p1)); SBAR(); asm volatile("s_waitcnt lgkmcnt(0)\n\ts_barrier" ::: "memory"); SBAR(); } while (0)
#define BAR_A() do { asm volatile("" : "+v"(pa0), "+v"(pa1), "+v"(pa2), "+v"(pa3)); SBAR(); asm volatile("s_waitcnt lgkmcnt(0)\n\ts_barrier" ::: "memory"); SBAR(); } while (0)
  f32x16 p0 = f32x16{}, p1 = f32x16{}; bf16x8 pa0, pa1, pa2, pa3; float alpha;
#define MSEG(VB, KS) do { VFrag fa_, fb_; bf16x8 kb0_[ND0], kb1_[ND0]; \
    pv_rd<0>(fa_, VB); pv_rd<1>(fb_, VB); pv_mm<8>(o[0], fa_, pa0, pa1, pa2, pa3); \
    pv_rd<2>(fa_, VB); pv_mm<8>(o[1], fb_, pa0, pa1, pa2, pa3); \
    pv_rd<3>(fb_, VB); pv_mm<8>(o[2], fa_, pa0, pa1, pa2, pa3); \
    qk_rd<ND0>(kb0_, kb1_, KS, r32, hi, kcb); pv_mm<8>(o[3], fb_, pa0, pa1, pa2, pa3); \
    qk_mm<ND0>(p0, p1, kb0_, kb1_, qr, negm); } while (0)
#define VSEG(FIRST) do { alpha = 1.f; const float pmax_ = rowmax32(p0, p1); \
    if (FIRST) { m_reg = pmax_; _Pragma("unroll") for (int r = 0; r < 16; ++r) { negm[r] = -pmax_; p0[r] -= pmax_; p1[r] -= pmax_; } } \
    else if (!__builtin_expect(__all(pmax_ <= THRL), 1)) { const float dlt_ = fmaxf(pmax_, 0.f); alpha = __builtin_amdgcn_exp2f(-dlt_); m_reg += dlt_; \
      _Pragma("unroll") for (int r = 0; r < 16; ++r) { negm[r] -= dlt_; p0[r] -= dlt_; p1[r] -= dlt_; } \
      if (hi == 0) al_l[r32] = alpha; asm volatile("s_waitcnt lgkmcnt(0)" ::: "memory"); \
      _Pragma("unroll") for (int d = 0; d < 4; ++d) _Pragma("unroll") for (int r = 0; r < 16; ++r) o[d][r] *= al_l[crow(r, hi)]; } \
    sm_exp0(p0); finishSM(p0, p1, alpha, l_reg, pa0, pa1, pa2, pa3); } while (0)
  __syncthreads();
  HLOAD(1);
  if (half == 1) BAR_P();
  qkt<ND0>(p0, p1, K_lds, qr, r32, hi, kcb);
  BAR_P();
  VSEG(true); HWRITE(1); HLOAD(2); BAR_A();
  MSEG(vb0, (bf16*)((char*)K_lds + SHM_K)); BAR_P();
#pragma unroll 1
  for (int j = 1; j + 1 < NT; j += 2) {
    VSEG(false); HWRITE(0); HLOAD(j + 2); BAR_A();
    MSEG(vb0 + SHM_V, K_lds); BAR_P();
    VSEG(false); HWRITE(1); if (j + 3 < NT) HLOAD(j + 3); BAR_A();
    MSEG(vb0, (bf16*)((char*)K_lds + SHM_K)); BAR_P();
  }
  VSEG(false); BAR_A();
  pv_d0(o, vb0 + SHM_V, pa0, pa1, pa2, pa3); BAR_P();
  if (half == 0) BAR_P();
#undef VSEG
#undef MSEG
#undef HLOAD
#undef HWRITE
#undef BAR_P
#undef BAR_A
}
__device__ __forceinline__ float half_sum32(float v) {
#pragma unroll
  for (int o = 1; o < 32; o <<= 1) v += __shfl_xor(v, o);
  return v;
}
__device__ __forceinline__ void diff_unit(const bf16* __restrict__ proj, bf16* __restrict__ mix, int h, int q0, float lam, float oml, const float* __restrict__ subg, char* lds) {
  int tid_ = threadIdx.x; asm volatile("" : "+v"(tid_));
  const int tid = tid_, wid = tid >> 6, lane = tid & 63, r32 = lane & 31, hi = lane >> 5, map = wid >> 2, wq = wid & 3;
  const bf16* Qw = proj + (size_t)(q0 + wq * 32 + r32) * LDP + h * 128 + map * 64 + hi * 8;
  f32x16 o[4]; float l_reg;
  attn_core<0>(Qw, proj + 1024 + h * 128, proj + 2048 + h * 128, 8192 / 64, lds, map * 128, 0, 0, 0, 0, 0, o, l_reg);
  float* ws = (float*)(lds + OFF_WS) + wid * 64;
  if (hi == 0) ws[r32] = l_reg;
  asm volatile("s_waitcnt lgkmcnt(0)" ::: "memory");
  float rli[16];
#pragma unroll
  for (int r = 0; r < 16; ++r) rli[r] = __builtin_amdgcn_rcpf(ws[crow(r, hi)]);
  __syncthreads();
  float* X = (float*)lds + (wq * 64) * 64 + lane;
  if (map == 1) {
#pragma unroll
    for (int d = 0; d < 4; ++d)
#pragma unroll
      for (int r = 0; r < 16; ++r) X[(d * 16 + r) * 64] = o[d][r] * rli[r];
  }
  __syncthreads();
  if (map == 0) {
    float gv[4];
#pragma unroll
    for (int d = 0; d < 4; ++d) gv[d] = subg[32 * d + r32] * oml;
    bf16* Ow = mix + (size_t)(q0 + wq * 32) * 2048 + 1024 + h * 128 + r32;
#pragma unroll
    for (int r = 0; r < 16; ++r) {
      float dv[4]; float sq = 0.f;
#pragma unroll
      for (int d = 0; d < 4; ++d) { dv[d] = o[d][r] * rli[r] - lam * X[(d * 16 + r) * 64]; sq += dv[d] * dv[d]; }
      sq = half_sum32(sq);
      const float rn = rsqrtf(sq * (1.0f / 128.0f) + 1e-6f);
      bf16* orow = Ow + (size_t)crow(r, hi) * 2048;
#pragma unroll
      for (int d = 0; d < 4; ++d) orow[32 * d] = (bf16)(cvtpk(dv[d] * rn * gv[d], 0.f) & 0xffffu);
    }
  }
  __syncthreads();
}
__device__ __forceinline__ void attn_na_core(const bf16* __restrict__ Qw, const bf16* __restrict__ Kh, const bf16* __restrict__ Vh, const int NT, char* lds,
                                             const int na_qr, const int na_rs, const int na_qc, const int na_cs, const int na_k0, f32x16 (&o)[4], float& l_reg) {
  int tid_ = threadIdx.x; asm volatile("" : "+v"(tid_));
  const int tid = tid_, wid = tid >> 6, lane = tid & 63, r32 = lane & 31, hi = lane >> 5;
  bf16* V_lds = (bf16*)lds; bf16* K_lds = (bf16*)(lds + 2 * SHM_V);
  float* ws = (float*)(lds + OFF_WS) + wid * 64; float* al_l = ws + 32;
  const float* rpbS = (const float*)(lds + OFF_RPB);
  float m_reg = -1e30f; l_reg = 0.f;
#pragma unroll
  for (int d = 0; d < 4; ++d) o[d] = f32x16{};
  bf16x8 qr[8];
#pragma unroll
  for (int d0 = 0; d0 < 8; ++d0) qr[d0] = ld8(Qw + d0 * 16);
  const int sr = tid >> 4, sc = (tid & 15) * 8, vst0 = v_st(sr, sc), vst1 = v_st(32 + sr, sc);
  const int vb0 = (int)(uintptr_t)V_lds + v_rd_base(lane);
  bf16x8 vs0, vs1, ks0, ks1;
#define SLOAD(k0) do { vs0 = ld8(&Vh[(long)((k0) + sr) * LDP + sc]); vs1 = ld8(&Vh[(long)((k0) + 32 + sr) * LDP + sc]); \
    ks0 = ld8(&Kh[(long)((k0) + sr) * LDP + sc]); ks1 = ld8(&Kh[(long)((k0) + 32 + sr) * LDP + sc]); } while (0)
  SLOAD(0);
#pragma unroll 1
  for (int j = 0; j < NT; ++j) {
    __syncthreads();
    *(bf16x8*)((char*)V_lds + vst0) = vs0; *(bf16x8*)((char*)V_lds + vst1) = vs1;
    *(bf16x8*)((char*)K_lds + KSWZ(sr, sc * 2)) = ks0; *(bf16x8*)((char*)K_lds + KSWZ(32 + sr, sc * 2)) = ks1;
    if (j + 1 < NT) SLOAD((j + 1) * 64);
    __syncthreads();
    const int kr = na_k0 + j;
    if (kr >= na_rs && kr < na_rs + 8) {
      f32x16 p0, p1; float mn, al; bf16x8 pa0, pa1, pa2, pa3;
      qkt<8>(p0, p1, K_lds, qr, r32, hi, 0);
      na_fix(p0, p1, kr, na_qr, na_rs, na_qc, na_cs, hi, rpbS);
      partialSM<1>(p0, p1, m_reg, mn, al);
      if (__any(al < 1.f)) { if (hi == 0) al_l[r32] = al; asm volatile("s_waitcnt lgkmcnt(0)" ::: "memory");
#pragma unroll
        for (int d = 0; d < 4; ++d)
#pragma unroll
          for (int r = 0; r < 16; ++r) o[d][r] *= al_l[crow(r, hi)]; }
      finishSM(p0, p1, al, l_reg, pa0, pa1, pa2, pa3); SBAR();
      pv_d0(o, vb0, pa0, pa1, pa2, pa3);
    }
  }
#undef SLOAD
}
__device__ __forceinline__ void na_unit(const bf16* __restrict__ proj, bf16* __restrict__ mix, float* __restrict__ nass, int h, int rb, const float* __restrict__ rpb_h, char* lds) {
  int tid_ = threadIdx.x; asm volatile("" : "+v"(tid_));
  const int tid = tid_, wid = tid >> 6, lane = tid & 63, r32 = lane & 31, hi = lane >> 5;
  float* rpbS = (float*)(lds + OFF_RPB);
  if (tid < 15 * 31) rpbS[tid] = rpb_h[tid] * 11.313708498984761f;
  const int q0 = rb * 256; int k0row = rb * 4 - 4; k0row = k0row < 0 ? 0 : (k0row > 116 ? 116 : k0row);
  const int qr_ = rb * 4 + (wid >> 1), qc = (wid & 1) * 32 + r32;
  int rs = qr_ - 4; rs = rs < 0 ? 0 : (rs > 120 ? 120 : rs);
  int cs = qc - 8; cs = cs < 0 ? 0 : (cs > 48 ? 48 : cs);
  const bf16* Qw = proj + (size_t)(q0 + wid * 32 + r32) * LDP + 3072 + h * 128 + hi * 8;
  const bf16* Kh = proj + (size_t)k0row * 64 * LDP + 4096 + h * 128;
  const bf16* Vh = proj + (size_t)k0row * 64 * LDP + 5120 + h * 128;
  f32x16 o[4]; float l_reg;
  attn_na_core(Qw, Kh, Vh, 12, lds, qr_, rs, qc, cs, k0row, o, l_reg);
  int t2 = threadIdx.x; asm volatile("" : "+v"(t2));
  const int wid2 = t2 >> 6, r32b = t2 & 31, hib = (t2 >> 5) & 1;
  float* ws = (float*)(lds + OFF_WS) + wid2 * 64;
  if (hib == 0) ws[r32b] = l_reg;
  asm volatile("s_waitcnt lgkmcnt(0)" ::: "memory");
  bf16* Ow = mix + (size_t)(rb * 256 + wid2 * 32) * 2048 + h * 128 + r32b;
  float* nrow = nass + (size_t)(rb * 256 + wid2 * 32) * 8 + h;
#pragma unroll
  for (int r = 0; r < 16; ++r) {
    const float rl = __builtin_amdgcn_rcpf(ws[crow(r, hib)]);
    bf16* orow = Ow + (size_t)crow(r, hib) * 2048; float sq = 0.f;
#pragma unroll
    for (int d = 0; d < 4; ++d) { const float v = o[d][r] * rl; sq += v * v; orow[32 * d] = (bf16)(cvtpk(v, 0.f) & 0xffffu); }
    sq = half_sum32(sq);
    if (r32b == 0) nrow[(size_t)crow(r, hib) * 8] = sq;
  }
  __syncthreads();
}
#undef KSWZ
#undef SBAR
}
#define LAS __attribute__((address_space(3)))
typedef unsigned short bf16_t;
typedef unsigned v4u __attribute__((ext_vector_type(4)));
typedef unsigned v2u __attribute__((ext_vector_type(2)));
typedef float v4f __attribute__((ext_vector_type(4)));
#define XB_TMO      128
#define XB_XCNT(j)  (256  + 64 * (j))
#define XB_XSUB(j)  (1280 + 64 * (j))
#define XB_XGEN(j)  (2304 + 64 * (j))
#define XB_TOP      3328
#define XB_TOPGEN   3392
#define XCD_BAR_WORDS 3456
#define XB_SPIN_CAP (1u << 18)

__device__ __forceinline__ unsigned xb_ld(unsigned* p)              { return __hip_atomic_load(p, __ATOMIC_RELAXED, __HIP_MEMORY_SCOPE_AGENT); }
__device__ __forceinline__ unsigned xb_add(unsigned* p, unsigned v) { return __hip_atomic_fetch_add(p, v, __ATOMIC_RELAXED, __HIP_MEMORY_SCOPE_AGENT); }
__device__ __forceinline__ unsigned xb_xcc_id() { return (unsigned)__builtin_amdgcn_s_getreg((3 << 11) | 20) & 0xFu; }
#define XB_SPIN(cond, bar) do { unsigned _sp = 0; while (cond) { __builtin_amdgcn_s_sleep(1); \
    if ((++_sp & 255u) == 0u) { if (xb_ld(&(bar)[XB_TMO])) break; if (_sp > XB_SPIN_CAP) { atomicAdd(&(bar)[XB_TMO], 1u); break; } } } } while (0)

struct XcdBarrier {
    unsigned* bar; unsigned x;
    volatile LAS unsigned* st;
};

__device__ __forceinline__ XcdBarrier xcd_barrier_post(unsigned* bar, volatile LAS unsigned* st) {
    XcdBarrier b; b.bar = bar; b.x = xb_xcc_id(); b.st = st;
    if (threadIdx.x == 0) (void)xb_add(&bar[XB_XCNT(b.x)], 1u);
    return b;
}
__device__ __forceinline__ void xcd_barrier_complete(unsigned* bar, unsigned x, unsigned& nloc, unsigned& nx) {
    const unsigned G = gridDim.x * gridDim.y * gridDim.z;
    unsigned sum, cnt, mine, sp = 0u;
    for (;;) {
        sum = 0u; cnt = 0u; mine = 0u;
#pragma unroll
        for (unsigned j = 0; j < 16; ++j) { const unsigned c = xb_ld(&bar[XB_XCNT(j)]); sum += c; cnt += (c > 0u) ? 1u : 0u; mine = (j == x) ? c : mine; }
        if (sum == G) break;
        __builtin_amdgcn_s_sleep(1);
        if ((++sp & 255u) == 0u) { if (xb_ld(&bar[XB_TMO])) break; if (sp > XB_SPIN_CAP) { atomicAdd(&bar[XB_TMO], 1u); break; } }
    }
    nloc = mine > 0u ? mine : 1u; nx = cnt > 0u ? cnt : 1u;
}

__device__ __forceinline__ void xcd_barrier(const XcdBarrier& b) {
    asm volatile("s_waitcnt vmcnt(0)" ::: "memory");
    __syncthreads();
    if (threadIdx.x == 0) {
        unsigned* bar = b.bar;
        __builtin_amdgcn_s_waitcnt(0);
        unsigned nloc = b.st[0], nx = b.st[1];
        if (nloc == 0u) { xcd_barrier_complete(bar, b.x, nloc, nx); b.st[0] = nloc; b.st[1] = nx; }
        const unsigned old = xb_add(&bar[XB_XSUB(b.x)], 1u);
        const unsigned gen = old / nloc;
        if (old + 1u == (gen + 1u) * nloc) {
            __builtin_amdgcn_fence(__ATOMIC_RELEASE, "agent");
            asm volatile("s_waitcnt vmcnt(0)" ::: "memory");
            const unsigned og = xb_add(&bar[XB_TOP], 1u);
            const unsigned tg = og / nx;
            if (og + 1u == (tg + 1u) * nx) xb_add(&bar[XB_TOPGEN], 1u);
            else XB_SPIN(xb_ld(&bar[XB_TOPGEN]) == tg, bar);
            __builtin_amdgcn_fence(__ATOMIC_ACQUIRE, "agent");
            xb_add(&bar[XB_XGEN(b.x)], 1u);
            asm volatile("s_waitcnt vmcnt(0)" ::: "memory");
        } else {
            XB_SPIN(xb_ld(&bar[XB_XGEN(b.x)]) == gen, bar);
            __builtin_amdgcn_fence(__ATOMIC_ACQUIRE, "agent");
            asm volatile("s_waitcnt vmcnt(0)" ::: "memory");
        }
    }
    __syncthreads();
}

constexpr int SEQ = 8192, DM = 2048, INC = 6144, FF = 8192, DEPTH = 4, NTHR = 512;
constexpr size_t SZ_WIN = (size_t)INC * DM * 2, SZ_WOUT = (size_t)DM * DM * 2, SZ_WMI = (size_t)FF * DM * 2, SZ_WMO = (size_t)DM * FF * 2;
constexpr size_t WS_WIN = 0, WS_WOUT = WS_WIN + DEPTH * SZ_WIN, WS_WMI = WS_WOUT + DEPTH * SZ_WOUT, WS_WMO = WS_WMI + DEPTH * SZ_WMI;
constexpr size_t WS_X = WS_WMO + DEPTH * SZ_WMO, WS_XB = WS_X + (size_t)SEQ * DM * 4, WS_PROJ = WS_XB + (size_t)SEQ * DM * 2, WS_MIX = WS_PROJ + (size_t)SEQ * INC * 2;
constexpr size_t WS_U = WS_MIX + (size_t)SEQ * DM * 2, WS_SS = WS_U + (size_t)SEQ * FF * 2, WS_COS = WS_SS + 9 * (size_t)SEQ * 32 * 4, WS_SIN = WS_COS + (size_t)SEQ * 32 * 4;
constexpr size_t WS_LAM = WS_SIN + (size_t)SEQ * 32 * 4, WS_BAR = WS_LAM + 256, WS_NASS = WS_BAR + 16384, WS_END = WS_NASS + (size_t)SEQ * 8 * 4;
#ifndef REP_P0
#define REP_P0 1
#endif
#ifndef REP_P1
#define REP_P1 1
#endif
#ifndef REP_P2
#define REP_P2 1
#endif
#ifndef REP_P3
#define REP_P3 1
#endif
#ifndef REP_P4
#define REP_P4 1
#endif
#ifndef REP_P6
#define REP_P6 1
#endif
#ifndef REP_P5
#define REP_P5 1
#endif
constexpr int LDS_BYTES = 139264;
static_assert(att::ATT_LDS <= LDS_BYTES && pg8::STAGE_BYTES <= LDS_BYTES, "LDS map");

struct Args {
    const float* in[15]; float* out; unsigned char* ws;
    double invf[32];
    float lam_init[4]; int pad[2];
};

__device__ __forceinline__ float wave_sum(float v) {
#pragma unroll
    for (int o = 1; o < 64; o <<= 1) v += __shfl_xor(v, o);
    return v;
}
__device__ __forceinline__ unsigned pk2(float lo, float hi) { return pg8::cvt_pk_bf16(lo, hi); }

struct TpItem { const float* W; bf16_t* WT; const float* gv; int K, N, k0, n0, krot; bool perm; };
__device__ __forceinline__ void tp_load(const TpItem& d, int lane, float (&w)[32]) {
    const float* wp = d.W + (size_t)(d.k0 + (lane >> 5)) * d.N + d.n0 + (lane & 31);
#pragma unroll
    for (int i = 0; i < 32; ++i) w[i] = wp[(size_t)(2 * i) * d.N];
}
__device__ __forceinline__ void tp_store(const TpItem& d, int lane, const float (&w)[32], LAS float* scr) {
    const int c = lane & 7;
    v4f g0 = {1.f, 1.f, 1.f, 1.f}, g1 = {1.f, 1.f, 1.f, 1.f};
    if (d.gv) { g0 = *(const v4f*)(d.gv + d.k0 + 8 * c); g1 = *(const v4f*)(d.gv + d.k0 + 8 * c + 4); }
#pragma unroll
    for (int i = 0; i < 32; ++i) scr[(2 * i + (lane >> 5)) * 33 + (lane & 31)] = w[i];
    asm volatile("s_waitcnt lgkmcnt(0)" ::: "memory");
#pragma unroll
    for (int j = 0; j < 4; ++j) { const int n = (lane >> 3) + 8 * j; const LAS float* s = scr + (8 * c) * 33 + n;
        v4u o; o.x = pk2(s[0 * 33] * g0.x, s[1 * 33] * g0.y); o.y = pk2(s[2 * 33] * g0.z, s[3 * 33] * g0.w); o.z = pk2(s[4 * 33] * g1.x, s[5 * 33] * g1.y); o.w = pk2(s[6 * 33] * g1.z, s[7 * 33] * g1.w);
        const int no = d.n0 + n; int dst = no;
        if (d.perm && no < 2048) { const int q = no & 63; dst = (no & ~63) + 8 * ((q & 31) >> 2) + 4 * (q >> 5) + (q & 3); }
        *(v4u*)(d.WT + (size_t)dst * d.K + ((d.k0 + d.krot) & (d.K - 1)) + 8 * c) = o; }
    asm volatile("s_waitcnt lgkmcnt(0)" ::: "memory");
}

__global__ void __launch_bounds__(NTHR, 2) fwd_megakernel(Args a) {
    extern __shared__ __attribute__((aligned(16))) unsigned char lds[];
    cg::grid_group grid = cg::this_grid();
#define GRID_SYNC() do { asm volatile("s_waitcnt vmcnt(0) lgkmcnt(0)" ::: "memory"); grid.sync(); __builtin_amdgcn_fence(__ATOMIC_ACQUIRE, "agent"); asm volatile("s_waitcnt vmcnt(0)" ::: "memory"); } while (0)
    const int tid = threadIdx.x, lane = tid & 63, wave = __builtin_amdgcn_readfirstlane(tid >> 6);
    const int G = gridDim.x, bx = blockIdx.x;
    const int gw = bx * 8 + wave, NGW = G * 8;
    unsigned char* ws = a.ws;
    bf16_t* WinT = (bf16_t*)(ws + WS_WIN); bf16_t* WoutT = (bf16_t*)(ws + WS_WOUT); bf16_t* WmiT = (bf16_t*)(ws + WS_WMI); bf16_t* WmoT = (bf16_t*)(ws + WS_WMO);
    float* X = (float*)(ws + WS_X); bf16_t* XB = (bf16_t*)(ws + WS_XB); bf16_t* PROJ = (bf16_t*)(ws + WS_PROJ); bf16_t* MIX = (bf16_t*)(ws + WS_MIX); bf16_t* U = (bf16_t*)(ws + WS_U);
    float* SS = (float*)(ws + WS_SS); float* COS = (float*)(ws + WS_COS); float* SIN = (float*)(ws + WS_SIN); float* LAM = (float*)(ws + WS_LAM); float* NASS = (float*)(ws + WS_NASS);
    LAS unsigned char* ldsl = (LAS unsigned char*)lds;
    volatile LAS unsigned* bst = (volatile LAS unsigned*)(ldsl + 135168);
    if (tid < 2) bst[tid] = 0u;
    __syncthreads();
    const XcdBarrier xbar = xcd_barrier_post((unsigned*)(ws + WS_BAR), bst);

    for (int rep = 0; rep < REP_P0; ++rep) {
        LAS float* scr = (LAS float*)(ldsl + wave * 16384);
        constexpr int I_IN = (DM / 64) * (INC / 32), I_OUT = (DM / 64) * (DM / 32), I_MI = (DM / 64) * (FF / 32), I_MO = (FF / 64) * (DM / 32), I_L = I_IN + I_OUT + I_MI + I_MO;
        auto mk = [&](int it) {
            TpItem d; const int l = it / I_L; int r = it % I_L; d.gv = nullptr; d.perm = false; d.krot = 0;
            if (r < I_IN) { d.W = a.in[2] + (size_t)l * DM * INC; d.K = DM; d.N = INC; d.WT = WinT + (size_t)l * INC * DM; d.gv = a.in[1] + l * DM; d.perm = true; }
            else if ((r -= I_IN) < I_OUT) {
                d.W = a.in[10] + (size_t)l * DM * DM; d.K = DM; d.N = DM; d.WT = WoutT + (size_t)l * DM * DM; d.krot = 1024; if (r / (DM / 32) >= 16) d.gv = a.in[8] + l * 1024 - 1024; }
            else if ((r -= I_OUT) < I_MI) { d.W = a.in[12] + (size_t)l * DM * FF; d.K = DM; d.N = FF; d.WT = WmiT + (size_t)l * FF * DM; d.gv = a.in[11] + l * DM; }
            else { r -= I_MI; d.W = a.in[13] + (size_t)l * FF * DM; d.K = FF; d.N = DM; d.WT = WmoT + (size_t)l * DM * FF; }
            const int nblk = d.N / 32; d.k0 = 64 * (r / nblk); d.n0 = 32 * (r % nblk);
            return d; };
        {
            constexpr int NIT = DEPTH * I_L; float wa[32], wb[32]; int it = gw;
            TpItem da = mk(it < NIT ? it : 0), db = da;
            if (it < NIT) tp_load(da, lane, wa);
            while (it < NIT) {
                const int itb = it + NGW; if (itb < NIT) { db = mk(itb); tp_load(db, lane, wb); }
                tp_store(da, lane, wa, scr);
                if (itb >= NIT) break;
                const int ita = itb + NGW; if (ita < NIT) { da = mk(ita); tp_load(da, lane, wa); }
                tp_store(db, lane, wb, scr);
                it = ita;
            }
        }
        for (int m = gw; m < SEQ; m += NGW) {
            const v4f* xr = (const v4f*)(a.in[0] + (size_t)m * DM) + lane; v2u* bo = (v2u*)(XB + (size_t)m * DM) + lane;
            float s = 0.f;
#pragma unroll
            for (int j = 0; j < 8; ++j) { const v4f v = xr[64 * j]; v2u w; w.x = pk2(v.x, v.y); w.y = pk2(v.z, v.w); bo[64 * j] = w; s += (v.x * v.x + v.y * v.y) + (v.z * v.z + v.w * v.w); }
            s = wave_sum(s);
            if (lane < 32) SS[(size_t)m * 32 + lane] = lane == 0 ? s : 0.f;
        }
        for (int i = bx * NTHR + tid; i < SEQ * 32; i += G * NTHR) {
            const int t = i >> 5, j = i & 31; double rev = (double)t * a.invf[j] * 0.15915494309189535; rev -= floor(rev);
            const float rf = (float)rev; COS[i] = __builtin_amdgcn_cosf(rf); SIN[i] = __builtin_amdgcn_sinf(rf);
        }
        if (bx == 0 && wave < DEPTH) {
            const int l = wave;
            const float p1 = wave_sum(a.in[3][l * 64 + lane] * a.in[4][l * 64 + lane]), p2 = wave_sum(a.in[5][l * 64 + lane] * a.in[6][l * 64 + lane]);
            if (lane == 0) LAM[l] = expf(p1) - expf(p2) + a.lam_init[l];
        }
    }
    GRID_SYNC();

#pragma unroll 1
    for (int l = 0; l < DEPTH; ++l) {
        const float* ss1 = SS + (size_t)(2 * l) * SEQ * 32; float* ss2 = SS + (size_t)(2 * l + 1) * SEQ * 32; float* ss3 = SS + (size_t)(2 * l + 2) * SEQ * 32;
        for (int rep = 0; rep < REP_P1; ++rep) {
            pg8::Gemm g{XB, WinT + (size_t)l * INC * DM, SEQ, INC, DM}; pg8::StaticOrder S; S.init(SEQ, INC, G, bx);
            pg8::EpiProj E{PROJ, ss1, COS, SIN};
            pg8::gemm_phase<pg8::EpiProj, pg8::StaticOrder, true, true>(ldsl, g, S, E);
        }
        xcd_barrier(xbar);
        {
            for (int rep = 0; rep < REP_P2; ++rep)
            for (int u = bx; u < 8 * 32; u += G) { const int h = u >> 5, rb = u & 31;
                att::na_unit(PROJ, MIX, NASS, h, rb, a.in[9] + ((size_t)l * 8 + h) * 15 * 31, (char*)lds); }
            const float lam = LAM[l], oml = 1.0f - a.lam_init[l];
            for (int rep = 0; rep < REP_P3; ++rep)
            for (int u = bx; u < 8 * 64; u += G) { const int h = u & 7, qb = u >> 3;
                att::diff_unit(PROJ, MIX, h, qb * 128, lam, oml, a.in[7] + l * 128, (char*)lds); }
        }
        xcd_barrier(xbar);
        for (int rep = 0; rep < REP_P4; ++rep) {
            pg8::Gemm g{MIX, WoutT + (size_t)l * DM * DM, SEQ, DM, DM}; pg8::StaticOrder S; S.init(SEQ, DM, G, bx);
            pg8::EpiResidMid E{(l == 0 && rep == 0) ? a.in[0] : (const float*)X, X, XB, ss2, (rep & 1) ? -1.f : 1.f, NASS};
            pg8::gemm_phase<pg8::EpiResidMid, pg8::StaticOrder, true, true>(ldsl, g, S, E);
        }
        xcd_barrier(xbar);
        for (int rep = 0; rep < REP_P5; ++rep) {
            pg8::Gemm g{XB, WmiT + (size_t)l * FF * DM, SEQ, FF, DM}; pg8::StaticOrder S; S.init(SEQ, FF, G, bx);
            pg8::EpiRelu2 E{U, ss2};
            pg8::gemm_phase<pg8::EpiRelu2, pg8::StaticOrder, true, true>(ldsl, g, S, E);
        }
        xcd_barrier(xbar);
        for (int rep = 0; rep < REP_P6; ++rep) {
            pg8::Gemm g{U, WmoT + (size_t)l * DM * FF, SEQ, DM, FF}; pg8::StaticOrder S; S.init(SEQ, DM, G, bx);
            pg8::EpiResid E{X, X, XB, ss3, (rep & 1) ? -1.f : 1.f, nullptr};
            pg8::gemm_phase<pg8::EpiResid, pg8::StaticOrder, true, true>(ldsl, g, S, E);
        }
        xcd_barrier(xbar);
    }
    {
        const float* fg = a.in[14]; const float* ssf = SS + (size_t)8 * SEQ * 32;
        int lnf = threadIdx.x; asm volatile("" : "+v"(lnf)); lnf &= 63;
        for (int m = gw; m < SEQ; m += NGW) {
            const float rn = rsqrtf(wave_sum(lnf < 32 ? ssf[(size_t)m * 32 + lnf] : 0.f) * (1.0f / 2048.0f) + 1e-6f);
            const v4f* xr = (const v4f*)(X + (size_t)m * DM) + lnf; v4f* xo = (v4f*)(a.out + (size_t)m * DM) + lnf; const v4f* gp = (const v4f*)fg + lnf;
#pragma unroll
            for (int j = 0; j < 8; ++j) xo[64 * j] = xr[64 * j] * rn * gp[64 * j];
        }
    }
}

extern "C" void kernel_launch(void* const* d_in, const int* in_sizes, int n_in, void* d_out, int out_size, void* d_ws, size_t ws_size, hipStream_t stream) {
    static int grid_blocks = 0;
    if (grid_blocks == 0) {
        if (n_in != 15 || out_size != SEQ * DM || ws_size < WS_END) { fprintf(stderr, "kernel_launch: unexpected shapes (n_in %d out %d ws %zu, need %zu)\n", n_in, out_size, ws_size, (size_t)WS_END); grid_blocks = -1; return; }
        int dev = 0, cus = 0, per_cu = 0;
        hipGetDevice(&dev); hipDeviceGetAttribute(&cus, hipDeviceAttributeMultiprocessorCount, dev);
        if (hipFuncSetAttribute((const void*)fwd_megakernel, hipFuncAttributeMaxDynamicSharedMemorySize, LDS_BYTES) != hipSuccess) { fprintf(stderr, "kernel_launch: hipFuncSetAttribute failed\n"); grid_blocks = -1; return; }
        if (hipOccupancyMaxActiveBlocksPerMultiprocessor(&per_cu, (const void*)fwd_megakernel, NTHR, LDS_BYTES) != hipSuccess || per_cu < 1) { fprintf(stderr, "kernel_launch: occupancy query gave %d\n", per_cu); per_cu = 1; (void)hipGetLastError(); }
        grid_blocks = cus * per_cu;
    }
    if (grid_blocks < 0) return;
    Args a{};
    for (int i = 0; i < 15; ++i) a.in[i] = (const float*)d_in[i];
    a.out = (float*)d_out; a.ws = (unsigned char*)d_ws;
    for (int j = 0; j < 32; ++j) a.invf[j] = 1.0 / pow(10000.0, (double)(2 * j) / 64.0);
    for (int l = 0; l < 4; ++l) a.lam_init[l] = (float)(0.8 - 0.6 * exp(-0.3 * l));
    if (hipMemsetAsync((char*)d_ws + WS_BAR, 0, XCD_BAR_WORDS * 4, stream) != hipSuccess) { fprintf(stderr, "kernel_launch: hipMemsetAsync of the barrier words failed\n"); return; }
    void* args[] = {&a};
    hipError_t e = hipLaunchCooperativeKernel((void*)fwd_megakernel, dim3(grid_blocks), dim3(NTHR), args, LDS_BYTES, stream);
    if (e != hipSuccess) fprintf(stderr, "cooperative launch failed: %s (grid %d)\n", hipGetErrorString(e), grid_blocks);
}
```

```cpp
#include <hip/hip_runtime.h>
#include <hip/hip_cooperative_groups.h>
#include <cstdio>
#include <cstdint>
namespace cg = cooperative_groups;
namespace pg8 {
#define PG8_LAS __attribute__((address_space(3)))
typedef unsigned short bf16_t;
typedef short bf16x8 __attribute__((ext_vector_type(8)));
typedef float f32x4 __attribute__((ext_vector_type(4)));
typedef unsigned u32x4 __attribute__((ext_vector_type(4)));
constexpr int BM = 256, BK = 64, HALF = 128, HTB = HALF * BK * 2  , STAGE_BYTES = 8 * HTB, NXCD = 8, WGM = 8;

__host__ __device__ __forceinline__ int lds_byte(int r, int c) { const int st = (r >> 4) * 2 + (c >> 5), rr = r & 15, cc = c & 31, ob = rr * 64 + cc * 2; return st * 1024 + (ob ^ (((ob >> 9) & 1) << 5)); }
__host__ __device__ __forceinline__ void stage_rc(int b, int& R, int& C) { const int st = b / 1024, sb = b % 1024, swz = sb ^ (((sb >> 9) & 1) << 5); R = (st >> 1) * 16 + swz / 64; C = (st & 1) * 32 + (swz % 64) / 2; }
__host__ __device__ __forceinline__ int perm32(int rho) { const int n = rho >> 4, i = rho & 15; return 8 * (i >> 2) + 4 * n + (i & 3); }

struct Unit { int pm, pn; };
struct Gemm { const bf16_t* A; const bf16_t* Bt; int M, N, K; };

struct StaticOrder {
    int nM, nN, nwg, G, c;
    __host__ __device__ void init(int M, int N, int G_, int c_) { nM = M / BM; nN = N / BM; nwg = nM * nN; G = G_; c = c_; }
    __host__ __device__ bool next(int i, Unit& u) const {
        const long L = (long)i * G + c; if (L >= nwg) return false;
        int wgid = (int)L; { const int q = nwg / NXCD, r = nwg % NXCD, xcd = wgid % NXCD, off = wgid / NXCD; wgid = (xcd < r ? xcd * (q + 1) : r * (q + 1) + (xcd - r) * q) + off; }
        const int nig = WGM * nN, gid = wgid / nig, fm = gid * WGM, gsz = (nM - fm) < WGM ? (nM - fm) : WGM;
        u.pm = fm + ((wgid % nig) % gsz); u.pn = (wgid % nig) / gsz; return true;
    }
    __device__ __forceinline__ void a_ready(const Unit&) const {}
    __device__ __forceinline__ void done(const Unit&) const {}
};

__device__ __forceinline__ unsigned cvt_pk_bf16(float lo, float hi) { unsigned r; asm volatile("v_cvt_pk_bf16_f32 %0, %1, %2" : "=v"(r) : "v"(lo), "v"(hi)); return r; }
typedef float f32x2 __attribute__((ext_vector_type(2)));
typedef unsigned u32x2 __attribute__((ext_vector_type(2)));
constexpr float RMS_EPS = 1e-6f;
__device__ __forceinline__ float row_rstd(const float* ss, int row, int fq) {
    const f32x4* sp = (const f32x4*)(ss + (size_t)row * 32 + fq * 8); const f32x4 a = sp[0], b = sp[1];
    float s = ((a[0] + a[1]) + (a[2] + a[3])) + ((b[0] + b[1]) + (b[2] + b[3]));
    s += __shfl_xor(s, 16); s += __shfl_xor(s, 32);
    return rsqrtf(s * (1.0f / 2048.0f) + RMS_EPS);
}
struct EpiProj {
    static constexpr bool PERM = true, AFTER_DRAIN = false, MIDK = false;
    bf16_t* O; const float* ss; const float* cosT; const float* sinT;
    __device__ __forceinline__ void operator()(const f32x4 (&acc)[2][2][4][2], const Unit& u, int wr, int wc, int fr, int fq) const {
        const int row0 = u.pm * BM + wr * 64 + fr; const int colt = u.pn * BM;
        const bool rope = colt < 2048;
        const float qs = colt < 1024 ? 0.125f * 1.4426950408889634f : 1.f;
        const int g = (wc & 1) * 4 + fq;
        const int pos0 = colt + wc * 32 + 8 * fq;
        const int rbase = colt + 64 * (wc >> 1) + 4 * g;
#pragma unroll
        for (int ai = 0; ai < 2; ++ai)
#pragma unroll
            for (int m = 0; m < 4; ++m) {
                const int row = row0 + ai * HALF + m * 16;
                const float rs = row_rstd(ss, row, fq) * qs;
                bf16_t* rowp = O + (size_t)row * 6144;
                if (rope) {
                    const f32x4 c4 = *(const f32x4*)(cosT + row * 32 + 4 * g), s4 = *(const f32x4*)(sinT + row * 32 + 4 * g);
#pragma unroll
                    for (int bj = 0; bj < 2; ++bj) {
                        const f32x4 v0 = acc[ai][bj][m][0] * rs, v1 = acc[ai][bj][m][1] * rs;
                        const f32x4 o1 = v0 * c4 - v1 * s4, o2 = v1 * c4 + v0 * s4;
                        u32x2 w1, w2; w1.x = cvt_pk_bf16(o1[0], o1[1]); w1.y = cvt_pk_bf16(o1[2], o1[3]); w2.x = cvt_pk_bf16(o2[0], o2[1]); w2.y = cvt_pk_bf16(o2[2], o2[3]);
                        *(u32x2*)(rowp + rbase + bj * HALF) = w1; *(u32x2*)(rowp + rbase + bj * HALF + 32) = w2;
                    }
                } else {
#pragma unroll
                    for (int bj = 0; bj < 2; ++bj) {
                        const f32x4 v0 = acc[ai][bj][m][0] * rs, v1 = acc[ai][bj][m][1] * rs;
                        u32x4 w; w.x = cvt_pk_bf16(v0[0], v0[1]); w.y = cvt_pk_bf16(v0[2], v0[3]); w.z = cvt_pk_bf16(v1[0], v1[1]); w.w = cvt_pk_bf16(v1[2], v1[3]);
                        *(u32x4*)(rowp + pos0 + bj * HALF) = w;
                    }
                }
            }
    }
};
struct EpiRelu2 {
    static constexpr bool PERM = true, AFTER_DRAIN = false, MIDK = false;
    bf16_t* O; const float* ss;
    __device__ __forceinline__ void operator()(const f32x4 (&acc)[2][2][4][2], const Unit& u, int wr, int wc, int fr, int fq) const {
        const int row0 = u.pm * BM + wr * 64 + fr; const int pos0 = u.pn * BM + wc * 32 + 8 * fq;
#pragma unroll
        for (int ai = 0; ai < 2; ++ai)
#pragma unroll
            for (int m = 0; m < 4; ++m) {
                const int row = row0 + ai * HALF + m * 16;
                const float rs = row_rstd(ss, row, fq);
                bf16_t* rowp = O + (size_t)row * 8192 + pos0;
#pragma unroll
                for (int bj = 0; bj < 2; ++bj) {
                    f32x4 v0 = acc[ai][bj][m][0] * rs, v1 = acc[ai][bj][m][1] * rs;
#pragma unroll
                    for (int e = 0; e < 4; ++e) { v0[e] = fmaxf(v0[e], 0.f); v1[e] = fmaxf(v1[e], 0.f); }
                    v0 = v0 * v0; v1 = v1 * v1;
                    u32x4 w; w.x = cvt_pk_bf16(v0[0], v0[1]); w.y = cvt_pk_bf16(v0[2], v0[3]); w.z = cvt_pk_bf16(v1[0], v1[1]); w.w = cvt_pk_bf16(v1[2], v1[3]);
                    *(u32x4*)(rowp + bj * HALF) = w;
                }
            }
    }
};
template <bool MID> struct EpiResidT {
    static constexpr bool PERM = false, AFTER_DRAIN = false, MIDK = MID;
    const float* Xin; float* X; bf16_t* XB; float* ssout; float sign; const float* nass;
    __device__ __forceinline__ void mid(f32x4 (&acc)[2][2][4][2], const Unit& u, int wr, int wc, int fr, int fq) const {
        int t_ = threadIdx.x; asm volatile("" : "+v"(t_));
        const int row0 = u.pm * BM + wr * 64 + (t_ & 15);
#pragma unroll
        for (int ai = 0; ai < 2; ++ai)
#pragma unroll
            for (int m = 0; m < 4; ++m) {
                const f32x4* sp = (const f32x4*)(nass + (size_t)(row0 + ai * HALF + m * 16) * 8); const f32x4 a = sp[0], b = sp[1];
                const float rn = rsqrtf((((a[0] + a[1]) + (a[2] + a[3])) + ((b[0] + b[1]) + (b[2] + b[3]))) * (1.0f / 1024.0f) + RMS_EPS);
#pragma unroll
                for (int bj = 0; bj < 2; ++bj)
#pragma unroll
                    for (int n = 0; n < 2; ++n) acc[ai][bj][m][n] = acc[ai][bj][m][n] * rn;
            }
    }
    __device__ __forceinline__ void operator()(const f32x4 (&acc)[2][2][4][2], const Unit& u, int wr, int wc, int fr, int fq) const {
        const int row0 = u.pm * BM + wr * 64 + fr; const int col0 = u.pn * BM + wc * 32 + 4 * fq;
#pragma unroll
        for (int ai = 0; ai < 2; ++ai)
#pragma unroll
            for (int m = 0; m < 4; ++m) {
                const int row = row0 + ai * HALF + m * 16; float sq = 0.f;
#pragma unroll
                for (int bj = 0; bj < 2; ++bj)
#pragma unroll
                    for (int n = 0; n < 2; ++n) {
                        const size_t off = (size_t)row * 2048 + col0 + bj * HALF + n * 16;
                        const f32x4 xv = *(const f32x4*)(Xin + off) + acc[ai][bj][m][n] * sign;
                        *(f32x4*)(X + off) = xv;
                        u32x2 w; w.x = cvt_pk_bf16(xv[0], xv[1]); w.y = cvt_pk_bf16(xv[2], xv[3]);
                        *(u32x2*)(XB + off) = w;
                        sq += (xv[0] * xv[0] + xv[1] * xv[1]) + (xv[2] * xv[2] + xv[3] * xv[3]);
                    }
                sq += __shfl_xor(sq, 16); sq += __shfl_xor(sq, 32);
                if (fq == 0) ssout[(size_t)row * 32 + u.pn * 4 + wc] = sq;
            }
    }
};
typedef EpiResidT<false> EpiResid; typedef EpiResidT<true> EpiResidMid;
template <class Epi, class Sched, bool ALIGN_EPI = false, bool SP2 = false>
__device__ __forceinline__ void gemm_phase(PG8_LAS unsigned char* lds, const Gemm g, const Sched& S, const Epi& E) {
    int tid_ = threadIdx.x; asm volatile("" : "+v"(tid_));
    const int tid = tid_, wid = __builtin_amdgcn_readfirstlane(tid >> 6), lane = tid & 63, wr = wid >> 2, wc = wid & 3, fr = lane & 15, fq = lane >> 4;
    const int K = g.K, nt = K / BK;
    unsigned voffA[2], voffB[2];
#pragma unroll
    for (int i = 0; i < 2; ++i) { int R, C; stage_rc(tid * 16 + i * 8192, R, C); const int Rb = Epi::PERM ? ((R & ~31) + perm32(R & 31)) : R;
        voffA[i] = (unsigned)(R * K + C) * 2u; voffB[i] = (unsigned)(Rb * K + C) * 2u; }
    const size_t kstep = (size_t)(BK * 2);
    const size_t hstep = (size_t)HALF * K * 2;
    const size_t tstep = 2 * hstep;
    const unsigned ldsw = (unsigned)wid * 1024u;
    const int aoff = lds_byte(wr * 64 + fr, fq * 8), boff = lds_byte(wc * 32 + fr, fq * 8);
#define PG8_SA(b, h) (((b) * 2 + (h)) * HTB)
#define PG8_SB(b, h) ((4 + (b) * 2 + (h)) * HTB)
#define PG8_STAGE(bufoff, gbase, voff) do { _Pragma("unroll") for (int _i = 0; _i < 2; ++_i) \
        __builtin_amdgcn_global_load_lds((const unsigned*)((const char*)(gbase) + (voff)[_i]), (PG8_LAS unsigned*)(lds + (bufoff) + ldsw + _i * 8192), 16, 0, 0); } while (0)
#define PG8_LDA(dst, b, h) do { _Pragma("unroll") for (int m = 0; m < 4; ++m) _Pragma("unroll") for (int k = 0; k < 2; ++k) dst[m][k] = *(const PG8_LAS bf16x8*)(lds + PG8_SA(b, h) + aoff + m * 2048 + k * 1024); } while (0)
#define PG8_LDB(dst, b, h) do { _Pragma("unroll") for (int n = 0; n < 2; ++n) _Pragma("unroll") for (int k = 0; k < 2; ++k) dst[n][k] = *(const PG8_LAS bf16x8*)(lds + PG8_SB(b, h) + boff + n * 2048 + k * 1024); } while (0)
#define PG8_MMA(ai, bj, At, Bt) do { __builtin_amdgcn_s_setprio(1); _Pragma("unroll") for (int m = 0; m < 4; ++m) _Pragma("unroll") for (int n = 0; n < 2; ++n) _Pragma("unroll") for (int k = 0; k < 2; ++k) \
        acc[ai][bj][m][n] = __builtin_amdgcn_mfma_f32_16x16x32_bf16(Bt[n][k], At[m][k], acc[ai][bj][m][n], 0, 0, 0); __builtin_amdgcn_s_setprio(0); } while (0)
#define PG8_WAIT_V(n) asm volatile("s_waitcnt vmcnt(" #n ")" ::: "memory")
#define PG8_WAIT_L(n) asm volatile("s_waitcnt lgkmcnt(" #n ")" ::: "memory")
#define PG8_BAR __builtin_amdgcn_s_barrier()
#define PG8_SCHED __builtin_amdgcn_sched_barrier(0)
    Unit cur, nxt; int ui = 0;
    if (!S.next(0, cur)) return;
    f32x4 acc[2][2][4][2];
#pragma unroll
    for (int a = 0; a < 2; ++a)
#pragma unroll
        for (int b = 0; b < 2; ++b)
#pragma unroll
            for (int m = 0; m < 4; ++m)
#pragma unroll
                for (int n = 0; n < 2; ++n) acc[a][b][m][n] = (f32x4){0.f, 0.f, 0.f, 0.f};
    bf16x8 At[4][2], B0[2][2], B1[2][2];
    const char* cA = (const char*)g.A + (size_t)cur.pm * tstep; const char* cB = (const char*)g.Bt + (size_t)cur.pn * tstep;
    S.a_ready(cur);
    if constexpr (SP2) {
        PG8_STAGE(PG8_SB(0, 0), cB, voffB); PG8_STAGE(PG8_SB(0, 1), cB + hstep, voffB); PG8_STAGE(PG8_SA(0, 0), cA, voffA); PG8_STAGE(PG8_SA(0, 1), cA + hstep, voffA);
        if (wr == 1) PG8_BAR;
        PG8_WAIT_V(2); PG8_BAR;
        PG8_STAGE(PG8_SB(1, 0), cB + kstep, voffB); PG8_STAGE(PG8_SA(1, 0), cA + kstep, voffA); PG8_STAGE(PG8_SB(1, 1), cB + hstep + kstep, voffB);
        PG8_WAIT_V(6); PG8_BAR;
    } else {
        PG8_STAGE(PG8_SB(0, 0), cB, voffB); PG8_STAGE(PG8_SA(0, 0), cA, voffA); PG8_STAGE(PG8_SB(0, 1), cB + hstep, voffB); PG8_STAGE(PG8_SA(0, 1), cA + hstep, voffA);
        if (wr == 1) PG8_BAR;
        PG8_WAIT_V(4); PG8_BAR;
        PG8_STAGE(PG8_SB(1, 0), cB + kstep, voffB); PG8_STAGE(PG8_SA(1, 0), cA + kstep, voffA); PG8_STAGE(PG8_SB(1, 1), cB + hstep + kstep, voffB);
        PG8_WAIT_V(6); PG8_BAR;
    }
    for (;;) {
        const bool has_next = S.next(ui + 1, nxt);
        const char* nA = has_next ? (const char*)g.A + (size_t)nxt.pm * tstep : cA; const char* nB = has_next ? (const char*)g.Bt + (size_t)nxt.pn * tstep : cB;
        for (int t = 0; t < nt; t += 2) {
            if constexpr (Epi::MIDK) { if (t == nt / 2) E.mid(acc, cur, wr, wc, fr, fq); }
            const bool last = (t == nt - 2);
            const char* a1 = cA + (size_t)(t + 1) * kstep;
            const char* a2 = last ? nA : cA + (size_t)(t + 2) * kstep; const char* b2 = last ? nB : cB + (size_t)(t + 2) * kstep;
            const char* a3 = a2 + kstep; const char* b3 = b2 + kstep;
            if (last && has_next) S.a_ready(nxt);
            if constexpr (SP2) {
            PG8_LDB(B0, 0, 0); PG8_LDB(B1, 0, 1); PG8_SCHED; PG8_LDA(At, 0, 0); PG8_STAGE(PG8_SA(1, 1), a1 + hstep, voffA);
            PG8_WAIT_V(8); PG8_WAIT_L(0); PG8_BAR; PG8_MMA(0, 0, At, B0); PG8_MMA(0, 1, At, B1); PG8_BAR; PG8_SCHED;
            PG8_LDA(At, 0, 1); PG8_STAGE(PG8_SB(0, 0), b2, voffB); PG8_STAGE(PG8_SB(0, 1), b2 + hstep, voffB); PG8_STAGE(PG8_SA(0, 0), a2, voffA);
            PG8_WAIT_V(8); PG8_WAIT_L(0); PG8_BAR; PG8_MMA(1, 0, At, B0); PG8_MMA(1, 1, At, B1); PG8_BAR; PG8_SCHED;
            PG8_LDB(B0, 1, 0); PG8_LDB(B1, 1, 1); PG8_SCHED; PG8_LDA(At, 1, 0); PG8_STAGE(PG8_SA(0, 1), a2 + hstep, voffA);
            PG8_WAIT_V(8); PG8_WAIT_L(0); PG8_BAR; PG8_MMA(0, 0, At, B0); PG8_MMA(0, 1, At, B1); PG8_BAR; PG8_SCHED;
            PG8_LDA(At, 1, 1); PG8_STAGE(PG8_SB(1, 0), b3, voffB); PG8_STAGE(PG8_SB(1, 1), b3 + hstep, voffB); PG8_STAGE(PG8_SA(1, 0), a3, voffA);
            PG8_WAIT_V(8); PG8_WAIT_L(0); PG8_BAR; PG8_MMA(1, 0, At, B0); PG8_MMA(1, 1, At, B1); PG8_BAR; PG8_SCHED;
            } else {
            PG8_LDB(B0, 0, 0); PG8_SCHED; PG8_LDA(At, 0, 0); PG8_STAGE(PG8_SA(1, 1), a1 + hstep, voffA);
            PG8_WAIT_L(8); PG8_BAR; PG8_WAIT_L(0); PG8_MMA(0, 0, At, B0); PG8_BAR; PG8_SCHED;
            PG8_LDB(B1, 0, 1); PG8_STAGE(PG8_SB(0, 0), b2, voffB);
            PG8_BAR; PG8_WAIT_L(0); PG8_MMA(0, 1, At, B1); PG8_BAR;
            PG8_LDA(At, 0, 1); PG8_STAGE(PG8_SA(0, 0), a2, voffA);
            PG8_BAR; PG8_WAIT_L(0); PG8_MMA(1, 0, At, B0); PG8_BAR; PG8_SCHED;
            PG8_STAGE(PG8_SB(0, 1), b2 + hstep, voffB);
            PG8_WAIT_V(6); PG8_BAR; PG8_MMA(1, 1, At, B1); PG8_BAR;
            PG8_LDB(B0, 1, 0); PG8_SCHED; PG8_LDA(At, 1, 0); PG8_STAGE(PG8_SA(0, 1), a2 + hstep, voffA);
            PG8_WAIT_L(8); PG8_BAR; PG8_WAIT_L(0); PG8_MMA(0, 0, At, B0); PG8_BAR; PG8_SCHED;
            PG8_LDB(B1, 1, 1); PG8_STAGE(PG8_SB(1, 0), b3, voffB);
            PG8_BAR; PG8_WAIT_L(0); PG8_MMA(0, 1, At, B1); PG8_BAR;
            PG8_LDA(At, 1, 1); PG8_STAGE(PG8_SA(1, 0), a3, voffA);
            PG8_BAR; PG8_WAIT_L(0); PG8_MMA(1, 0, At, B0); PG8_BAR; PG8_SCHED;
            PG8_STAGE(PG8_SB(1, 1), b3 + hstep, voffB);
            PG8_WAIT_V(6); PG8_BAR; PG8_MMA(1, 1, At, B1); PG8_BAR;
            }
        }
        if constexpr (ALIGN_EPI) { if (wr == 0) PG8_BAR; }
        if constexpr (!Epi::AFTER_DRAIN) { E(acc, cur, wr, wc, fr, fq); S.done(cur); }
        if (!has_next) break;
#pragma unroll
        for (int a = 0; a < 2; ++a)
#pragma unroll
            for (int b = 0; b < 2; ++b)
#pragma unroll
                for (int m = 0; m < 4; ++m)
#pragma unroll
                    for (int n = 0; n < 2; ++n) acc[a][b][m][n] = (f32x4){0.f, 0.f, 0.f, 0.f};
        cur = nxt; cA = nA; cB = nB; ++ui;
        if constexpr (ALIGN_EPI) { if (wr == 1) PG8_BAR; }
    }
    PG8_WAIT_V(0);
    if constexpr (!ALIGN_EPI) { if (wr == 0) PG8_BAR; }
    PG8_BAR;
    if constexpr (Epi::AFTER_DRAIN) { E.fused(acc, cur, wr, wc, fr, fq, lds, wid, lane); S.done(cur); }
#undef PG8_SA
#undef PG8_SB
#undef PG8_STAGE
#undef PG8_LDA
#undef PG8_LDB
#undef PG8_MMA
#undef PG8_WAIT_V
#undef PG8_WAIT_L
#undef PG8_BAR
#undef PG8_SCHED
}
}
namespace att {
typedef unsigned short bf16;
using bf16x8 = __attribute__((ext_vector_type(8))) short;
using s16x4  = __attribute__((ext_vector_type(4))) short;
using f32x16 = __attribute__((ext_vector_type(16))) float;
using u32x4  = __attribute__((ext_vector_type(4))) unsigned;
constexpr int LDP = 6144;
constexpr int SHM_V = 64 * 128 * 2, SHM_K = 64 * 128 * 2;
constexpr int OFF_WS = 2 * SHM_V + 2 * SHM_K, OFF_RPB = OFF_WS + 8 * 64 * 4, ATT_LDS = OFF_RPB + 2048;
constexpr float THR = 8.f;
#define KSWZ(row, colB) ((row) * 256 + ((colB) ^ (((row) & 7) << 4)))
#define SBAR() __builtin_amdgcn_sched_barrier(0)
__device__ __forceinline__ int crow(int r, int hi) { return (r & 3) + 8 * (r >> 2) + 4 * hi; }
__device__ __forceinline__ unsigned cvtpk(float lo, float hi) {
  unsigned r; asm volatile("v_cvt_pk_bf16_f32 %0, %1, %2" : "=v"(r) : "v"(lo), "v"(hi)); return r;
}
__device__ __forceinline__ bf16x8 ld8(const bf16* p) { return *reinterpret_cast<const bf16x8*>(p); }

template <int MODE> struct Cfg;
template <> struct Cfg<0> { static constexpr int ND0 = 4; static constexpr float SCALE = 0.125f; };
template <> struct Cfg<1> { static constexpr int ND0 = 8; static constexpr float SCALE = 0.088388347648318440f; };

template <int MODE>
__device__ __forceinline__ void partialSM(f32x16& p0, f32x16& p1, float& m_reg, float& mn, float& alpha) {
  constexpr float SCALE = Cfg<MODE>::SCALE;
  constexpr float C = SCALE * 1.4426950408889634f;
  float pmax = p0[0];
#pragma unroll
  for (int r = 1; r < 16; ++r) pmax = fmaxf(pmax, p0[r]);
#pragma unroll
  for (int r = 0; r < 16; ++r) pmax = fmaxf(pmax, p1[r]);
  { auto rr = __builtin_amdgcn_permlane32_swap(__float_as_uint(pmax), __float_as_uint(pmax), false, false);
    pmax = fmaxf(__uint_as_float(rr[0]), __uint_as_float(rr[1])); }
  if (__builtin_expect(__all(pmax - m_reg <= THR / SCALE), 1)) { mn = m_reg; alpha = 1.f; }
  else { mn = fmaxf(m_reg, pmax); alpha = __builtin_amdgcn_exp2f((m_reg - mn) * C); m_reg = mn; }
  float mnC = -mn * C;
#pragma unroll
  for (int r = 0; r < 16; ++r) p0[r] = fmaf(p0[r], C, mnC);
#pragma unroll
  for (int r = 0; r < 16; ++r) p1[r] = fmaf(p1[r], C, mnC);
#pragma unroll
  for (int r = 0; r < 16; ++r) p0[r] = __builtin_amdgcn_exp2f(p0[r]);
}
__device__ __forceinline__ void finishSM(f32x16& p0, f32x16& p1, float alpha, float& l_reg, bf16x8& pa0, bf16x8& pa1, bf16x8& pa2, bf16x8& pa3) {
#pragma unroll
  for (int r = 0; r < 16; ++r) p1[r] = __builtin_amdgcn_exp2f(p1[r]);
  float ps = 0;
#pragma unroll
  for (int r = 0; r < 16; ++r) ps += p0[r];
#pragma unroll
  for (int r = 0; r < 16; ++r) ps += p1[r];
  { auto rr = __builtin_amdgcn_permlane32_swap(__float_as_uint(ps), __float_as_uint(ps), false, false);
    ps = __uint_as_float(rr[0]) + __uint_as_float(rr[1]); }
  l_reg = l_reg * alpha + ps;
#define PK4(P, BASE, OUT) do { u32x4 w = {cvtpk(P[BASE + 0], P[BASE + 1]), cvtpk(P[BASE + 2], P[BASE + 3]), cvtpk(P[BASE + 4], P[BASE + 5]), cvtpk(P[BASE + 6], P[BASE + 7])}; \
    OUT = *reinterpret_cast<bf16x8*>(&w); } while (0)
  PK4(p0, 0, pa0); PK4(p0, 8, pa1); PK4(p1, 0, pa2); PK4(p1, 8, pa3);
#undef PK4
}
__device__ __forceinline__ void finishSM_ns(f32x16& p0, f32x16& p1, bf16x8& pa0, bf16x8& pa1, bf16x8& pa2, bf16x8& pa3) {
#pragma unroll
  for (int r = 0; r < 16; ++r) p1[r] = __builtin_amdgcn_exp2f(p1[r]);
#define PK4(P, BASE, OUT) do { u32x4 w = {cvtpk(P[BASE + 0], P[BASE + 1]), cvtpk(P[BASE + 2], P[BASE + 3]), cvtpk(P[BASE + 4], P[BASE + 5]), cvtpk(P[BASE + 6], P[BASE + 7])}; \
    OUT = *reinterpret_cast<bf16x8*>(&w); } while (0)
  PK4(p0, 0, pa0); PK4(p0, 8, pa1); PK4(p1, 0, pa2); PK4(p1, 8, pa3);
#undef PK4
}
__device__ __forceinline__ void sm_sum(const f32x16& p0, const f32x16& p1, float& ps) {
  ps = 0;
#pragma unroll
  for (int r = 0; r < 16; ++r) ps += p0[r];
#pragma unroll
  for (int r = 0; r < 16; ++r) ps += p1[r];
}
template <int MODE>
__device__ __forceinline__ void sm_lmax(float ps, float alpha_prev, float& l_reg, const f32x16& p0, const f32x16& p1, float& m_reg, float& mn, float& alpha, float& mnC) {
  constexpr float SCALE = Cfg<MODE>::SCALE; constexpr float C = SCALE * 1.4426950408889634f;
  { auto rr = __builtin_amdgcn_permlane32_swap(__float_as_uint(ps), __float_as_uint(ps), false, false);
    ps = __uint_as_float(rr[0]) + __uint_as_float(rr[1]); }
  l_reg = l_reg * alpha_prev + ps;
  float pmax = p0[0];
#pragma unroll
  for (int r = 1; r < 16; ++r) pmax = fmaxf(pmax, p0[r]);
#pragma unroll
  for (int r = 0; r < 16; ++r) pmax = fmaxf(pmax, p1[r]);
  { auto rr = __builtin_amdgcn_permlane32_swap(__float_as_uint(pmax), __float_as_uint(pmax), false, false);
    pmax = fmaxf(__uint_as_float(rr[0]), __uint_as_float(rr[1])); }
  if (__builtin_expect(__all(pmax - m_reg <= THR / SCALE), 1)) { mn = m_reg; alpha = 1.f; }
  else { mn = fmaxf(m_reg, pmax); alpha = __builtin_amdgcn_exp2f((m_reg - mn) * C); m_reg = mn; }
  mnC = -mn * C;
}
template <int MODE>
__device__ __forceinline__ void sm_fma(f32x16& p0, f32x16& p1, float mnC) {
  constexpr float C = Cfg<MODE>::SCALE * 1.4426950408889634f;
#pragma unroll
  for (int r = 0; r < 16; ++r) p0[r] = fmaf(p0[r], C, mnC);
#pragma unroll
  for (int r = 0; r < 16; ++r) p1[r] = fmaf(p1[r], C, mnC);
}
__device__ __forceinline__ void sm_exp0(f32x16& p0) {
#pragma unroll
  for (int r = 0; r < 16; ++r) p0[r] = __builtin_amdgcn_exp2f(p0[r]);
}
template <int ND0>
__device__ __forceinline__ void qkt(f32x16& p0, f32x16& p1, const bf16* Ks, const bf16x8* qr, int r32, int hi, int kcb) {
  p0 = f32x16{}; p1 = f32x16{};
#pragma unroll
  for (int d0 = 0; d0 < ND0; ++d0) { int cb = kcb + (d0 * 16 + hi * 8) * 2;
    bf16x8 b0 = *reinterpret_cast<const bf16x8*>((const char*)Ks + KSWZ(r32, cb));
    bf16x8 b1 = *reinterpret_cast<const bf16x8*>((const char*)Ks + KSWZ(32 + r32, cb));
    p0 = __builtin_amdgcn_mfma_f32_32x32x16_bf16(b0, qr[d0], p0, 0, 0, 0);
    p1 = __builtin_amdgcn_mfma_f32_32x32x16_bf16(b1, qr[d0], p1, 0, 0, 0); }
}
constexpr float THRL = 8.f * 1.4426950408889634f;
template <int ND0>
__device__ __forceinline__ void qk_rd(bf16x8 (&kb0)[ND0], bf16x8 (&kb1)[ND0], const bf16* Ks, int r32, int hi, int kcb) {
#pragma unroll
  for (int d0 = 0; d0 < ND0; ++d0) { int cb = kcb + (d0 * 16 + hi * 8) * 2;
    kb0[d0] = *reinterpret_cast<const bf16x8*>((const char*)Ks + KSWZ(r32, cb));
    kb1[d0] = *reinterpret_cast<const bf16x8*>((const char*)Ks + KSWZ(32 + r32, cb)); }
}
template <int ND0>
__device__ __forceinline__ void qk_mm(f32x16& p0, f32x16& p1, const bf16x8 (&kb0)[ND0], const bf16x8 (&kb1)[ND0], const bf16x8* qr, const f32x16& negm) {
#pragma unroll
  for (int d0 = 0; d0 < ND0; ++d0) {
    if (d0 == 0) { p0 = __builtin_amdgcn_mfma_f32_32x32x16_bf16(kb0[d0], qr[d0], negm, 0, 0, 0); p1 = __builtin_amdgcn_mfma_f32_32x32x16_bf16(kb1[d0], qr[d0], negm, 0, 0, 0); }
    else { p0 = __builtin_amdgcn_mfma_f32_32x32x16_bf16(kb0[d0], qr[d0], p0, 0, 0, 0); p1 = __builtin_amdgcn_mfma_f32_32x32x16_bf16(kb1[d0], qr[d0], p1, 0, 0, 0); } }
}
template <int ND0>
__device__ __forceinline__ void qkt_c(f32x16& p0, f32x16& p1, const bf16* Ks, const bf16x8* qr, int r32, int hi, int kcb, const f32x16& negm) {
  bf16x8 kb0[ND0], kb1[ND0];
#pragma unroll
  for (int d0 = 0; d0 < ND0; ++d0) { int cb = kcb + (d0 * 16 + hi * 8) * 2;
    kb0[d0] = *reinterpret_cast<const bf16x8*>((const char*)Ks + KSWZ(r32, cb));
    kb1[d0] = *reinterpret_cast<const bf16x8*>((const char*)Ks + KSWZ(32 + r32, cb)); }
  SBAR();
#pragma unroll
  for (int d0 = 0; d0 < ND0; ++d0) { const bf16x8 b0 = kb0[d0], b1 = kb1[d0];
    if (d0 == 0) { p0 = __builtin_amdgcn_mfma_f32_32x32x16_bf16(b0, qr[d0], negm, 0, 0, 0); p1 = __builtin_amdgcn_mfma_f32_32x32x16_bf16(b1, qr[d0], negm, 0, 0, 0); }
    else { p0 = __builtin_amdgcn_mfma_f32_32x32x16_bf16(b0, qr[d0], p0, 0, 0, 0); p1 = __builtin_amdgcn_mfma_f32_32x32x16_bf16(b1, qr[d0], p1, 0, 0, 0); } }
}
__device__ __forceinline__ float rowmax32(const f32x16& p0, const f32x16& p1) {
  float pmax = p0[0];
#pragma unroll
  for (int r = 1; r < 16; ++r) pmax = fmaxf(pmax, p0[r]);
#pragma unroll
  for (int r = 0; r < 16; ++r) pmax = fmaxf(pmax, p1[r]);
  auto rr = __builtin_amdgcn_permlane32_swap(__float_as_uint(pmax), __float_as_uint(pmax), false, false);
  return fmaxf(__uint_as_float(rr[0]), __uint_as_float(rr[1]));
}
__device__ __forceinline__ void firstSM_l2(f32x16& p0, f32x16& p1, float& m_reg, f32x16& negm) {
  const float pmax = rowmax32(p0, p1);
  m_reg = pmax;
#pragma unroll
  for (int r = 0; r < 16; ++r) { negm[r] = -pmax; p0[r] -= pmax; p1[r] -= pmax; }
#pragma unroll
  for (int r = 0; r < 16; ++r) p0[r] = __builtin_amdgcn_exp2f(p0[r]);
}
__device__ __forceinline__ void sm_lmax_l2(float ps, float alpha_prev, float& l_reg, f32x16& p0, f32x16& p1, float& m_reg, float& alpha, f32x16& negm) {
  { auto rr = __builtin_amdgcn_permlane32_swap(__float_as_uint(ps), __float_as_uint(ps), false, false);
    ps = __uint_as_float(rr[0]) + __uint_as_float(rr[1]); }
  l_reg = l_reg * alpha_prev + ps;
  const float pmax = rowmax32(p0, p1);
  if (__builtin_expect(__all(pmax <= THRL), 1)) { alpha = 1.f; }
  else { const float dlt = fmaxf(pmax, 0.f); alpha = __builtin_amdgcn_exp2f(-dlt); m_reg += dlt;
#pragma unroll
    for (int r = 0; r < 16; ++r) { negm[r] -= dlt; p0[r] -= dlt; p1[r] -= dlt; } }
}
__device__ __forceinline__ void sm_exp_lo(f32x16& p0) {
#pragma unroll
  for (int r = 0; r < 8; ++r) p0[r] = __builtin_amdgcn_exp2f(p0[r]);
}
__device__ __forceinline__ void sm_exp_hi(f32x16& p0) {
#pragma unroll
  for (int r = 8; r < 16; ++r) p0[r] = __builtin_amdgcn_exp2f(p0[r]);
}
__device__ __forceinline__ int v_st(int k, int c) { return ((k >> 3) * 4 + (c >> 5)) * 512 + ((k & 7) * 32 + (c & 31)) * 2; }
__device__ __forceinline__ int v_rd_base(int lane) { return ((lane & 3) << 3) | (((lane >> 2) & 3) << 6) | (((lane >> 4) & 1) << 5) | (((lane >> 5) & 1) << 8); }
constexpr int v_rd_off(int d0, int ks, int half) { return d0 * 512 + ks * 4096 + half * 2048; }
template <int OFF> __device__ __forceinline__ s16x4 tr_read(int vb) {
  s16x4 r; asm volatile("ds_read_b64_tr_b16 %0, %1 offset:%2" : "=&v"(r) : "v"(vb), "i"(OFF) : "memory"); return r;
}
template <int D0> __device__ __forceinline__ void pv_one(f32x16& od, int vb, bf16x8 pa0, bf16x8 pa1, bf16x8 pa2, bf16x8 pa3) {
  const s16x4 l0 = tr_read<v_rd_off(D0, 0, 0)>(vb), h0 = tr_read<v_rd_off(D0, 0, 1)>(vb), l1 = tr_read<v_rd_off(D0, 1, 0)>(vb), h1 = tr_read<v_rd_off(D0, 1, 1)>(vb);
  const s16x4 l2 = tr_read<v_rd_off(D0, 2, 0)>(vb), h2 = tr_read<v_rd_off(D0, 2, 1)>(vb), l3 = tr_read<v_rd_off(D0, 3, 0)>(vb), h3 = tr_read<v_rd_off(D0, 3, 1)>(vb);
  asm volatile("s_waitcnt lgkmcnt(0)" ::: "memory"); SBAR();
#define PK(L, H) (bf16x8){L[0], L[1], L[2], L[3], H[0], H[1], H[2], H[3]}
  od = __builtin_amdgcn_mfma_f32_32x32x16_bf16(pa0, PK(l0, h0), od, 0, 0, 0);
  od = __builtin_amdgcn_mfma_f32_32x32x16_bf16(pa1, PK(l1, h1), od, 0, 0, 0);
  od = __builtin_amdgcn_mfma_f32_32x32x16_bf16(pa2, PK(l2, h2), od, 0, 0, 0);
  od = __builtin_amdgcn_mfma_f32_32x32x16_bf16(pa3, PK(l3, h3), od, 0, 0, 0);
#undef PK
}
__device__ __forceinline__ void pv_d0(f32x16* o, int vb, bf16x8 pa0, bf16x8 pa1, bf16x8 pa2, bf16x8 pa3) {
  pv_one<0>(o[0], vb, pa0, pa1, pa2, pa3); pv_one<1>(o[1], vb, pa0, pa1, pa2, pa3); pv_one<2>(o[2], vb, pa0, pa1, pa2, pa3); pv_one<3>(o[3], vb, pa0, pa1, pa2, pa3);
}
struct VFrag { s16x4 l0, h0, l1, h1, l2, h2, l3, h3; };
template <int D0> __device__ __forceinline__ void pv_rd(VFrag& f, int vb) {
  f.l0 = tr_read<v_rd_off(D0, 0, 0)>(vb); f.h0 = tr_read<v_rd_off(D0, 0, 1)>(vb); f.l1 = tr_read<v_rd_off(D0, 1, 0)>(vb); f.h1 = tr_read<v_rd_off(D0, 1, 1)>(vb);
  f.l2 = tr_read<v_rd_off(D0, 2, 0)>(vb); f.h2 = tr_read<v_rd_off(D0, 2, 1)>(vb); f.l3 = tr_read<v_rd_off(D0, 3, 0)>(vb); f.h3 = tr_read<v_rd_off(D0, 3, 1)>(vb);
}
template <int NW_>
__device__ __forceinline__ void pv_mm(f32x16& od, const VFrag& f, bf16x8 pa0, bf16x8 pa1, bf16x8 pa2, bf16x8 pa3) {
  if (NW_ == 8) asm volatile("s_waitcnt lgkmcnt(8)" ::: "memory"); else asm volatile("s_waitcnt lgkmcnt(0)" ::: "memory");
  SBAR();
#define PK(L, H) (bf16x8){L[0], L[1], L[2], L[3], H[0], H[1], H[2], H[3]}
  od = __builtin_amdgcn_mfma_f32_32x32x16_bf16(pa0, PK(f.l0, f.h0), od, 0, 0, 0);
  od = __builtin_amdgcn_mfma_f32_32x32x16_bf16(pa1, PK(f.l1, f.h1), od, 0, 0, 0);
  od = __builtin_amdgcn_mfma_f32_32x32x16_bf16(pa2, PK(f.l2, f.h2), od, 0, 0, 0);
  od = __builtin_amdgcn_mfma_f32_32x32x16_bf16(pa3, PK(f.l3, f.h3), od, 0, 0, 0);
#undef PK
}
__device__ __forceinline__ void na_fix(f32x16& p0, f32x16& p1, int kr, int qr_, int rs, int qc, int cs, int hi, const float* rpbS) {
  const float NEG = -__builtin_inff();
  if (kr < rs || kr >= rs + 8) {
#pragma unroll
    for (int r = 0; r < 16; ++r) { p0[r] = NEG; p1[r] = NEG; }
  } else {
    const float* brow = rpbS + (kr - qr_ + 7) * 31 + (15 - qc);
#pragma unroll
    for (int g = 0; g < 4; ++g) {
#pragma unroll
      for (int q = 0; q < 4; ++q) { const int r = 4 * g + q;
        const int k0 = crow(r, hi), k1 = 32 + k0;
        const bool v0 = (unsigned)(k0 - cs) < 16u, v1 = (unsigned)(k1 - cs) < 16u;
        const float b0 = brow[v0 ? k0 : qc], b1 = brow[v1 ? k1 : qc];
        p0[r] = (p0[r] + b0) + (v0 ? 0.f : NEG); p1[r] = (p1[r] + b1) + (v1 ? 0.f : NEG);
      }
      SBAR();
    }
  }
}

template <int MODE>
__device__ __forceinline__ void attn_core(const bf16* __restrict__ Qw, const bf16* __restrict__ Kh, const bf16* __restrict__ Vh, const int NT, char* lds, const int kcb,
                                          const int, const int, const int, const int, const int, f32x16 (&o)[4], float& l_reg) {
  constexpr int ND0 = Cfg<MODE>::ND0;
  int tid_ = threadIdx.x; asm volatile("" : "+v"(tid_));
  const int tid = tid_, wid = __builtin_amdgcn_readfirstlane(tid >> 6), lane = tid & 63, r32 = lane & 31, hi = lane >> 5, half = wid >> 2, ht = tid & 255;
  bf16* V_lds = (bf16*)lds; bf16* K_lds = (bf16*)(lds + 2 * SHM_V);
  float* ws = (float*)(lds + OFF_WS) + wid * 64; float* al_l = ws + 32;
  float m_reg = 0.f; l_reg = 0.f; f32x16 negm = f32x16{};
#pragma unroll
  for (int d = 0; d < 4; ++d) o[d] = f32x16{};
  bf16x8 qr[ND0];
#pragma unroll
  for (int d0 = 0; d0 < ND0; ++d0) qr[d0] = ld8(Qw + d0 * 16);
  const int vb0 = (int)(uintptr_t)V_lds + v_rd_base(lane);
  {
    const int sr = tid >> 4, sc = (tid & 15) * 8;
    const bf16x8 v0 = ld8(&Vh[(long)sr * LDP + sc]), v1 = ld8(&Vh[(long)(32 + sr) * LDP + sc]), k0 = ld8(&Kh[(long)sr * LDP + sc]), k1 = ld8(&Kh[(long)(32 + sr) * LDP + sc]);
    *(bf16x8*)((char*)V_lds + v_st(sr, sc)) = v0; *(bf16x8*)((char*)V_lds + v_st(32 + sr, sc)) = v1;
    *(bf16x8*)((char*)K_lds + KSWZ(sr, sc * 2)) = k0; *(bf16x8*)((char*)K_lds + KSWZ(32 + sr, sc * 2)) = k1; }
  const int hr = ht >> 4, hc = (ht & 15) * 8;
  const bf16* Sg = (half == 0 ? Kh : Vh) + (long)hr * LDP + hc;
  char* Sl = half == 0 ? (char*)K_lds : (char*)V_lds;
  int soff[4];
#pragma unroll
  for (int i = 0; i < 4; ++i) soff[i] = half == 0 ? KSWZ(hr + 16 * i, hc * 2) : v_st(hr + 16 * i, hc);
  bf16x8 st[4], su[4];
#define HLOAD(R, t) do { _Pragma("unroll") for (int i = 0; i < 4; ++i) R[i] = ld8(Sg + (long)((t) * 64 + 16 * i) * LDP); } while (0)
#define HWRITE(R, b) do { _Pragma("unroll") for (int i = 0; i < 4; ++i) *(bf16x8*)(Sl + (b) * SHM_V + soff[i]) = R[i]; } while (0)
#define BAR_P() do { asm volatile("" : "+v"(p0), "+v"(p1)); SBAR(); asm volatile("s_waitcnt lgkmcnt(0)\n\ts_barrier" ::: "memory"); SBAR(); } while (0)
#define BAR_A() do { asm volatile("" : "+v"(pa0), "+v"(pa1), "+v"(pa2), "+v"(pa3)); SBAR(); asm volatile("s_waitcnt lgkmcnt(0)\n\ts_barrier" ::: "memory"); SBAR(); } while (0)
  f32x16 p0 = f32x16{}, p1 = f32x16{}; bf16x8 pa0, pa1, pa2, pa3; float alpha;
#define MSEG(VB, KS) do { VFrag fa_, fb_; bf16x8 kb0_[ND0], kb1_[ND0]; \
    pv_rd<0>(fa_, VB); pv_rd<1>(fb_, VB); pv_mm<8>(o[0], fa_, pa0, pa1, pa2, pa3); \
    pv_rd<2>(fa_, VB); pv_mm<8>(o[1], fb_, pa0, pa1, pa2, pa3); \
    pv_rd<3>(fb_, VB); pv_mm<8>(o[2], fa_, pa0, pa1, pa2, pa3); \
    qk_rd<ND0>(kb0_, kb1_, KS, r32, hi, kcb); pv_mm<8>(o[3], fb_, pa0, pa1, pa2, pa3); \
    qk_mm<ND0>(p0, p1, kb0_, kb1_, qr, negm); } while (0)
#define VSEG(FIRST) do { alpha = 1.f; const float pmax_ = rowmax32(p0, p1); \
    if (FIRST) { m_reg = pmax_; _Pragma("unroll") for (int r = 0; r < 16; ++r) { negm[r] = -pmax_; p0[r] -= pmax_; p1[r] -= pmax_; } } \
    else if (!__builtin_expect(__all(pmax_ <= THRL), 1)) { const float dlt_ = fmaxf(pmax_, 0.f); alpha = __builtin_amdgcn_exp2f(-dlt_); m_reg += dlt_; \
      _Pragma("unroll") for (int r = 0; r < 16; ++r) { negm[r] -= dlt_; p0[r] -= dlt_; p1[r] -= dlt_; } \
      if (hi == 0) al_l[r32] = alpha; asm volatile("s_waitcnt lgkmcnt(0)" ::: "memory"); \
      _Pragma("unroll") for (int d = 0; d < 4; ++d) _Pragma("unroll") for (int r = 0; r < 16; ++r) o[d][r] *= al_l[crow(r, hi)]; } \
    sm_exp0(p0); finishSM(p0, p1, alpha, l_reg, pa0, pa1, pa2, pa3); } while (0)
  __syncthreads();
  HLOAD(st, 1); HLOAD(su, 2);
  if (half == 1) BAR_P();
  qkt<ND0>(p0, p1, K_lds, qr, r32, hi, kcb);
  BAR_P();
  VSEG(true); HWRITE(st, 1); if (3 < NT) HLOAD(st, 3); BAR_A();
  MSEG(vb0, (bf16*)((char*)K_lds + SHM_K)); BAR_P();
#pragma unroll 1
  for (int j = 1; j + 1 < NT; j += 2) {
    VSEG(false); HWRITE(su, 0); if (j + 3 < NT) HLOAD(su, j + 3); BAR_A();
    MSEG(vb0 + SHM_V, K_lds); BAR_P();
    VSEG(false); HWRITE(st, 1); if (j + 4 < NT) HLOAD(st, j + 4); BAR_A();
    MSEG(vb0, (bf16*)((char*)K_lds + SHM_K)); BAR_P();
  }
  VSEG(false); BAR_A();
  pv_d0(o, vb0 + SHM_V, pa0, pa1, pa2, pa3); BAR_P();
  if (half == 0) BAR_P();
#undef VSEG
#undef MSEG
#undef HLOAD
#undef HWRITE
#undef BAR_P
#undef BAR_A
}
__device__ __forceinline__ float half_sum32(float v) {
#pragma unroll
  for (int o = 1; o < 32; o <<= 1) v += __shfl_xor(v, o);
  return v;
}
__device__ __forceinline__ void diff_unit(const bf16* __restrict__ proj, bf16* __restrict__ mix, int h, int q0, float lam, float oml, const float* __restrict__ subg, char* lds) {
  int tid_ = threadIdx.x; asm volatile("" : "+v"(tid_));
  const int tid = tid_, wid = tid >> 6, lane = tid & 63, r32 = lane & 31, hi = lane >> 5, map = wid >> 2, wq = wid & 3;
  const bf16* Qw = proj + (size_t)(q0 + wq * 32 + r32) * LDP + h * 128 + map * 64 + hi * 8;
  f32x16 o[4]; float l_reg;
  attn_core<0>(Qw, proj + 1024 + h * 128, proj + 2048 + h * 128, 8192 / 64, lds, map * 128, 0, 0, 0, 0, 0, o, l_reg);
  float* ws = (float*)(lds + OFF_WS) + wid * 64;
  if (hi == 0) ws[r32] = l_reg;
  asm volatile("s_waitcnt lgkmcnt(0)" ::: "memory");
  float rli[16];
#pragma unroll
  for (int r = 0; r < 16; ++r) rli[r] = __builtin_amdgcn_rcpf(ws[crow(r, hi)]);
  __syncthreads();
  float* X = (float*)lds + (wq * 64) * 64 + lane;
  if (map == 1) {
#pragma unroll
    for (int d = 0; d < 4; ++d)
#pragma unroll
      for (int r = 0; r < 16; ++r) X[(d * 16 + r) * 64] = o[d][r] * rli[r];
  }
  __syncthreads();
  if (map == 0) {
    float gv[4];
#pragma unroll
    for (int d = 0; d < 4; ++d) gv[d] = subg[32 * d + r32] * oml;
    bf16* Ow = mix + (size_t)(q0 + wq * 32) * 2048 + 1024 + h * 128 + r32;
#pragma unroll
    for (int r = 0; r < 16; ++r) {
      float dv[4]; float sq = 0.f;
#pragma unroll
      for (int d = 0; d < 4; ++d) { dv[d] = o[d][r] * rli[r] - lam * X[(d * 16 + r) * 64]; sq += dv[d] * dv[d]; }
      sq = half_sum32(sq);
      const float rn = rsqrtf(sq * (1.0f / 128.0f) + 1e-6f);
      bf16* orow = Ow + (size_t)crow(r, hi) * 2048;
#pragma unroll
      for (int d = 0; d < 4; ++d) orow[32 * d] = (bf16)(cvtpk(dv[d] * rn * gv[d], 0.f) & 0xffffu);
    }
  }
  __syncthreads();
}
__device__ __forceinline__ void attn_na_core(const bf16* __restrict__ Qw, const bf16* __restrict__ Kh, const bf16* __restrict__ Vh, const int NT, char* lds,
                                             const int na_qr, const int na_rs, const int na_qc, const int na_cs, const int na_k0, f32x16 (&o)[4], float& l_reg) {
  int tid_ = threadIdx.x; asm volatile("" : "+v"(tid_));
  const int tid = tid_, wid = tid >> 6, lane = tid & 63, r32 = lane & 31, hi = lane >> 5;
  bf16* V_lds = (bf16*)lds; bf16* K_lds = (bf16*)(lds + 2 * SHM_V);
  float* ws = (float*)(lds + OFF_WS) + wid * 64; float* al_l = ws + 32;
  const float* rpbS = (const float*)(lds + OFF_RPB);
  float m_reg = -1e30f; l_reg = 0.f;
#pragma unroll
  for (int d = 0; d < 4; ++d) o[d] = f32x16{};
  bf16x8 qr[8];
#pragma unroll
  for (int d0 = 0; d0 < 8; ++d0) qr[d0] = ld8(Qw + d0 * 16);
  const int sr = tid >> 4, sc = (tid & 15) * 8, vst0 = v_st(sr, sc), vst1 = v_st(32 + sr, sc);
  const int vb0 = (int)(uintptr_t)V_lds + v_rd_base(lane);
  bf16x8 vs0, vs1, ks0, ks1;
#define SLOAD(k0) do { vs0 = ld8(&Vh[(long)((k0) + sr) * LDP + sc]); vs1 = ld8(&Vh[(long)((k0) + 32 + sr) * LDP + sc]); \
    ks0 = ld8(&Kh[(long)((k0) + sr) * LDP + sc]); ks1 = ld8(&Kh[(long)((k0) + 32 + sr) * LDP + sc]); } while (0)
  SLOAD(0);
#pragma unroll 1
  for (int j = 0; j < NT; ++j) {
    __syncthreads();
    *(bf16x8*)((char*)V_lds + vst0) = vs0; *(bf16x8*)((char*)V_lds + vst1) = vs1;
    *(bf16x8*)((char*)K_lds + KSWZ(sr, sc * 2)) = ks0; *(bf16x8*)((char*)K_lds + KSWZ(32 + sr, sc * 2)) = ks1;
    if (j + 1 < NT) SLOAD((j + 1) * 64);
    __syncthreads();
    const int kr = na_k0 + j;
    if (kr >= na_rs && kr < na_rs + 8) {
      f32x16 p0, p1; float mn, al; bf16x8 pa0, pa1, pa2, pa3;
      qkt<8>(p0, p1, K_lds, qr, r32, hi, 0);
      na_fix(p0, p1, kr, na_qr, na_rs, na_qc, na_cs, hi, rpbS);
      partialSM<1>(p0, p1, m_reg, mn, al);
      if (__any(al < 1.f)) { if (hi == 0) al_l[r32] = al; asm volatile("s_waitcnt lgkmcnt(0)" ::: "memory");
#pragma unroll
        for (int d = 0; d < 4; ++d)
#pragma unroll
          for (int r = 0; r < 16; ++r) o[d][r] *= al_l[crow(r, hi)]; }
      finishSM(p0, p1, al, l_reg, pa0, pa1, pa2, pa3); SBAR();
      pv_d0(o, vb0, pa0, pa1, pa2, pa3);
    }
  }
#undef SLOAD
}
__device__ __forceinline__ void na_unit(const bf16* __restrict__ proj, bf16* __restrict__ mix, float* __restrict__ nass, int h, int rb, const float* __restrict__ rpb_h, char* lds) {
  int tid_ = threadIdx.x; asm volatile("" : "+v"(tid_));
  const int tid = tid_, wid = tid >> 6, lane = tid & 63, r32 = lane & 31, hi = lane >> 5;
  float* rpbS = (float*)(lds + OFF_RPB);
  if (tid < 15 * 31) rpbS[tid] = rpb_h[tid] * 11.313708498984761f;
  const int q0 = rb * 256; int k0row = rb * 4 - 4; k0row = k0row < 0 ? 0 : (k0row > 116 ? 116 : k0row);
  const int qr_ = rb * 4 + (wid >> 1), qc = (wid & 1) * 32 + r32;
  int rs = qr_ - 4; rs = rs < 0 ? 0 : (rs > 120 ? 120 : rs);
  int cs = qc - 8; cs = cs < 0 ? 0 : (cs > 48 ? 48 : cs);
  const bf16* Qw = proj + (size_t)(q0 + wid * 32 + r32) * LDP + 3072 + h * 128 + hi * 8;
  const bf16* Kh = proj + (size_t)k0row * 64 * LDP + 4096 + h * 128;
  const bf16* Vh = proj + (size_t)k0row * 64 * LDP + 5120 + h * 128;
  f32x16 o[4]; float l_reg;
  attn_na_core(Qw, Kh, Vh, 12, lds, qr_, rs, qc, cs, k0row, o, l_reg);
  int t2 = threadIdx.x; asm volatile("" : "+v"(t2));
  const int wid2 = t2 >> 6, r32b = t2 & 31, hib = (t2 >> 5) & 1;
  float* ws = (float*)(lds + OFF_WS) + wid2 * 64;
  if (hib == 0) ws[r32b] = l_reg;
  asm volatile("s_waitcnt lgkmcnt(0)" ::: "memory");
  bf16* Ow = mix + (size_t)(rb * 256 + wid2 * 32) * 2048 + h * 128 + r32b;
  float* nrow = nass + (size_t)(rb * 256 + wid2 * 32) * 8 + h;
#pragma unroll
  for (int r = 0; r < 16; ++r) {
    const float rl = __builtin_amdgcn_rcpf(ws[crow(r, hib)]);
    bf16* orow = Ow + (size_t)crow(r, hib) * 2048; float sq = 0.f;
#pragma unroll
    for (int d = 0; d < 4; ++d) { const float v = o[d][r] * rl; sq += v * v; orow[32 * d] = (bf16)(cvtpk(v, 0.f) & 0xffffu); }
    sq = half_sum32(sq);
    if (r32b == 0) nrow[(size_t)crow(r, hib) * 8] = sq;
  }
  __syncthreads();
}
#undef KSWZ
#undef SBAR
}
#define LAS __attribute__((address_space(3)))
typedef unsigned short bf16_t;
typedef unsigned v4u __attribute__((ext_vector_type(4)));
typedef unsigned v2u __attribute__((ext_vector_type(2)));
typedef float v4f __attribute__((ext_vector_type(4)));
#define XB_TMO      128
#define XB_XCNT(j)  (256  + 64 * (j))
#define XB_XSUB(j)  (1280 + 64 * (j))
#define XB_XGEN(j)  (2304 + 64 * (j))
#define XB_TOP      3328
#define XB_TOPGEN   3392
#define XCD_BAR_WORDS 3456
#define XB_SPIN_CAP (1u << 18)

__device__ __forceinline__ unsigned xb_ld(unsigned* p)              { return __hip_atomic_load(p, __ATOMIC_RELAXED, __HIP_MEMORY_SCOPE_AGENT); }
__device__ __forceinline__ unsigned xb_add(unsigned* p, unsigned v) { return __hip_atomic_fetch_add(p, v, __ATOMIC_RELAXED, __HIP_MEMORY_SCOPE_AGENT); }
__device__ __forceinline__ unsigned xb_xcc_id() { return (unsigned)__builtin_amdgcn_s_getreg((3 << 11) | 20) & 0xFu; }
#define XB_SPIN(cond, bar) do { unsigned _sp = 0; while (cond) { __builtin_amdgcn_s_sleep(1); \
    if ((++_sp & 255u) == 0u) { if (xb_ld(&(bar)[XB_TMO])) break; if (_sp > XB_SPIN_CAP) { atomicAdd(&(bar)[XB_TMO], 1u); break; } } } } while (0)

struct XcdBarrier {
    unsigned* bar; unsigned x;
    volatile LAS unsigned* st;
};

__device__ __forceinline__ XcdBarrier xcd_barrier_post(unsigned* bar, volatile LAS unsigned* st) {
    XcdBarrier b; b.bar = bar; b.x = xb_xcc_id(); b.st = st;
    if (threadIdx.x == 0) (void)xb_add(&bar[XB_XCNT(b.x)], 1u);
    return b;
}
__device__ __forceinline__ void xcd_barrier_complete(unsigned* bar, unsigned x, unsigned& nloc, unsigned& nx) {
    const unsigned G = gridDim.x * gridDim.y * gridDim.z;
    unsigned sum, cnt, mine, sp = 0u;
    for (;;) {
        sum = 0u; cnt = 0u; mine = 0u;
#pragma unroll
        for (unsigned j = 0; j < 16; ++j) { const unsigned c = xb_ld(&bar[XB_XCNT(j)]); sum += c; cnt += (c > 0u) ? 1u : 0u; mine = (j == x) ? c : mine; }
        if (sum == G) break;
        __builtin_amdgcn_s_sleep(1);
        if ((++sp & 255u) == 0u) { if (xb_ld(&bar[XB_TMO])) break; if (sp > XB_SPIN_CAP) { atomicAdd(&bar[XB_TMO], 1u); break; } }
    }
    nloc = mine > 0u ? mine : 1u; nx = cnt > 0u ? cnt : 1u;
}

__device__ __forceinline__ void xcd_barrier(const XcdBarrier& b) {
    asm volatile("s_waitcnt vmcnt(0)" ::: "memory");
    __syncthreads();
    if (threadIdx.x == 0) {
        unsigned* bar = b.bar;
        __builtin_amdgcn_s_waitcnt(0);
        unsigned nloc = b.st[0], nx = b.st[1];
        if (nloc == 0u) { xcd_barrier_complete(bar, b.x, nloc, nx); b.st[0] = nloc; b.st[1] = nx; }
        const unsigned old = xb_add(&bar[XB_XSUB(b.x)], 1u);
        const unsigned gen = old / nloc;
        if (old + 1u == (gen + 1u) * nloc) {
            __builtin_amdgcn_fence(__ATOMIC_RELEASE, "agent");
            asm volatile("s_waitcnt vmcnt(0)" ::: "memory");
            const unsigned og = xb_add(&bar[XB_TOP], 1u);
            const unsigned tg = og / nx;
            if (og + 1u == (tg + 1u) * nx) xb_add(&bar[XB_TOPGEN], 1u);
            else XB_SPIN(xb_ld(&bar[XB_TOPGEN]) == tg, bar);
            __builtin_amdgcn_fence(__ATOMIC_ACQUIRE, "agent");
            xb_add(&bar[XB_XGEN(b.x)], 1u);
            asm volatile("s_waitcnt vmcnt(0)" ::: "memory");
        } else {
            XB_SPIN(xb_ld(&bar[XB_XGEN(b.x)]) == gen, bar);
            __builtin_amdgcn_fence(__ATOMIC_ACQUIRE, "agent");
            asm volatile("s_waitcnt vmcnt(0)" ::: "memory");
        }
    }
    __syncthreads();
}

constexpr int SEQ = 8192, DM = 2048, INC = 6144, FF = 8192, DEPTH = 4, NTHR = 512;
constexpr size_t SZ_WIN = (size_t)INC * DM * 2, SZ_WOUT = (size_t)DM * DM * 2, SZ_WMI = (size_t)FF * DM * 2, SZ_WMO = (size_t)DM * FF * 2;
constexpr size_t WS_WIN = 0, WS_WOUT = WS_WIN + DEPTH * SZ_WIN, WS_WMI = WS_WOUT + DEPTH * SZ_WOUT, WS_WMO = WS_WMI + DEPTH * SZ_WMI;
constexpr size_t WS_X = WS_WMO + DEPTH * SZ_WMO, WS_XB = WS_X + (size_t)SEQ * DM * 4, WS_PROJ = WS_XB + (size_t)SEQ * DM * 2, WS_MIX = WS_PROJ + (size_t)SEQ * INC * 2;
constexpr size_t WS_U = WS_MIX + (size_t)SEQ * DM * 2, WS_SS = WS_U + (size_t)SEQ * FF * 2, WS_COS = WS_SS + 9 * (size_t)SEQ * 32 * 4, WS_SIN = WS_COS + (size_t)SEQ * 32 * 4;
constexpr size_t WS_LAM = WS_SIN + (size_t)SEQ * 32 * 4, WS_BAR = WS_LAM + 256, WS_NASS = WS_BAR + 16384, WS_END = WS_NASS + (size_t)SEQ * 8 * 4;
#ifndef REP_P0
#define REP_P0 1
#endif
#ifndef REP_P1
#define REP_P1 1
#endif
#ifndef REP_P2
#define REP_P2 1
#endif
#ifndef REP_P3
#define REP_P3 1
#endif
#ifndef REP_P4
#define REP_P4 1
#endif
#ifndef REP_P6
#define REP_P6 1
#endif
#ifndef REP_P5
#define REP_P5 1
#endif
constexpr int LDS_BYTES = 139264;
static_assert(att::ATT_LDS <= LDS_BYTES && pg8::STAGE_BYTES <= LDS_BYTES, "LDS map");

struct Args {
    const float* in[15]; float* out; unsigned char* ws;
    double invf[32];
    float lam_init[4]; int pad[2];
};

__device__ __forceinline__ float wave_sum(float v) {
#pragma unroll
    for (int o = 1; o < 64; o <<= 1) v += __shfl_xor(v, o);
    return v;
}
__device__ __forceinline__ unsigned pk2(float lo, float hi) { return pg8::cvt_pk_bf16(lo, hi); }

struct TpItem { const float* W; bf16_t* WT; const float* gv; int K, N, k0, n0, krot; bool perm; };
__device__ __forceinline__ void tp_load(const TpItem& d, int lane, float (&w)[32]) {
    const float* wp = d.W + (size_t)(d.k0 + (lane >> 5)) * d.N + d.n0 + (lane & 31);
#pragma unroll
    for (int i = 0; i < 32; ++i) w[i] = wp[(size_t)(2 * i) * d.N];
}
__device__ __forceinline__ void tp_store(const TpItem& d, int lane, const float (&w)[32], LAS float* scr) {
    const int c = lane & 7;
    v4f g0 = {1.f, 1.f, 1.f, 1.f}, g1 = {1.f, 1.f, 1.f, 1.f};
    if (d.gv) { g0 = *(const v4f*)(d.gv + d.k0 + 8 * c); g1 = *(const v4f*)(d.gv + d.k0 + 8 * c + 4); }
#pragma unroll
    for (int i = 0; i < 32; ++i) scr[(2 * i + (lane >> 5)) * 33 + (lane & 31)] = w[i];
    asm volatile("s_waitcnt lgkmcnt(0)" ::: "memory");
#pragma unroll
    for (int j = 0; j < 4; ++j) { const int n = (lane >> 3) + 8 * j; const LAS float* s = scr + (8 * c) * 33 + n;
        v4u o; o.x = pk2(s[0 * 33] * g0.x, s[1 * 33] * g0.y); o.y = pk2(s[2 * 33] * g0.z, s[3 * 33] * g0.w); o.z = pk2(s[4 * 33] * g1.x, s[5 * 33] * g1.y); o.w = pk2(s[6 * 33] * g1.z, s[7 * 33] * g1.w);
        const int no = d.n0 + n; int dst = no;
        if (d.perm && no < 2048) { const int q = no & 63; dst = (no & ~63) + 8 * ((q & 31) >> 2) + 4 * (q >> 5) + (q & 3); }
        *(v4u*)(d.WT + (size_t)dst * d.K + ((d.k0 + d.krot) & (d.K - 1)) + 8 * c) = o; }
    asm volatile("s_waitcnt lgkmcnt(0)" ::: "memory");
}

__global__ void __launch_bounds__(NTHR, 2) fwd_megakernel(Args a) {
    extern __shared__ __attribute__((aligned(16))) unsigned char lds[];
    cg::grid_group grid = cg::this_grid();
#define GRID_SYNC() do { asm volatile("s_waitcnt vmcnt(0) lgkmcnt(0)" ::: "memory"); grid.sync(); __builtin_amdgcn_fence(__ATOMIC_ACQUIRE, "agent"); asm volatile("s_waitcnt vmcnt(0)" ::: "memory"); } while (0)
    const int tid = threadIdx.x, lane = tid & 63, wave = __builtin_amdgcn_readfirstlane(tid >> 6);
    const int G = gridDim.x, bx = blockIdx.x;
    const int gw = bx * 8 + wave, NGW = G * 8;
    unsigned char* ws = a.ws;
    bf16_t* WinT = (bf16_t*)(ws + WS_WIN); bf16_t* WoutT = (bf16_t*)(ws + WS_WOUT); bf16_t* WmiT = (bf16_t*)(ws + WS_WMI); bf16_t* WmoT = (bf16_t*)(ws + WS_WMO);
    float* X = (float*)(ws + WS_X); bf16_t* XB = (bf16_t*)(ws + WS_XB); bf16_t* PROJ = (bf16_t*)(ws + WS_PROJ); bf16_t* MIX = (bf16_t*)(ws + WS_MIX); bf16_t* U = (bf16_t*)(ws + WS_U);
    float* SS = (float*)(ws + WS_SS); float* COS = (float*)(ws + WS_COS); float* SIN = (float*)(ws + WS_SIN); float* LAM = (float*)(ws + WS_LAM); float* NASS = (float*)(ws + WS_NASS);
    LAS unsigned char* ldsl = (LAS unsigned char*)lds;
    volatile LAS unsigned* bst = (volatile LAS unsigned*)(ldsl + 135168);
    if (tid < 2) bst[tid] = 0u;
    __syncthreads();
    const XcdBarrier xbar = xcd_barrier_post((unsigned*)(ws + WS_BAR), bst);

    for (int rep = 0; rep < REP_P0; ++rep) {
        LAS float* scr = (LAS float*)(ldsl + wave * 16384);
        constexpr int I_IN = (DM / 64) * (INC / 32), I_OUT = (DM / 64) * (DM / 32), I_MI = (DM / 64) * (FF / 32), I_MO = (FF / 64) * (DM / 32), I_L = I_IN + I_OUT + I_MI + I_MO;
        auto mk = [&](int it) {
            TpItem d; const int l = it / I_L; int r = it % I_L; d.gv = nullptr; d.perm = false; d.krot = 0;
            if (r < I_IN) { d.W = a.in[2] + (size_t)l * DM * INC; d.K = DM; d.N = INC; d.WT = WinT + (size_t)l * INC * DM; d.gv = a.in[1] + l * DM; d.perm = true; }
            else if ((r -= I_IN) < I_OUT) {
                d.W = a.in[10] + (size_t)l * DM * DM; d.K = DM; d.N = DM; d.WT = WoutT + (size_t)l * DM * DM; d.krot = 1024; if (r / (DM / 32) >= 16) d.gv = a.in[8] + l * 1024 - 1024; }
            else if ((r -= I_OUT) < I_MI) { d.W = a.in[12] + (size_t)l * DM * FF; d.K = DM; d.N = FF; d.WT = WmiT + (size_t)l * FF * DM; d.gv = a.in[11] + l * DM; }
            else { r -= I_MI; d.W = a.in[13] + (size_t)l * FF * DM; d.K = FF; d.N = DM; d.WT = WmoT + (size_t)l * DM * FF; }
            const int nblk = d.N / 32; d.k0 = 64 * (r / nblk); d.n0 = 32 * (r % nblk);
            return d; };
        {
            constexpr int NIT = DEPTH * I_L; float wa[32], wb[32]; int it = gw;
            TpItem da = mk(it < NIT ? it : 0), db = da;
            if (it < NIT) tp_load(da, lane, wa);
            while (it < NIT) {
                const int itb = it + NGW; if (itb < NIT) { db = mk(itb); tp_load(db, lane, wb); }
                tp_store(da, lane, wa, scr);
                if (itb >= NIT) break;
                const int ita = itb + NGW; if (ita < NIT) { da = mk(ita); tp_load(da, lane, wa); }
                tp_store(db, lane, wb, scr);
                it = ita;
            }
        }
        for (int m = gw; m < SEQ; m += NGW) {
            const v4f* xr = (const v4f*)(a.in[0] + (size_t)m * DM) + lane; v2u* bo = (v2u*)(XB + (size_t)m * DM) + lane;
            float s = 0.f;
#pragma unroll
            for (int j = 0; j < 8; ++j) { const v4f v = xr[64 * j]; v2u w; w.x = pk2(v.x, v.y); w.y = pk2(v.z, v.w); bo[64 * j] = w; s += (v.x * v.x + v.y * v.y) + (v.z * v.z + v.w * v.w); }
            s = wave_sum(s);
            if (lane < 32) SS[(size_t)m * 32 + lane] = lane == 0 ? s : 0.f;
        }
        for (int i = bx * NTHR + tid; i < SEQ * 32; i += G * NTHR) {
            const int t = i >> 5, j = i & 31; double rev = (double)t * a.invf[j] * 0.15915494309189535; rev -= floor(rev);
            const float rf = (float)rev; COS[i] = __builtin_amdgcn_cosf(rf); SIN[i] = __builtin_amdgcn_sinf(rf);
        }
        if (bx == 0 && wave < DEPTH) {
            const int l = wave;
            const float p1 = wave_sum(a.in[3][l * 64 + lane] * a.in[4][l * 64 + lane]), p2 = wave_sum(a.in[5][l * 64 + lane] * a.in[6][l * 64 + lane]);
            if (lane == 0) LAM[l] = expf(p1) - expf(p2) + a.lam_init[l];
        }
    }
    GRID_SYNC();

#pragma unroll 1
    for (int l = 0; l < DEPTH; ++l) {
        const float* ss1 = SS + (size_t)(2 * l) * SEQ * 32; float* ss2 = SS + (size_t)(2 * l + 1) * SEQ * 32; float* ss3 = SS + (size_t)(2 * l + 2) * SEQ * 32;
        for (int rep = 0; rep < REP_P1; ++rep) {
            pg8::Gemm g{XB, WinT + (size_t)l * INC * DM, SEQ, INC, DM}; pg8::StaticOrder S; S.init(SEQ, INC, G, bx);
            pg8::EpiProj E{PROJ, ss1, COS, SIN};
            pg8::gemm_phase<pg8::EpiProj, pg8::StaticOrder, true, true>(ldsl, g, S, E);
        }
        xcd_barrier(xbar);
        {
            for (int rep = 0; rep < REP_P2; ++rep)
            for (int u = bx; u < 8 * 32; u += G) { const int h = u >> 5, rb = u & 31;
                att::na_unit(PROJ, MIX, NASS, h, rb, a.in[9] + ((size_t)l * 8 + h) * 15 * 31, (char*)lds); }
            const float lam = LAM[l], oml = 1.0f - a.lam_init[l];
            for (int rep = 0; rep < REP_P3; ++rep)
            for (int u = bx; u < 8 * 64; u += G) { const int h = u & 7, qb = u >> 3;
                att::diff_unit(PROJ, MIX, h, qb * 128, lam, oml, a.in[7] + l * 128, (char*)lds); }
        }
        xcd_barrier(xbar);
        for (int rep = 0; rep < REP_P4; ++rep) {
            pg8::Gemm g{MIX, WoutT + (size_t)l * DM * DM, SEQ, DM, DM}; pg8::StaticOrder S; S.init(SEQ, DM, G, bx);
            pg8::EpiResidMid E{(l == 0 && rep == 0) ? a.in[0] : (const float*)X, X, XB, ss2, (rep & 1) ? -1.f : 1.f, NASS};
            pg8::gemm_phase<pg8::EpiResidMid, pg8::StaticOrder, true, true>(ldsl, g, S, E);
        }
        xcd_barrier(xbar);
        for (int rep = 0; rep < REP_P5; ++rep) {
            pg8::Gemm g{XB, WmiT + (size_t)l * FF * DM, SEQ, FF, DM}; pg8::StaticOrder S; S.init(SEQ, FF, G, bx);
            pg8::EpiRelu2 E{U, ss2};
            pg8::gemm_phase<pg8::EpiRelu2, pg8::StaticOrder, true, true>(ldsl, g, S, E);
        }
        xcd_barrier(xbar);
        for (int rep = 0; rep < REP_P6; ++rep) {
            pg8::Gemm g{U, WmoT + (size_t)l * DM * FF, SEQ, DM, FF}; pg8::StaticOrder S; S.init(SEQ, DM, G, bx);
            pg8::EpiResid E{X, X, XB, ss3, (rep & 1) ? -1.f : 1.f, nullptr};
            pg8::gemm_phase<pg8::EpiResid, pg8::StaticOrder, true, true>(ldsl, g, S, E);
        }
        xcd_barrier(xbar);
    }
    {
        const float* fg = a.in[14]; const float* ssf = SS + (size_t)8 * SEQ * 32;
        int lnf = threadIdx.x; asm volatile("" : "+v"(lnf)); lnf &= 63;
        for (int m = gw; m < SEQ; m += NGW) {
            const float rn = rsqrtf(wave_sum(lnf < 32 ? ssf[(size_t)m * 32 + lnf] : 0.f) * (1.0f / 2048.0f) + 1e-6f);
            const v4f* xr = (const v4f*)(X + (size_t)m * DM) + lnf; v4f* xo = (v4f*)(a.out + (size_t)m * DM) + lnf; const v4f* gp = (const v4f*)fg + lnf;
#pragma unroll
            for (int j = 0; j < 8; ++j) xo[64 * j] = xr[64 * j] * rn * gp[64 * j];
        }
    }
}

extern "C" void kernel_launch(void* const* d_in, const int* in_sizes, int n_in, void* d_out, int out_size, void* d_ws, size_t ws_size, hipStream_t stream) {
    static int grid_blocks = 0;
    if (grid_blocks == 0) {
        if (n_in != 15 || out_size != SEQ * DM || ws_size < WS_END) { fprintf(stderr, "kernel_launch: unexpected shapes (n_in %d out %d ws %zu, need %zu)\n", n_in, out_size, ws_size, (size_t)WS_END); grid_blocks = -1; return; }
        int dev = 0, cus = 0, per_cu = 0;
        hipGetDevice(&dev); hipDeviceGetAttribute(&cus, hipDeviceAttributeMultiprocessorCount, dev);
        if (hipFuncSetAttribute((const void*)fwd_megakernel, hipFuncAttributeMaxDynamicSharedMemorySize, LDS_BYTES) != hipSuccess) { fprintf(stderr, "kernel_launch: hipFuncSetAttribute failed\n"); grid_blocks = -1; return; }
        if (hipOccupancyMaxActiveBlocksPerMultiprocessor(&per_cu, (const void*)fwd_megakernel, NTHR, LDS_BYTES) != hipSuccess || per_cu < 1) { fprintf(stderr, "kernel_launch: occupancy query gave %d\n", per_cu); per_cu = 1; (void)hipGetLastError(); }
        grid_blocks = cus * per_cu;
    }
    if (grid_blocks < 0) return;
    Args a{};
    for (int i = 0; i < 15; ++i) a.in[i] = (const float*)d_in[i];
    a.out = (float*)d_out; a.ws = (unsigned char*)d_ws;
    for (int j = 0; j < 32; ++j) a.invf[j] = 1.0 / pow(10000.0, (double)(2 * j) / 64.0);
    for (int l = 0; l < 4; ++l) a.lam_init[l] = (float)(0.8 - 0.6 * exp(-0.3 * l));
    if (hipMemsetAsync((char*)d_ws + WS_BAR, 0, XCD_BAR_WORDS * 4, stream) != hipSuccess) { fprintf(stderr, "kernel_launch: hipMemsetAsync of the barrier words failed\n"); return; }
    void* args[] = {&a};
    hipError_t e = hipLaunchCooperativeKernel((void*)fwd_megakernel, dim3(grid_blocks), dim3(NTHR), args, LDS_BYTES, stream);
    if (e != hipSuccess) fprintf(stderr, "cooperative launch failed: %s (grid %d)\n", hipGetErrorString(e), grid_blocks);
}
```

```cpp
#include <hip/hip_runtime.h>
#include <hip/hip_cooperative_groups.h>
#include <cstdio>
#include <cstdint>
namespace cg = cooperative_groups;
namespace pg8 {
#define PG8_LAS __attribute__((address_space(3)))
typedef unsigned short bf16_t;
typedef short bf16x8 __attribute__((ext_vector_type(8)));
typedef float f32x4 __attribute__((ext_vector_type(4)));
typedef unsigned u32x4 __attribute__((ext_vector_type(4)));
constexpr int BM = 256, BK = 64, HALF = 128, HTB = HALF * BK * 2  , STAGE_BYTES = 8 * HTB, NXCD = 8, WGM = 8;

__host__ __device__ __forceinline__ int lds_byte(int r, int c) { const int st = (r >> 4) * 2 + (c >> 5), rr = r & 15, cc = c & 31, ob = rr * 64 + cc * 2; return st * 1024 + (ob ^ (((ob >> 9) & 1) << 5)); }
__host__ __device__ __forceinline__ void stage_rc(int b, int& R, int& C) { const int st = b / 1024, sb = b % 1024, swz = sb ^ (((sb >> 9) & 1) << 5); R = (st >> 1) * 16 + swz / 64; C = (st & 1) * 32 + (swz % 64) / 2; }
__host__ __device__ __forceinline__ int perm32(int rho) { const int n = rho >> 4, i = rho & 15; return 8 * (i >> 2) + 4 * n + (i & 3); }

struct Unit { int pm, pn; };
struct Gemm { const bf16_t* A; const bf16_t* Bt; int M, N, K; };

struct StaticOrder {
    int nM, nN, nwg, G, c;
    __host__ __device__ void init(int M, int N, int G_, int c_) { nM = M / BM; nN = N / BM; nwg = nM * nN; G = G_; c = c_; }
    __host__ __device__ bool next(int i, Unit& u) const {
        const long L = (long)i * G + c; if (L >= nwg) return false;
        int wgid = (int)L; { const int q = nwg / NXCD, r = nwg % NXCD, xcd = wgid % NXCD, off = wgid / NXCD; wgid = (xcd < r ? xcd * (q + 1) : r * (q + 1) + (xcd - r) * q) + off; }
        const int nig = WGM * nN, gid = wgid / nig, fm = gid * WGM, gsz = (nM - fm) < WGM ? (nM - fm) : WGM;
        u.pm = fm + ((wgid % nig) % gsz); u.pn = (wgid % nig) / gsz; return true;
    }
    __device__ __forceinline__ void a_ready(const Unit&) const {}
    __device__ __forceinline__ void done(const Unit&) const {}
};

__device__ __forceinline__ unsigned cvt_pk_bf16(float lo, float hi) { unsigned r; asm volatile("v_cvt_pk_bf16_f32 %0, %1, %2" : "=v"(r) : "v"(lo), "v"(hi)); return r; }
typedef float f32x2 __attribute__((ext_vector_type(2)));
typedef unsigned u32x2 __attribute__((ext_vector_type(2)));
constexpr float RMS_EPS = 1e-6f;
__device__ __forceinline__ float row_rstd(const float* ss, int row, int fq) {
    const f32x4* sp = (const f32x4*)(ss + (size_t)row * 32 + fq * 8); const f32x4 a = sp[0], b = sp[1];
    float s = ((a[0] + a[1]) + (a[2] + a[3])) + ((b[0] + b[1]) + (b[2] + b[3]));
    s += __shfl_xor(s, 16); s += __shfl_xor(s, 32);
    return rsqrtf(s * (1.0f / 2048.0f) + RMS_EPS);
}
struct EpiProj {
    static constexpr bool PERM = true, AFTER_DRAIN = false, MIDK = false;
    bf16_t* O; const float* ss; const float* cosT; const float* sinT;
    __device__ __forceinline__ void operator()(const f32x4 (&acc)[2][2][4][2], const Unit& u, int wr, int wc, int fr, int fq) const {
        const int row0 = u.pm * BM + wr * 64 + fr; const int colt = u.pn * BM;
        const bool rope = colt < 2048;
        const float qs = colt < 1024 ? 0.125f * 1.4426950408889634f : 1.f;
        const int g = (wc & 1) * 4 + fq;
        const int pos0 = colt + wc * 32 + 8 * fq;
        const int rbase = colt + 64 * (wc >> 1) + 4 * g;
#pragma unroll
        for (int ai = 0; ai < 2; ++ai)
#pragma unroll
            for (int m = 0; m < 4; ++m) {
                const int row = row0 + ai * HALF + m * 16;
                const float rs = row_rstd(ss, row, fq) * qs;
                bf16_t* rowp = O + (size_t)row * 6144;
                if (rope) {
                    const f32x4 c4 = *(const f32x4*)(cosT + row * 32 + 4 * g), s4 = *(const f32x4*)(sinT + row * 32 + 4 * g);
#pragma unroll
                    for (int bj = 0; bj < 2; ++bj) {
                        const f32x4 v0 = acc[ai][bj][m][0] * rs, v1 = acc[ai][bj][m][1] * rs;
                        const f32x4 o1 = v0 * c4 - v1 * s4, o2 = v1 * c4 + v0 * s4;
                        u32x2 w1, w2; w1.x = cvt_pk_bf16(o1[0], o1[1]); w1.y = cvt_pk_bf16(o1[2], o1[3]); w2.x = cvt_pk_bf16(o2[0], o2[1]); w2.y = cvt_pk_bf16(o2[2], o2[3]);
                        *(u32x2*)(rowp + rbase + bj * HALF) = w1; *(u32x2*)(rowp + rbase + bj * HALF + 32) = w2;
                    }
                } else {
#pragma unroll
                    for (int bj = 0; bj < 2; ++bj) {
                        const f32x4 v0 = acc[ai][bj][m][0] * rs, v1 = acc[ai][bj][m][1] * rs;
                        u32x4 w; w.x = cvt_pk_bf16(v0[0], v0[1]); w.y = cvt_pk_bf16(v0[2], v0[3]); w.z = cvt_pk_bf16(v1[0], v1[1]); w.w = cvt_pk_bf16(v1[2], v1[3]);
                        *(u32x4*)(rowp + pos0 + bj * HALF) = w;
                    }
                }
            }
    }
};
struct EpiRelu2 {
    static constexpr bool PERM = true, AFTER_DRAIN = false, MIDK = false;
    bf16_t* O; const float* ss;
    __device__ __forceinline__ void operator()(const f32x4 (&acc)[2][2][4][2], const Unit& u, int wr, int wc, int fr, int fq) const {
        const int row0 = u.pm * BM + wr * 64 + fr; const int pos0 = u.pn * BM + wc * 32 + 8 * fq;
#pragma unroll
        for (int ai = 0; ai < 2; ++ai)
#pragma unroll
            for (int m = 0; m < 4; ++m) {
                const int row = row0 + ai * HALF + m * 16;
                const float rs = row_rstd(ss, row, fq);
                bf16_t* rowp = O + (size_t)row * 8192 + pos0;
#pragma unroll
                for (int bj = 0; bj < 2; ++bj) {
                    f32x4 v0 = acc[ai][bj][m][0] * rs, v1 = acc[ai][bj][m][1] * rs;
#pragma unroll
                    for (int e = 0; e < 4; ++e) { v0[e] = fmaxf(v0[e], 0.f); v1[e] = fmaxf(v1[e], 0.f); }
                    v0 = v0 * v0; v1 = v1 * v1;
                    u32x4 w; w.x = cvt_pk_bf16(v0[0], v0[1]); w.y = cvt_pk_bf16(v0[2], v0[3]); w.z = cvt_pk_bf16(v1[0], v1[1]); w.w = cvt_pk_bf16(v1[2], v1[3]);
                    *(u32x4*)(rowp + bj * HALF) = w;
                }
            }
    }
};
template <bool MID> struct EpiResidT {
    static constexpr bool PERM = false, AFTER_DRAIN = false, MIDK = MID;
    const float* Xin; float* X; bf16_t* XB; float* ssout; float sign; const float* nass;
    __device__ __forceinline__ void mid(f32x4 (&acc)[2][2][4][2], const Unit& u, int wr, int wc, int fr, int fq) const {
        int t_ = threadIdx.x; asm volatile("" : "+v"(t_));
        const int row0 = u.pm * BM + wr * 64 + (t_ & 15);
#pragma unroll
        for (int ai = 0; ai < 2; ++ai)
#pragma unroll
            for (int m = 0; m < 4; ++m) {
                const f32x4* sp = (const f32x4*)(nass + (size_t)(row0 + ai * HALF + m * 16) * 8); const f32x4 a = sp[0], b = sp[1];
                const float rn = rsqrtf((((a[0] + a[1]) + (a[2] + a[3])) + ((b[0] + b[1]) + (b[2] + b[3]))) * (1.0f / 1024.0f) + RMS_EPS);
#pragma unroll
                for (int bj = 0; bj < 2; ++bj)
#pragma unroll
                    for (int n = 0; n < 2; ++n) acc[ai][bj][m][n] = acc[ai][bj][m][n] * rn;
            }
    }
    __device__ __forceinline__ void operator()(const f32x4 (&acc)[2][2][4][2], const Unit& u, int wr, int wc, int fr, int fq) const {
        const int row0 = u.pm * BM + wr * 64 + fr; const int col0 = u.pn * BM + wc * 32 + 4 * fq;
#pragma unroll
        for (int ai = 0; ai < 2; ++ai)
#pragma unroll
            for (int m = 0; m < 4; ++m) {
                const int row = row0 + ai * HALF + m * 16; float sq = 0.f;
#pragma unroll
                for (int bj = 0; bj < 2; ++bj)
#pragma unroll
                    for (int n = 0; n < 2; ++n) {
                        const size_t off = (size_t)row * 2048 + col0 + bj * HALF + n * 16;
                        const f32x4 xv = *(const f32x4*)(Xin + off) + acc[ai][bj][m][n] * sign;
                        *(f32x4*)(X + off) = xv;
                        u32x2 w; w.x = cvt_pk_bf16(xv[0], xv[1]); w.y = cvt_pk_bf16(xv[2], xv[3]);
                        *(u32x2*)(XB + off) = w;
                        sq += (xv[0] * xv[0] + xv[1] * xv[1]) + (xv[2] * xv[2] + xv[3] * xv[3]);
                    }
                sq += __shfl_xor(sq, 16); sq += __shfl_xor(sq, 32);
                if (fq == 0) ssout[(size_t)row * 32 + u.pn * 4 + wc] = sq;
            }
    }
};
typedef EpiResidT<false> EpiResid; typedef EpiResidT<true> EpiResidMid;
template <class Epi, class Sched, bool ALIGN_EPI = false, bool SP2 = false>
__device__ __forceinline__ void gemm_phase(PG8_LAS unsigned char* lds, const Gemm g, const Sched& S, const Epi& E) {
    int tid_ = threadIdx.x; asm volatile("" : "+v"(tid_));
    const int tid = tid_, wid = __builtin_amdgcn_readfirstlane(tid >> 6), lane = tid & 63, wr = wid >> 2, wc = wid & 3, fr = lane & 15, fq = lane >> 4;
    const int K = g.K, nt = K / BK;
    unsigned voffA[2], voffB[2];
#pragma unroll
    for (int i = 0; i < 2; ++i) { int R, C; stage_rc(tid * 16 + i * 8192, R, C); const int Rb = Epi::PERM ? ((R & ~31) + perm32(R & 31)) : R;
        voffA[i] = (unsigned)(R * K + C) * 2u; voffB[i] = (unsigned)(Rb * K + C) * 2u; }
    const size_t kstep = (size_t)(BK * 2);
    const size_t hstep = (size_t)HALF * K * 2;
    const size_t tstep = 2 * hstep;
    const unsigned ldsw = (unsigned)wid * 1024u;
    const int aoff = lds_byte(wr * 64 + fr, fq * 8), boff = lds_byte(wc * 32 + fr, fq * 8);
#define PG8_SA(b, h) (((b) * 2 + (h)) * HTB)
#define PG8_SB(b, h) ((4 + (b) * 2 + (h)) * HTB)
#define PG8_STAGE(bufoff, gbase, voff) do { _Pragma("unroll") for (int _i = 0; _i < 2; ++_i) \
        __builtin_amdgcn_global_load_lds((const unsigned*)((const char*)(gbase) + (voff)[_i]), (PG8_LAS unsigned*)(lds + (bufoff) + ldsw + _i * 8192), 16, 0, 0); } while (0)
#define PG8_LDA(dst, b, h) do { _Pragma("unroll") for (int m = 0; m < 4; ++m) _Pragma("unroll") for (int k = 0; k < 2; ++k) dst[m][k] = *(const PG8_LAS bf16x8*)(lds + PG8_SA(b, h) + aoff + m * 2048 + k * 1024); } while (0)
#define PG8_LDB(dst, b, h) do { _Pragma("unroll") for (int n = 0; n < 2; ++n) _Pragma("unroll") for (int k = 0; k < 2; ++k) dst[n][k] = *(const PG8_LAS bf16x8*)(lds + PG8_SB(b, h) + boff + n * 2048 + k * 1024); } while (0)
#define PG8_MMA(ai, bj, At, Bt) do { __builtin_amdgcn_s_setprio(1); _Pragma("unroll") for (int m = 0; m < 4; ++m) _Pragma("unroll") for (int n = 0; n < 2; ++n) _Pragma("unroll") for (int k = 0; k < 2; ++k) \
        acc[ai][bj][m][n] = __builtin_amdgcn_mfma_f32_16x16x32_bf16(Bt[n][k], At[m][k], acc[ai][bj][m][n], 0, 0, 0); __builtin_amdgcn_s_setprio(0); } while (0)
#define PG8_WAIT_V(n) asm volatile("s_waitcnt vmcnt(" #n ")" ::: "memory")
#define PG8_WAIT_L(n) asm volatile("s_waitcnt lgkmcnt(" #n ")" ::: "memory")
#define PG8_BAR __builtin_amdgcn_s_barrier()
#define PG8_SCHED __builtin_amdgcn_sched_barrier(0)
    Unit cur, nxt; int ui = 0;
    if (!S.next(0, cur)) return;
    f32x4 acc[2][2][4][2];
#pragma unroll
    for (int a = 0; a < 2; ++a)
#pragma unroll
        for (int b = 0; b < 2; ++b)
#pragma unroll
            for (int m = 0; m < 4; ++m)
#pragma unroll
                for (int n = 0; n < 2; ++n) acc[a][b][m][n] = (f32x4){0.f, 0.f, 0.f, 0.f};
    bf16x8 At[4][2], B0[2][2], B1[2][2];
    const char* cA = (const char*)g.A + (size_t)cur.pm * tstep; const char* cB = (const char*)g.Bt + (size_t)cur.pn * tstep;
    S.a_ready(cur);
    if constexpr (SP2) {
        PG8_STAGE(PG8_SB(0, 0), cB, voffB); PG8_STAGE(PG8_SB(0, 1), cB + hstep, voffB); PG8_STAGE(PG8_SA(0, 0), cA, voffA); PG8_STAGE(PG8_SA(0, 1), cA + hstep, voffA);
        if (wr == 1) PG8_BAR;
        PG8_WAIT_V(2); PG8_BAR;
        PG8_STAGE(PG8_SB(1, 0), cB + kstep, voffB); PG8_STAGE(PG8_SA(1, 0), cA + kstep, voffA); PG8_STAGE(PG8_SB(1, 1), cB + hstep + kstep, voffB);
        PG8_WAIT_V(6); PG8_BAR;
    } else {
        PG8_STAGE(PG8_SB(0, 0), cB, voffB); PG8_STAGE(PG8_SA(0, 0), cA, voffA); PG8_STAGE(PG8_SB(0, 1), cB + hstep, voffB); PG8_STAGE(PG8_SA(0, 1), cA + hstep, voffA);
        if (wr == 1) PG8_BAR;
        PG8_WAIT_V(4); PG8_BAR;
        PG8_STAGE(PG8_SB(1, 0), cB + kstep, voffB); PG8_STAGE(PG8_SA(1, 0), cA + kstep, voffA); PG8_STAGE(PG8_SB(1, 1), cB + hstep + kstep, voffB);
        PG8_WAIT_V(6); PG8_BAR;
    }
    for (;;) {
        const bool has_next = S.next(ui + 1, nxt);
        const char* nA = has_next ? (const char*)g.A + (size_t)nxt.pm * tstep : cA; const char* nB = has_next ? (const char*)g.Bt + (size_t)nxt.pn * tstep : cB;
        for (int t = 0; t < nt; t += 2) {
            if constexpr (Epi::MIDK) { if (t == nt / 2) E.mid(acc, cur, wr, wc, fr, fq); }
            const bool last = (t == nt - 2);
            const char* a1 = cA + (size_t)(t + 1) * kstep;
            const char* a2 = last ? nA : cA + (size_t)(t + 2) * kstep; const char* b2 = last ? nB : cB + (size_t)(t + 2) * kstep;
            const char* a3 = a2 + kstep; const char* b3 = b2 + kstep;
            if (last && has_next) S.a_ready(nxt);
            if constexpr (SP2) {
            PG8_LDB(B0, 0, 0); PG8_LDB(B1, 0, 1); PG8_SCHED; PG8_LDA(At, 0, 0); PG8_STAGE(PG8_SA(1, 1), a1 + hstep, voffA);
            PG8_WAIT_V(8); PG8_WAIT_L(0); PG8_BAR; PG8_MMA(0, 0, At, B0); PG8_MMA(0, 1, At, B1); PG8_BAR; PG8_SCHED;
            PG8_LDA(At, 0, 1); PG8_STAGE(PG8_SB(0, 0), b2, voffB); PG8_STAGE(PG8_SB(0, 1), b2 + hstep, voffB); PG8_STAGE(PG8_SA(0, 0), a2, voffA);
            PG8_WAIT_V(8); PG8_WAIT_L(0); PG8_BAR; PG8_MMA(1, 0, At, B0); PG8_MMA(1, 1, At, B1); PG8_BAR; PG8_SCHED;
            PG8_LDB(B0, 1, 0); PG8_LDB(B1, 1, 1); PG8_SCHED; PG8_LDA(At, 1, 0); PG8_STAGE(PG8_SA(0, 1), a2 + hstep, voffA);
            PG8_WAIT_V(8); PG8_WAIT_L(0); PG8_BAR; PG8_MMA(0, 0, At, B0); PG8_MMA(0, 1, At, B1); PG8_BAR; PG8_SCHED;
            PG8_LDA(At, 1, 1); PG8_STAGE(PG8_SB(1, 0), b3, voffB); PG8_STAGE(PG8_SB(1, 1), b3 + hstep, voffB); PG8_STAGE(PG8_SA(1, 0), a3, voffA);
            PG8_WAIT_V(8); PG8_WAIT_L(0); PG8_BAR; PG8_MMA(1, 0, At, B0); PG8_MMA(1, 1, At, B1); PG8_BAR; PG8_SCHED;
            } else {
            PG8_LDB(B0, 0, 0); PG8_SCHED; PG8_LDA(At, 0, 0); PG8_STAGE(PG8_SA(1, 1), a1 + hstep, voffA);
            PG8_WAIT_L(8); PG8_BAR; PG8_WAIT_L(0); PG8_MMA(0, 0, At, B0); PG8_BAR; PG8_SCHED;
            PG8_LDB(B1, 0, 1); PG8_STAGE(PG8_SB(0, 0), b2, voffB);
            PG8_BAR; PG8_WAIT_L(0); PG8_MMA(0, 1, At, B1); PG8_BAR;
            PG8_LDA(At, 0, 1); PG8_STAGE(PG8_SA(0, 0), a2, voffA);
            PG8_BAR; PG8_WAIT_L(0); PG8_MMA(1, 0, At, B0); PG8_BAR; PG8_SCHED;
            PG8_STAGE(PG8_SB(0, 1), b2 + hstep, voffB);
            PG8_WAIT_V(6); PG8_BAR; PG8_MMA(1, 1, At, B1); PG8_BAR;
            PG8_LDB(B0, 1, 0); PG8_SCHED; PG8_LDA(At, 1, 0); PG8_STAGE(PG8_SA(0, 1), a2 + hstep, voffA);
            PG8_WAIT_L(8); PG8_BAR; PG8_WAIT_L(0); PG8_MMA(0, 0, At, B0); PG8_BAR; PG8_SCHED;
            PG8_LDB(B1, 1, 1); PG8_STAGE(PG8_SB(1, 0), b3, voffB);
            PG8_BAR; PG8_WAIT_L(0); PG8_MMA(0, 1, At, B1); PG8_BAR;
            PG8_LDA(At, 1, 1); PG8_STAGE(PG8_SA(1, 0), a3, voffA);
            PG8_BAR; PG8_WAIT_L(0); PG8_MMA(1, 0, At, B0); PG8_BAR; PG8_SCHED;
            PG8_STAGE(PG8_SB(1, 1), b3 + hstep, voffB);
            PG8_WAIT_V(6); PG8_BAR; PG8_MMA(1, 1, At, B1); PG8_BAR;
            }
        }
        if constexpr (ALIGN_EPI) { if (wr == 0) PG8_BAR; }
        if constexpr (!Epi::AFTER_DRAIN) { E(acc, cur, wr, wc, fr, fq); S.done(cur); }
        if (!has_next) break;
#pragma unroll
        for (int a = 0; a < 2; ++a)
#pragma unroll
            for (int b = 0; b < 2; ++b)
#pragma unroll
                for (int m = 0; m < 4; ++m)
#pragma unroll
                    for (int n = 0; n < 2; ++n) acc[a][b][m][n] = (f32x4){0.f, 0.f, 0.f, 0.f};
        cur = nxt; cA = nA; cB = nB; ++ui;
        if constexpr (ALIGN_EPI) { if (wr == 1) PG8_BAR; }
    }
    PG8_WAIT_V(0);
    if constexpr (!ALIGN_EPI) { if (wr == 0) PG8_BAR; }
    PG8_BAR;
    if constexpr (Epi::AFTER_DRAIN) { E.fused(acc, cur, wr, wc, fr, fq, lds, wid, lane); S.done(cur); }
#undef PG8_SA
#undef PG8_SB
#undef PG8_STAGE
#undef PG8_LDA
#undef PG8_LDB
#undef PG8_MMA
#undef PG8_WAIT_V
#undef PG8_WAIT_L
#undef PG8_BAR
#undef PG8_SCHED
}
}
namespace att {
typedef unsigned short bf16;
using bf16x8 = __attribute__((ext_vector_type(8))) short;
using s16x4  = __attribute__((ext_vector_type(4))) short;
using f32x16 = __attribute__((ext_vector_type(16))) float;
using u32x4  = __attribute__((ext_vector_type(4))) unsigned;
constexpr int LDP = 6144;
constexpr int SHM_V = 64 * 128 * 2, SHM_K = 64 * 128 * 2;
constexpr int OFF_WS = 2 * SHM_V + 2 * SHM_K, OFF_RPB = OFF_WS + 8 * 64 * 4, ATT_LDS = OFF_RPB + 2048;
constexpr float THR = 8.f;
#define KSWZ(row, colB) ((row) * 256 + ((colB) ^ (((row) & 7) << 4)))
#define SBAR() __builtin_amdgcn_sched_barrier(0)
__device__ __forceinline__ int crow(int r, int hi) { return (r & 3) + 8 * (r >> 2) + 4 * hi; }
__device__ __forceinline__ unsigned cvtpk(float lo, float hi) {
  unsigned r; asm volatile("v_cvt_pk_bf16_f32 %0, %1, %2" : "=v"(r) : "v"(lo), "v"(hi)); return r;
}
__device__ __forceinline__ bf16x8 ld8(const bf16* p) { return *reinterpret_cast<const bf16x8*>(p); }

template <int MODE> struct Cfg;
template <> struct Cfg<0> { static constexpr int ND0 = 4; static constexpr float SCALE = 0.125f; };
template <> struct Cfg<1> { static constexpr int ND0 = 8; static constexpr float SCALE = 0.088388347648318440f; };

template <int MODE>
__device__ __forceinline__ void partialSM(f32x16& p0, f32x16& p1, float& m_reg, float& mn, float& alpha) {
  constexpr float SCALE = Cfg<MODE>::SCALE;
  constexpr float C = SCALE * 1.4426950408889634f;
  float pmax = p0[0];
#pragma unroll
  for (int r = 1; r < 16; ++r) pmax = fmaxf(pmax, p0[r]);
#pragma unroll
  for (int r = 0; r < 16; ++r) pmax = fmaxf(pmax, p1[r]);
  { auto rr = __builtin_amdgcn_permlane32_swap(__float_as_uint(pmax), __float_as_uint(pmax), false, false);
    pmax = fmaxf(__uint_as_float(rr[0]), __uint_as_float(rr[1])); }
  if (__builtin_expect(__all(pmax - m_reg <= THR / SCALE), 1)) { mn = m_reg; alpha = 1.f; }
  else { mn = fmaxf(m_reg, pmax); alpha = __builtin_amdgcn_exp2f((m_reg - mn) * C); m_reg = mn; }
  float mnC = -mn * C;
#pragma unroll
  for (int r = 0; r < 16; ++r) p0[r] = fmaf(p0[r], C, mnC);
#pragma unroll
  for (int r = 0; r < 16; ++r) p1[r] = fmaf(p1[r], C, mnC);
#pragma unroll
  for (int r = 0; r < 16; ++r) p0[r] = __builtin_amdgcn_exp2f(p0[r]);
}
__device__ __forceinline__ void finishSM(f32x16& p0, f32x16& p1, float alpha, float& l_reg, bf16x8& pa0, bf16x8& pa1, bf16x8& pa2, bf16x8& pa3) {
#pragma unroll
  for (int r = 0; r < 16; ++r) p1[r] = __builtin_amdgcn_exp2f(p1[r]);
  float ps = 0;
#pragma unroll
  for (int r = 0; r < 16; ++r) ps += p0[r];
#pragma unroll
  for (int r = 0; r < 16; ++r) ps += p1[r];
  { auto rr = __builtin_amdgcn_permlane32_swap(__float_as_uint(ps), __float_as_uint(ps), false, false);
    ps = __uint_as_float(rr[0]) + __uint_as_float(rr[1]); }
  l_reg = l_reg * alpha + ps;
#define PK4(P, BASE, OUT) do { u32x4 w = {cvtpk(P[BASE + 0], P[BASE + 1]), cvtpk(P[BASE + 2], P[BASE + 3]), cvtpk(P[BASE + 4], P[BASE + 5]), cvtpk(P[BASE + 6], P[BASE + 7])}; \
    OUT = *reinterpret_cast<bf16x8*>(&w); } while (0)
  PK4(p0, 0, pa0); PK4(p0, 8, pa1); PK4(p1, 0, pa2); PK4(p1, 8, pa3);
#undef PK4
}
__device__ __forceinline__ void finishSM_ns(f32x16& p0, f32x16& p1, bf16x8& pa0, bf16x8& pa1, bf16x8& pa2, bf16x8& pa3) {
#pragma unroll
  for (int r = 0; r < 16; ++r) p1[r] = __builtin_amdgcn_exp2f(p1[r]);
#define PK4(P, BASE, OUT) do { u32x4 w = {cvtpk(P[BASE + 0], P[BASE + 1]), cvtpk(P[BASE + 2], P[BASE + 3]), cvtpk(P[BASE + 4], P[BASE + 5]), cvtpk(P[BASE + 6], P[BASE + 7])}; \
    OUT = *reinterpret_cast<bf16x8*>(&w); } while (0)
  PK4(p0, 0, pa0); PK4(p0, 8, pa1); PK4(p1, 0, pa2); PK4(p1, 8, pa3);
#undef PK4
}
__device__ __forceinline__ void sm_sum(const f32x16& p0, const f32x16& p1, float& ps) {
  ps = 0;
#pragma unroll
  for (int r = 0; r < 16; ++r) ps += p0[r];
#pragma unroll
  for (int r = 0; r < 16; ++r) ps += p1[r];
}
template <int MODE>
__device__ __forceinline__ void sm_lmax(float ps, float alpha_prev, float& l_reg, const f32x16& p0, const f32x16& p1, float& m_reg, float& mn, float& alpha, float& mnC) {
  constexpr float SCALE = Cfg<MODE>::SCALE; constexpr float C = SCALE * 1.4426950408889634f;
  { auto rr = __builtin_amdgcn_permlane32_swap(__float_as_uint(ps), __float_as_uint(ps), false, false);
    ps = __uint_as_float(rr[0]) + __uint_as_float(rr[1]); }
  l_reg = l_reg * alpha_prev + ps;
  float pmax = p0[0];
#pragma unroll
  for (int r = 1; r < 16; ++r) pmax = fmaxf(pmax, p0[r]);
#pragma unroll
  for (int r = 0; r < 16; ++r) pmax = fmaxf(pmax, p1[r]);
  { auto rr = __builtin_amdgcn_permlane32_swap(__float_as_uint(pmax), __float_as_uint(pmax), false, false);
    pmax = fmaxf(__uint_as_float(rr[0]), __uint_as_float(rr[1])); }
  if (__builtin_expect(__all(pmax - m_reg <= THR / SCALE), 1)) { mn = m_reg; alpha = 1.f; }
  else { mn = fmaxf(m_reg, pmax); alpha = __builtin_amdgcn_exp2f((m_reg - mn) * C); m_reg = mn; }
  mnC = -mn * C;
}
template <int MODE>
__device__ __forceinline__ void sm_fma(f32x16& p0, f32x16& p1, float mnC) {
  constexpr float C = Cfg<MODE>::SCALE * 1.4426950408889634f;
#pragma unroll
  for (int r = 0; r < 16; ++r) p0[r] = fmaf(p0[r], C, mnC);
#pragma unroll
  for (int r = 0; r < 16; ++r) p1[r] = fmaf(p1[r], C, mnC);
}
__device__ __forceinline__ void sm_exp0(f32x16& p0) {
#pragma unroll
  for (int r = 0; r < 16; ++r) p0[r] = __builtin_amdgcn_exp2f(p0[r]);
}
template <int ND0>
__device__ __forceinline__ void qkt(f32x16& p0, f32x16& p1, const bf16* Ks, const bf16x8* qr, int r32, int hi, int kcb) {
  p0 = f32x16{}; p1 = f32x16{};
#pragma unroll
  for (int d0 = 0; d0 < ND0; ++d0) { int cb = kcb + (d0 * 16 + hi * 8) * 2;
    bf16x8 b0 = *reinterpret_cast<const bf16x8*>((const char*)Ks + KSWZ(r32, cb));
    bf16x8 b1 = *reinterpret_cast<const bf16x8*>((const char*)Ks + KSWZ(32 + r32, cb));
    p0 = __builtin_amdgcn_mfma_f32_32x32x16_bf16(b0, qr[d0], p0, 0, 0, 0);
    p1 = __builtin_amdgcn_mfma_f32_32x32x16_bf16(b1, qr[d0], p1, 0, 0, 0); }
}
constexpr float THRL = 8.f * 1.4426950408889634f;
template <int ND0>
__device__ __forceinline__ void qk_rd(bf16x8 (&kb0)[ND0], bf16x8 (&kb1)[ND0], const bf16* Ks, int r32, int hi, int kcb) {
#pragma unroll
  for (int d0 = 0; d0 < ND0; ++d0) { int cb = kcb + (d0 * 16 + hi * 8) * 2;
    kb0[d0] = *reinterpret_cast<const bf16x8*>((const char*)Ks + KSWZ(r32, cb));
    kb1[d0] = *reinterpret_cast<const bf16x8*>((const char*)Ks + KSWZ(32 + r32, cb)); }
}
template <int ND0>
__device__ __forceinline__ void qk_mm(f32x16& p0, f32x16& p1, const bf16x8 (&kb0)[ND0], const bf16x8 (&kb1)[ND0], const bf16x8* qr, const f32x16& negm) {
#pragma unroll
  for (int d0 = 0; d0 < ND0; ++d0) {
    if (d0 == 0) { p0 = __builtin_amdgcn_mfma_f32_32x32x16_bf16(kb0[d0], qr[d0], negm, 0, 0, 0); p1 = __builtin_amdgcn_mfma_f32_32x32x16_bf16(kb1[d0], qr[d0], negm, 0, 0, 0); }
    else { p0 = __builtin_amdgcn_mfma_f32_32x32x16_bf16(kb0[d0], qr[d0], p0, 0, 0, 0); p1 = __builtin_amdgcn_mfma_f32_32x32x16_bf16(kb1[d0], qr[d0], p1, 0, 0, 0); } }
}
template <int ND0>
__device__ __forceinline__ void qkt_c(f32x16& p0, f32x16& p1, const bf16* Ks, const bf16x8* qr, int r32, int hi, int kcb, const f32x16& negm) {
  bf16x8 kb0[ND0], kb1[ND0];
#pragma unroll
  for (int d0 = 0; d0 < ND0; ++d0) { int cb = kcb + (d0 * 16 + hi * 8) * 2;
    kb0[d0] = *reinterpret_cast<const bf16x8*>((const char*)Ks + KSWZ(r32, cb));
    kb1[d0] = *reinterpret_cast<const bf16x8*>((const char*)Ks + KSWZ(32 + r32, cb)); }
  SBAR();
#pragma unroll
  for (int d0 = 0; d0 < ND0; ++d0) { const bf16x8 b0 = kb0[d0], b1 = kb1[d0];
    if (d0 == 0) { p0 = __builtin_amdgcn_mfma_f32_32x32x16_bf16(b0, qr[d0], negm, 0, 0, 0); p1 = __builtin_amdgcn_mfma_f32_32x32x16_bf16(b1, qr[d0], negm, 0, 0, 0); }
    else { p0 = __builtin_amdgcn_mfma_f32_32x32x16_bf16(b0, qr[d0], p0, 0, 0, 0); p1 = __builtin_amdgcn_mfma_f32_32x32x16_bf16(b1, qr[d0], p1, 0, 0, 0); } }
}
__device__ __forceinline__ float rowmax32(const f32x16& p0, const f32x16& p1) {
  float pmax = p0[0];
#pragma unroll
  for (int r = 1; r < 16; ++r) pmax = fmaxf(pmax, p0[r]);
#pragma unroll
  for (int r = 0; r < 16; ++r) pmax = fmaxf(pmax, p1[r]);
  auto rr = __builtin_amdgcn_permlane32_swap(__float_as_uint(pmax), __float_as_uint(pmax), false, false);
  return fmaxf(__uint_as_float(rr[0]), __uint_as_float(rr[1]));
}
__device__ __forceinline__ void firstSM_l2(f32x16& p0, f32x16& p1, float& m_reg, f32x16& negm) {
  const float pmax = rowmax32(p0, p1);
  m_reg = pmax;
#pragma unroll
  for (int r = 0; r < 16; ++r) { negm[r] = -pmax; p0[r] -= pmax; p1[r] -= pmax; }
#pragma unroll
  for (int r = 0; r < 16; ++r) p0[r] = __builtin_amdgcn_exp2f(p0[r]);
}
__device__ __forceinline__ void sm_lmax_l2(float ps, float alpha_prev, float& l_reg, f32x16& p0, f32x16& p1, float& m_reg, float& alpha, f32x16& negm) {
  { auto rr = __builtin_amdgcn_permlane32_swap(__float_as_uint(ps), __float_as_uint(ps), false, false);
    ps = __uint_as_float(rr[0]) + __uint_as_float(rr[1]); }
  l_reg = l_reg * alpha_prev + ps;
  const float pmax = rowmax32(p0, p1);
  if (__builtin_expect(__all(pmax <= THRL), 1)) { alpha = 1.f; }
  else { const float dlt = fmaxf(pmax, 0.f); alpha = __builtin_amdgcn_exp2f(-dlt); m_reg += dlt;
#pragma unroll
    for (int r = 0; r < 16; ++r) { negm[r] -= dlt; p0[r] -= dlt; p1[r] -= dlt; } }
}
__device__ __forceinline__ void sm_exp_lo(f32x16& p0) {
#pragma unroll
  for (int r = 0; r < 8; ++r) p0[r] = __builtin_amdgcn_exp2f(p0[r]);
}
__device__ __forceinline__ void sm_exp_hi(f32x16& p0) {
#pragma unroll
  for (int r = 8; r < 16; ++r) p0[r] = __builtin_amdgcn_exp2f(p0[r]);
}
__device__ __forceinline__ int v_st(int k, int c) { return ((k >> 3) * 4 + (c >> 5)) * 512 + ((k & 7) * 32 + (c & 31)) * 2; }
__device__ __forceinline__ int v_rd_base(int lane) { return ((lane & 3) << 3) | (((lane >> 2) & 3) << 6) | (((lane >> 4) & 1) << 5) | (((lane >> 5) & 1) << 8); }
constexpr int v_rd_off(int d0, int ks, int half) { return d0 * 512 + ks * 4096 + half * 2048; }
template <int OFF> __device__ __forceinline__ s16x4 tr_read(int vb) {
  s16x4 r; asm volatile("ds_read_b64_tr_b16 %0, %1 offset:%2" : "=&v"(r) : "v"(vb), "i"(OFF) : "memory"); return r;
}
template <int D0> __device__ __forceinline__ void pv_one(f32x16& od, int vb, bf16x8 pa0, bf16x8 pa1, bf16x8 pa2, bf16x8 pa3) {
  const s16x4 l0 = tr_read<v_rd_off(D0, 0, 0)>(vb), h0 = tr_read<v_rd_off(D0, 0, 1)>(vb), l1 = tr_read<v_rd_off(D0, 1, 0)>(vb), h1 = tr_read<v_rd_off(D0, 1, 1)>(vb);
  const s16x4 l2 = tr_read<v_rd_off(D0, 2, 0)>(vb), h2 = tr_read<v_rd_off(D0, 2, 1)>(vb), l3 = tr_read<v_rd_off(D0, 3, 0)>(vb), h3 = tr_read<v_rd_off(D0, 3, 1)>(vb);
  asm volatile("s_waitcnt lgkmcnt(0)" ::: "memory"); SBAR();
#define PK(L, H) (bf16x8){L[0], L[1], L[2], L[3], H[0], H[1], H[2], H[3]}
  od = __builtin_amdgcn_mfma_f32_32x32x16_bf16(pa0, PK(l0, h0), od, 0, 0, 0);
  od = __builtin_amdgcn_mfma_f32_32x32x16_bf16(pa1, PK(l1, h1), od, 0, 0, 0);
  od = __builtin_amdgcn_mfma_f32_32x32x16_bf16(pa2, PK(l2, h2), od, 0, 0, 0);
  od = __builtin_amdgcn_mfma_f32_32x32x16_bf16(pa3, PK(l3, h3), od, 0, 0, 0);
#undef PK
}
__device__ __forceinline__ void pv_d0(f32x16* o, int vb, bf16x8 pa0, bf16x8 pa1, bf16x8 pa2, bf16x8 pa3) {
  pv_one<0>(o[0], vb, pa0, pa1, pa2, pa3); pv_one<1>(o[1], vb, pa0, pa1, pa2, pa3); pv_one<2>(o[2], vb, pa0, pa1, pa2, pa3); pv_one<3>(o[3], vb, pa0, pa1, pa2, pa3);
}
struct VFrag { s16x4 l0, h0, l1, h1, l2, h2, l3, h3; };
template <int D0> __device__ __forceinline__ void pv_rd(VFrag& f, int vb) {
  f.l0 = tr_read<v_rd_off(D0, 0, 0)>(vb); f.h0 = tr_read<v_rd_off(D0, 0, 1)>(vb); f.l1 = tr_read<v_rd_off(D0, 1, 0)>(vb); f.h1 = tr_read<v_rd_off(D0, 1, 1)>(vb);
  f.l2 = tr_read<v_rd_off(D0, 2, 0)>(vb); f.h2 = tr_read<v_rd_off(D0, 2, 1)>(vb); f.l3 = tr_read<v_rd_off(D0, 3, 0)>(vb); f.h3 = tr_read<v_rd_off(D0, 3, 1)>(vb);
}
template <int NW_>
__device__ __forceinline__ void pv_mm(f32x16& od, const VFrag& f, bf16x8 pa0, bf16x8 pa1, bf16x8 pa2, bf16x8 pa3) {
  if (NW_ == 8) asm volatile("s_waitcnt lgkmcnt(8)" ::: "memory"); else asm volatile("s_waitcnt lgkmcnt(0)" ::: "memory");
  SBAR();
#define PK(L, H) (bf16x8){L[0], L[1], L[2], L[3], H[0], H[1], H[2], H[3]}
  od = __builtin_amdgcn_mfma_f32_32x32x16_bf16(pa0, PK(f.l0, f.h0), od, 0, 0, 0);
  od = __builtin_amdgcn_mfma_f32_32x32x16_bf16(pa1, PK(f.l1, f.h1), od, 0, 0, 0);
  od = __builtin_amdgcn_mfma_f32_32x32x16_bf16(pa2, PK(f.l2, f.h2), od, 0, 0, 0);
  od = __builtin_amdgcn_mfma_f32_32x32x16_bf16(pa3, PK(f.l3, f.h3), od, 0, 0, 0);
#undef PK
}
__device__ __forceinline__ void na_fix(f32x16& p0, f32x16& p1, int kr, int qr_, int rs, int qc, int cs, int hi, const float* rpbS) {
  const float NEG = -__builtin_inff();
  if (kr < rs || kr >= rs + 8) {
#pragma unroll
    for (int r = 0; r < 16; ++r) { p0[r] = NEG; p1[r] = NEG; }
  } else {
    const float* brow = rpbS + (kr - qr_ + 7) * 31 + (15 - qc);
#pragma unroll
    for (int g = 0; g < 4; ++g) {
#pragma unroll
      for (int q = 0; q < 4; ++q) { const int r = 4 * g + q;
        const int k0 = crow(r, hi), k1 = 32 + k0;
        const bool v0 = (unsigned)(k0 - cs) < 16u, v1 = (unsigned)(k1 - cs) < 16u;
        const float b0 = brow[v0 ? k0 : qc], b1 = brow[v1 ? k1 : qc];
        p0[r] = (p0[r] + b0) + (v0 ? 0.f : NEG); p1[r] = (p1[r] + b1) + (v1 ? 0.f : NEG);
      }
      SBAR();
    }
  }
}

template <int MODE>
__device__ __forceinline__ void attn_core(const bf16* __restrict__ Qw, const bf16* __restrict__ Kh, const bf16* __restrict__ Vh, const int NT, char* lds, const int kcb,
                                          const int, const int, const int, const int, const int, f32x16 (&o)[4], float& l_reg) {
  constexpr int ND0 = Cfg<MODE>::ND0;
  int tid_ = threadIdx.x; asm volatile("" : "+v"(tid_));
  const int tid = tid_, wid = __builtin_amdgcn_readfirstlane(tid >> 6), lane = tid & 63, r32 = lane & 31, hi = lane >> 5, half = wid >> 2, ht = tid & 255;
  bf16* V_lds = (bf16*)lds; bf16* K_lds = (bf16*)(lds + 2 * SHM_V);
  float* ws = (float*)(lds + OFF_WS) + wid * 64; float* al_l = ws + 32;
  float m_reg = 0.f; l_reg = 0.f; f32x16 negm = f32x16{};
#pragma unroll
  for (int d = 0; d < 4; ++d) o[d] = f32x16{};
  bf16x8 qr[ND0];
#pragma unroll
  for (int d0 = 0; d0 < ND0; ++d0) qr[d0] = ld8(Qw + d0 * 16);
  const int vb0 = (int)(uintptr_t)V_lds + v_rd_base(lane);
  {
    const int sr = tid >> 4, sc = (tid & 15) * 8;
    const bf16x8 v0 = ld8(&Vh[(long)sr * LDP + sc]), v1 = ld8(&Vh[(long)(32 + sr) * LDP + sc]), k0 = ld8(&Kh[(long)sr * LDP + sc]), k1 = ld8(&Kh[(long)(32 + sr) * LDP + sc]);
    *(bf16x8*)((char*)V_lds + v_st(sr, sc)) = v0; *(bf16x8*)((char*)V_lds + v_st(32 + sr, sc)) = v1;
    *(bf16x8*)((char*)K_lds + KSWZ(sr, sc * 2)) = k0; *(bf16x8*)((char*)K_lds + KSWZ(32 + sr, sc * 2)) = k1; }
  const int hr = ht >> 4, hc = (ht & 15) * 8;
  const bf16* Sg = (half == 0 ? Kh : Vh) + (long)hr * LDP + hc;
  char* Sl = half == 0 ? (char*)K_lds : (char*)V_lds;
  int soff[4];
#pragma unroll
  for (int i = 0; i < 4; ++i) soff[i] = half == 0 ? KSWZ(hr + 16 * i, hc * 2) : v_st(hr + 16 * i, hc);
  bf16x8 st[4], su[4];
#define HLOAD(R, t) do { _Pragma("unroll") for (int i = 0; i < 4; ++i) R[i] = ld8(Sg + (long)((t) * 64 + 16 * i) * LDP); } while (0)
#define HWRITE(R, b) do { _Pragma("unroll") for (int i = 0; i < 4; ++i) *(bf16x8*)(Sl + (b) * SHM_V + soff[i]) = R[i]; } while (0)
#define BAR_P() do { asm volatile("" : "+v"(p0), "+v"(p1)); SBAR(); asm volatile("s_waitcnt lgkmcnt(0)\n\ts_barrier" ::: "memory"); SBAR(); } while (0)
#define BAR_A() do { asm volatile("" : "+v"(pa0), "+v"(pa1), "+v"(pa2), "+v"(pa3)); SBAR(); asm volatile("s_waitcnt lgkmcnt(0)\n\ts_barrier" ::: "memory"); SBAR(); } while (0)
  f32x16 p0 = f32x16{}, p1 = f32x16{}; bf16x8 pa0, pa1, pa2, pa3; float alpha;
#define MSEG(VB, KS) do { VFrag fa_, fb_; bf16x8 kb0_[ND0], kb1_[ND0]; \
    pv_rd<0>(fa_, VB); pv_rd<1>(fb_, VB); pv_mm<8>(o[0], fa_, pa0, pa1, pa2, pa3); \
    pv_rd<2>(fa_, VB); pv_mm<8>(o[1], fb_, pa0, pa1, pa2, pa3); \
    pv_rd<3>(fb_, VB); pv_mm<8>(o[2], fa_, pa0, pa1, pa2, pa3); \
    qk_rd<ND0>(kb0_, kb1_, KS, r32, hi, kcb); pv_mm<8>(o[3], fb_, pa0, pa1, pa2, pa3); \
    qk_mm<ND0>(p0, p1, kb0_, kb1_, qr, negm); } while (0)
#define VSEG(FIRST) do { alpha = 1.f; const float pmax_ = rowmax32(p0, p1); \
    if (FIRST) { m_reg = pmax_; _Pragma("unroll") for (int r = 0; r < 16; ++r) { negm[r] = -pmax_; p0[r] -= pmax_; p1[r] -= pmax_; } } \
    else if (!__builtin_expect(__all(pmax_ <= THRL), 1)) { const float dlt_ = fmaxf(pmax_, 0.f); alpha = __builtin_amdgcn_exp2f(-dlt_); m_reg += dlt_; \
      _Pragma("unroll") for (int r = 0; r < 16; ++r) { negm[r] -= dlt_; p0[r] -= dlt_; p1[r] -= dlt_; } \
      if (hi == 0) al_l[r32] = alpha; asm volatile("s_waitcnt lgkmcnt(0)" ::: "memory"); \
      _Pragma("unroll") for (int d = 0; d < 4; ++d) _Pragma("unroll") for (int r = 0; r < 16; ++r) o[d][r] *= al_l[crow(r, hi)]; } \
    sm_exp0(p0); finishSM(p0, p1, alpha, l_reg, pa0, pa1, pa2, pa3); } while (0)
  __syncthreads();
  HLOAD(st, 1); HLOAD(su, 2);
  if (half == 1) BAR_P();
  qkt<ND0>(p0, p1, K_lds, qr, r32, hi, kcb);
  BAR_P();
  VSEG(true); HWRITE(st, 1); BAR_A();
  MSEG(vb0, (bf16*)((char*)K_lds + SHM_K)); if (3 < NT) HLOAD(st, 3); BAR_P();
#pragma unroll 1
  for (int j = 1; j + 1 < NT; j += 2) {
    VSEG(false); HWRITE(su, 0); BAR_A();
    MSEG(vb0 + SHM_V, K_lds); if (j + 3 < NT) HLOAD(su, j + 3); BAR_P();
    VSEG(false); HWRITE(st, 1); BAR_A();
    MSEG(vb0, (bf16*)((char*)K_lds + SHM_K)); if (j + 4 < NT) HLOAD(st, j + 4); BAR_P();
  }
  VSEG(false); BAR_A();
  pv_d0(o, vb0 + SHM_V, pa0, pa1, pa2, pa3); BAR_P();
  if (half == 0) BAR_P();
#undef VSEG
#undef MSEG
#undef HLOAD
#undef HWRITE
#undef BAR_P
#undef BAR_A
}
__device__ __forceinline__ float half_sum32(float v) {
#pragma unroll
  for (int o = 1; o < 32; o <<= 1) v += __shfl_xor(v, o);
  return v;
}
__device__ __forceinline__ void diff_unit(const bf16* __restrict__ proj, bf16* __restrict__ mix, int h, int q0, float lam, float oml, const float* __restrict__ subg, char* lds) {
  int tid_ = threadIdx.x; asm volatile("" : "+v"(tid_));
  const int tid = tid_, wid = tid >> 6, lane = tid & 63, r32 = lane & 31, hi = lane >> 5, map = wid >> 2, wq = wid & 3;
  const bf16* Qw = proj + (size_t)(q0 + wq * 32 + r32) * LDP + h * 128 + map * 64 + hi * 8;
  f32x16 o[4]; float l_reg;
  attn_core<0>(Qw, proj + 1024 + h * 128, proj + 2048 + h * 128, 8192 / 64, lds, map * 128, 0, 0, 0, 0, 0, o, l_reg);
  float* ws = (float*)(lds + OFF_WS) + wid * 64;
  if (hi == 0) ws[r32] = l_reg;
  asm volatile("s_waitcnt lgkmcnt(0)" ::: "memory");
  float rli[16];
#pragma unroll
  for (int r = 0; r < 16; ++r) rli[r] = __builtin_amdgcn_rcpf(ws[crow(r, hi)]);
  __syncthreads();
  float* X = (float*)lds + (wq * 64) * 64 + lane;
  if (map == 1) {
#pragma unroll
    for (int d = 0; d < 4; ++d)
#pragma unroll
      for (int r = 0; r < 16; ++r) X[(d * 16 + r) * 64] = o[d][r] * rli[r];
  }
  __syncthreads();
  if (map == 0) {
    float gv[4];
#pragma unroll
    for (int d = 0; d < 4; ++d) gv[d] = subg[32 * d + r32] * oml;
    bf16* Ow = mix + (size_t)(q0 + wq * 32) * 2048 + 1024 + h * 128 + r32;
#pragma unroll
    for (int r = 0; r < 16; ++r) {
      float dv[4]; float sq = 0.f;
#pragma unroll
      for (int d = 0; d < 4; ++d) { dv[d] = o[d][r] * rli[r] - lam * X[(d * 16 + r) * 64]; sq += dv[d] * dv[d]; }
      sq = half_sum32(sq);
      const float rn = rsqrtf(sq * (1.0f / 128.0f) + 1e-6f);
      bf16* orow = Ow + (size_t)crow(r, hi) * 2048;
#pragma unroll
      for (int d = 0; d < 4; ++d) orow[32 * d] = (bf16)(cvtpk(dv[d] * rn * gv[d], 0.f) & 0xffffu);
    }
  }
  __syncthreads();
}
__device__ __forceinline__ void attn_na_core(const bf16* __restrict__ Qw, const bf16* __restrict__ Kh, const bf16* __restrict__ Vh, const int NT, char* lds,
                                             const int na_qr, const int na_rs, const int na_qc, const int na_cs, const int na_k0, f32x16 (&o)[4], float& l_reg) {
  int tid_ = threadIdx.x; asm volatile("" : "+v"(tid_));
  const int tid = tid_, wid = tid >> 6, lane = tid & 63, r32 = lane & 31, hi = lane >> 5;
  bf16* V_lds = (bf16*)lds; bf16* K_lds = (bf16*)(lds + 2 * SHM_V);
  float* ws = (float*)(lds + OFF_WS) + wid * 64; float* al_l = ws + 32;
  const float* rpbS = (const float*)(lds + OFF_RPB);
  float m_reg = -1e30f; l_reg = 0.f;
#pragma unroll
  for (int d = 0; d < 4; ++d) o[d] = f32x16{};
  bf16x8 qr[8];
#pragma unroll
  for (int d0 = 0; d0 < 8; ++d0) qr[d0] = ld8(Qw + d0 * 16);
  const int sr = tid >> 4, sc = (tid & 15) * 8, vst0 = v_st(sr, sc), vst1 = v_st(32 + sr, sc);
  const int vb0 = (int)(uintptr_t)V_lds + v_rd_base(lane);
  bf16x8 vs0, vs1, ks0, ks1;
#define SLOAD(k0) do { vs0 = ld8(&Vh[(long)((k0) + sr) * LDP + sc]); vs1 = ld8(&Vh[(long)((k0) + 32 + sr) * LDP + sc]); \
    ks0 = ld8(&Kh[(long)((k0) + sr) * LDP + sc]); ks1 = ld8(&Kh[(long)((k0) + 32 + sr) * LDP + sc]); } while (0)
  SLOAD(0);
#pragma unroll 1
  for (int j = 0; j < NT; ++j) {
    __syncthreads();
    *(bf16x8*)((char*)V_lds + vst0) = vs0; *(bf16x8*)((char*)V_lds + vst1) = vs1;
    *(bf16x8*)((char*)K_lds + KSWZ(sr, sc * 2)) = ks0; *(bf16x8*)((char*)K_lds + KSWZ(32 + sr, sc * 2)) = ks1;
    if (j + 1 < NT) SLOAD((j + 1) * 64);
    __syncthreads();
    const int kr = na_k0 + j;
    if (kr >= na_rs && kr < na_rs + 8) {
      f32x16 p0, p1; float mn, al; bf16x8 pa0, pa1, pa2, pa3;
      qkt<8>(p0, p1, K_lds, qr, r32, hi, 0);
      na_fix(p0, p1, kr, na_qr, na_rs, na_qc, na_cs, hi, rpbS);
      partialSM<1>(p0, p1, m_reg, mn, al);
      if (__any(al < 1.f)) { if (hi == 0) al_l[r32] = al; asm volatile("s_waitcnt lgkmcnt(0)" ::: "memory");
#pragma unroll
        for (int d = 0; d < 4; ++d)
#pragma unroll
          for (int r = 0; r < 16; ++r) o[d][r] *= al_l[crow(r, hi)]; }
      finishSM(p0, p1, al, l_reg, pa0, pa1, pa2, pa3); SBAR();
      pv_d0(o, vb0, pa0, pa1, pa2, pa3);
    }
  }
#undef SLOAD
}
__device__ __forceinline__ void na_unit(const bf16* __restrict__ proj, bf16* __restrict__ mix, float* __restrict__ nass, int h, int rb, const float* __restrict__ rpb_h, char* lds) {
  int tid_ = threadIdx.x; asm volatile("" : "+v"(tid_));
  const int tid = tid_, wid = tid >> 6, lane = tid & 63, r32 = lane & 31, hi = lane >> 5;
  float* rpbS = (float*)(lds + OFF_RPB);
  if (tid < 15 * 31) rpbS[tid] = rpb_h[tid] * 11.313708498984761f;
  const int q0 = rb * 256; int k0row = rb * 4 - 4; k0row = k0row < 0 ? 0 : (k0row > 116 ? 116 : k0row);
  const int qr_ = rb * 4 + (wid >> 1), qc = (wid & 1) * 32 + r32;
  int rs = qr_ - 4; rs = rs < 0 ? 0 : (rs > 120 ? 120 : rs);
  int cs = qc - 8; cs = cs < 0 ? 0 : (cs > 48 ? 48 : cs);
  const bf16* Qw = proj + (size_t)(q0 + wid * 32 + r32) * LDP + 3072 + h * 128 + hi * 8;
  const bf16* Kh = proj + (size_t)k0row * 64 * LDP + 4096 + h * 128;
  const bf16* Vh = proj + (size_t)k0row * 64 * LDP + 5120 + h * 128;
  f32x16 o[4]; float l_reg;
  attn_na_core(Qw, Kh, Vh, 12, lds, qr_, rs, qc, cs, k0row, o, l_reg);
  int t2 = threadIdx.x; asm volatile("" : "+v"(t2));
  const int wid2 = t2 >> 6, r32b = t2 & 31, hib = (t2 >> 5) & 1;
  float* ws = (float*)(lds + OFF_WS) + wid2 * 64;
  if (hib == 0) ws[r32b] = l_reg;
  asm volatile("s_waitcnt lgkmcnt(0)" ::: "memory");
  bf16* Ow = mix + (size_t)(rb * 256 + wid2 * 32) * 2048 + h * 128 + r32b;
  float* nrow = nass + (size_t)(rb * 256 + wid2 * 32) * 8 + h;
#pragma unroll
  for (int r = 0; r < 16; ++r) {
    const float rl = __builtin_amdgcn_rcpf(ws[crow(r, hib)]);
    bf16* orow = Ow + (size_t)crow(r, hib) * 2048; float sq = 0.f;
#pragma unroll
    for (int d = 0; d < 4; ++d) { const float v = o[d][r] * rl; sq += v * v; orow[32 * d] = (bf16)(cvtpk(v, 0.f) & 0xffffu); }
    sq = half_sum32(sq);
    if (r32b == 0) nrow[(size_t)crow(r, hib) * 8] = sq;
  }
  __syncthreads();
}
#undef KSWZ
#undef SBAR
}
#define LAS __attribute__((address_space(3)))
typedef unsigned short bf16_t;
typedef unsigned v4u __attribute__((ext_vector_type(4)));
typedef unsigned v2u __attribute__((ext_vector_type(2)));
typedef float v4f __attribute__((ext_vector_type(4)));
#define XB_TMO      128
#define XB_XCNT(j)  (256  + 64 * (j))
#define XB_XSUB(j)  (1280 + 64 * (j))
#define XB_XGEN(j)  (2304 + 64 * (j))
#define XB_TOP      3328
#define XB_TOPGEN   3392
#define XCD_BAR_WORDS 3456
#define XB_SPIN_CAP (1u << 18)

__device__ __forceinline__ unsigned xb_ld(unsigned* p)              { return __hip_atomic_load(p, __ATOMIC_RELAXED, __HIP_MEMORY_SCOPE_AGENT); }
__device__ __forceinline__ unsigned xb_add(unsigned* p, unsigned v) { return __hip_atomic_fetch_add(p, v, __ATOMIC_RELAXED, __HIP_MEMORY_SCOPE_AGENT); }
__device__ __forceinline__ unsigned xb_xcc_id() { return (unsigned)__builtin_amdgcn_s_getreg((3 << 11) | 20) & 0xFu; }
#define XB_SPIN(cond, bar) do { unsigned _sp = 0; while (cond) { __builtin_amdgcn_s_sleep(1); \
    if ((++_sp & 255u) == 0u) { if (xb_ld(&(bar)[XB_TMO])) break; if (_sp > XB_SPIN_CAP) { atomicAdd(&(bar)[XB_TMO], 1u); break; } } } } while (0)

struct XcdBarrier {
    unsigned* bar; unsigned x;
    volatile LAS unsigned* st;
};

__device__ __forceinline__ XcdBarrier xcd_barrier_post(unsigned* bar, volatile LAS unsigned* st) {
    XcdBarrier b; b.bar = bar; b.x = xb_xcc_id(); b.st = st;
    if (threadIdx.x == 0) (void)xb_add(&bar[XB_XCNT(b.x)], 1u);
    return b;
}
__device__ __forceinline__ void xcd_barrier_complete(unsigned* bar, unsigned x, unsigned& nloc, unsigned& nx) {
    const unsigned G = gridDim.x * gridDim.y * gridDim.z;
    unsigned sum, cnt, mine, sp = 0u;
    for (;;) {
        sum = 0u; cnt = 0u; mine = 0u;
#pragma unroll
        for (unsigned j = 0; j < 16; ++j) { const unsigned c = xb_ld(&bar[XB_XCNT(j)]); sum += c; cnt += (c > 0u) ? 1u : 0u; mine = (j == x) ? c : mine; }
        if (sum == G) break;
        __builtin_amdgcn_s_sleep(1);
        if ((++sp & 255u) == 0u) { if (xb_ld(&bar[XB_TMO])) break; if (sp > XB_SPIN_CAP) { atomicAdd(&bar[XB_TMO], 1u); break; } }
    }
    nloc = mine > 0u ? mine : 1u; nx = cnt > 0u ? cnt : 1u;
}

__device__ __forceinline__ void xcd_barrier(const XcdBarrier& b) {
    asm volatile("s_waitcnt vmcnt(0)" ::: "memory");
    __syncthreads();
    if (threadIdx.x == 0) {
        unsigned* bar = b.bar;
        __builtin_amdgcn_s_waitcnt(0);
        unsigned nloc = b.st[0], nx = b.st[1];
        if (nloc == 0u) { xcd_barrier_complete(bar, b.x, nloc, nx); b.st[0] = nloc; b.st[1] = nx; }
        const unsigned old = xb_add(&bar[XB_XSUB(b.x)], 1u);
        const unsigned gen = old / nloc;
        if (old + 1u == (gen + 1u) * nloc) {
            __builtin_amdgcn_fence(__ATOMIC_RELEASE, "agent");
            asm volatile("s_waitcnt vmcnt(0)" ::: "memory");
            const unsigned og = xb_add(&bar[XB_TOP], 1u);
            const unsigned tg = og / nx;
            if (og + 1u == (tg + 1u) * nx) xb_add(&bar[XB_TOPGEN], 1u);
            else XB_SPIN(xb_ld(&bar[XB_TOPGEN]) == tg, bar);
            __builtin_amdgcn_fence(__ATOMIC_ACQUIRE, "agent");
            xb_add(&bar[XB_XGEN(b.x)], 1u);
            asm volatile("s_waitcnt vmcnt(0)" ::: "memory");
        } else {
            XB_SPIN(xb_ld(&bar[XB_XGEN(b.x)]) == gen, bar);
            __builtin_amdgcn_fence(__ATOMIC_ACQUIRE, "agent");
            asm volatile("s_waitcnt vmcnt(0)" ::: "memory");
        }
    }
    __syncthreads();
}

constexpr int SEQ = 8192, DM = 2048, INC = 6144, FF = 8192, DEPTH = 4, NTHR = 512;
constexpr size_t SZ_WIN = (size_t)INC * DM * 2, SZ_WOUT = (size_t)DM * DM * 2, SZ_WMI = (size_t)FF * DM * 2, SZ_WMO = (size_t)DM * FF * 2;
constexpr size_t WS_WIN = 0, WS_WOUT = WS_WIN + DEPTH * SZ_WIN, WS_WMI = WS_WOUT + DEPTH * SZ_WOUT, WS_WMO = WS_WMI + DEPTH * SZ_WMI;
constexpr size_t WS_X = WS_WMO + DEPTH * SZ_WMO, WS_XB = WS_X + (size_t)SEQ * DM * 4, WS_PROJ = WS_XB + (size_t)SEQ * DM * 2, WS_MIX = WS_PROJ + (size_t)SEQ * INC * 2;
constexpr size_t WS_U = WS_MIX + (size_t)SEQ * DM * 2, WS_SS = WS_U + (size_t)SEQ * FF * 2, WS_COS = WS_SS + 9 * (size_t)SEQ * 32 * 4, WS_SIN = WS_COS + (size_t)SEQ * 32 * 4;
constexpr size_t WS_LAM = WS_SIN + (size_t)SEQ * 32 * 4, WS_BAR = WS_LAM + 256, WS_NASS = WS_BAR + 16384, WS_END = WS_NASS + (size_t)SEQ * 8 * 4;
#ifndef REP_P0
#define REP_P0 1
#endif
#ifndef REP_P1
#define REP_P1 1
#endif
#ifndef REP_P2
#define REP_P2 1
#endif
#ifndef REP_P3
#define REP_P3 1
#endif
#ifndef REP_P4
#define REP_P4 1
#endif
#ifndef REP_P6
#define REP_P6 1
#endif
#ifndef REP_P5
#define REP_P5 1
#endif
constexpr int LDS_BYTES = 139264;
static_assert(att::ATT_LDS <= LDS_BYTES && pg8::STAGE_BYTES <= LDS_BYTES, "LDS map");

struct Args {
    const float* in[15]; float* out; unsigned char* ws;
    double invf[32];
    float lam_init[4]; int pad[2];
};

__device__ __forceinline__ float wave_sum(float v) {
#pragma unroll
    for (int o = 1; o < 64; o <<= 1) v += __shfl_xor(v, o);
    return v;
}
__device__ __forceinline__ unsigned pk2(float lo, float hi) { return pg8::cvt_pk_bf16(lo, hi); }

struct TpItem { const float* W; bf16_t* WT; const float* gv; int K, N, k0, n0, krot; bool perm; };
__device__ __forceinline__ void tp_load(const TpItem& d, int lane, float (&w)[32]) {
    const float* wp = d.W + (size_t)(d.k0 + (lane >> 5)) * d.N + d.n0 + (lane & 31);
#pragma unroll
    for (int i = 0; i < 32; ++i) w[i] = wp[(size_t)(2 * i) * d.N];
}
__device__ __forceinline__ void tp_store(const TpItem& d, int lane, const float (&w)[32], LAS float* scr) {
    const int c = lane & 7;
    v4f g0 = {1.f, 1.f, 1.f, 1.f}, g1 = {1.f, 1.f, 1.f, 1.f};
    if (d.gv) { g0 = *(const v4f*)(d.gv + d.k0 + 8 * c); g1 = *(const v4f*)(d.gv + d.k0 + 8 * c + 4); }
#pragma unroll
    for (int i = 0; i < 32; ++i) scr[(2 * i + (lane >> 5)) * 33 + (lane & 31)] = w[i];
    asm volatile("s_waitcnt lgkmcnt(0)" ::: "memory");
#pragma unroll
    for (int j = 0; j < 4; ++j) { const int n = (lane >> 3) + 8 * j; const LAS float* s = scr + (8 * c) * 33 + n;
        v4u o; o.x = pk2(s[0 * 33] * g0.x, s[1 * 33] * g0.y); o.y = pk2(s[2 * 33] * g0.z, s[3 * 33] * g0.w); o.z = pk2(s[4 * 33] * g1.x, s[5 * 33] * g1.y); o.w = pk2(s[6 * 33] * g1.z, s[7 * 33] * g1.w);
        const int no = d.n0 + n; int dst = no;
        if (d.perm && no < 2048) { const int q = no & 63; dst = (no & ~63) + 8 * ((q & 31) >> 2) + 4 * (q >> 5) + (q & 3); }
        *(v4u*)(d.WT + (size_t)dst * d.K + ((d.k0 + d.krot) & (d.K - 1)) + 8 * c) = o; }
    asm volatile("s_waitcnt lgkmcnt(0)" ::: "memory");
}

__global__ void __launch_bounds__(NTHR, 2) fwd_megakernel(Args a) {
    extern __shared__ __attribute__((aligned(16))) unsigned char lds[];
    cg::grid_group grid = cg::this_grid();
#define GRID_SYNC() do { asm volatile("s_waitcnt vmcnt(0) lgkmcnt(0)" ::: "memory"); grid.sync(); __builtin_amdgcn_fence(__ATOMIC_ACQUIRE, "agent"); asm volatile("s_waitcnt vmcnt(0)" ::: "memory"); } while (0)
    const int tid = threadIdx.x, lane = tid & 63, wave = __builtin_amdgcn_readfirstlane(tid >> 6);
    const int G = gridDim.x, bx = blockIdx.x;
    const int gw = bx * 8 + wave, NGW = G * 8;
    unsigned char* ws = a.ws;
    bf16_t* WinT = (bf16_t*)(ws + WS_WIN); bf16_t* WoutT = (bf16_t*)(ws + WS_WOUT); bf16_t* WmiT = (bf16_t*)(ws + WS_WMI); bf16_t* WmoT = (bf16_t*)(ws + WS_WMO);
    float* X = (float*)(ws + WS_X); bf16_t* XB = (bf16_t*)(ws + WS_XB); bf16_t* PROJ = (bf16_t*)(ws + WS_PROJ); bf16_t* MIX = (bf16_t*)(ws + WS_MIX); bf16_t* U = (bf16_t*)(ws + WS_U);
    float* SS = (float*)(ws + WS_SS); float* COS = (float*)(ws + WS_COS); float* SIN = (float*)(ws + WS_SIN); float* LAM = (float*)(ws + WS_LAM); float* NASS = (float*)(ws + WS_NASS);
    LAS unsigned char* ldsl = (LAS unsigned char*)lds;
    volatile LAS unsigned* bst = (volatile LAS unsigned*)(ldsl + 135168);
    if (tid < 2) bst[tid] = 0u;
    __syncthreads();
    const XcdBarrier xbar = xcd_barrier_post((unsigned*)(ws + WS_BAR), bst);

    for (int rep = 0; rep < REP_P0; ++rep) {
        LAS float* scr = (LAS float*)(ldsl + wave * 16384);
        constexpr int I_IN = (DM / 64) * (INC / 32), I_OUT = (DM / 64) * (DM / 32), I_MI = (DM / 64) * (FF / 32), I_MO = (FF / 64) * (DM / 32), I_L = I_IN + I_OUT + I_MI + I_MO;
        auto mk = [&](int it) {
            TpItem d; const int l = it / I_L; int r = it % I_L; d.gv = nullptr; d.perm = false; d.krot = 0;
            if (r < I_IN) { d.W = a.in[2] + (size_t)l * DM * INC; d.K = DM; d.N = INC; d.WT = WinT + (size_t)l * INC * DM; d.gv = a.in[1] + l * DM; d.perm = true; }
            else if ((r -= I_IN) < I_OUT) {
                d.W = a.in[10] + (size_t)l * DM * DM; d.K = DM; d.N = DM; d.WT = WoutT + (size_t)l * DM * DM; d.krot = 1024; if (r / (DM / 32) >= 16) d.gv = a.in[8] + l * 1024 - 1024; }
            else if ((r -= I_OUT) < I_MI) { d.W = a.in[12] + (size_t)l * DM * FF; d.K = DM; d.N = FF; d.WT = WmiT + (size_t)l * FF * DM; d.gv = a.in[11] + l * DM; }
            else { r -= I_MI; d.W = a.in[13] + (size_t)l * FF * DM; d.K = FF; d.N = DM; d.WT = WmoT + (size_t)l * DM * FF; }
            const int nblk = d.N / 32; d.k0 = 64 * (r / nblk); d.n0 = 32 * (r % nblk);
            return d; };
        {
            constexpr int NIT = DEPTH * I_L; float wa[32], wb[32]; int it = gw;
            TpItem da = mk(it < NIT ? it : 0), db = da;
            if (it < NIT) tp_load(da, lane, wa);
            while (it < NIT) {
                const int itb = it + NGW; if (itb < NIT) { db = mk(itb); tp_load(db, lane, wb); }
                tp_store(da, lane, wa, scr);
                if (itb >= NIT) break;
                const int ita = itb + NGW; if (ita < NIT) { da = mk(ita); tp_load(da, lane, wa); }
                tp_store(db, lane, wb, scr);
                it = ita;
            }
        }
        for (int m = gw; m < SEQ; m += NGW) {
            const v4f* xr = (const v4f*)(a.in[0] + (size_t)m * DM) + lane; v2u* bo = (v2u*)(XB + (size_t)m * DM) + lane;
            float s = 0.f;
#pragma unroll
            for (int j = 0; j < 8; ++j) { const v4f v = xr[64 * j]; v2u w; w.x = pk2(v.x, v.y); w.y = pk2(v.z, v.w); bo[64 * j] = w; s += (v.x * v.x + v.y * v.y) + (v.z * v.z + v.w * v.w); }
            s = wave_sum(s);
            if (lane < 32) SS[(size_t)m * 32 + lane] = lane == 0 ? s : 0.f;
        }
        for (int i = bx * NTHR + tid; i < SEQ * 32; i += G * NTHR) {
            const int t = i >> 5, j = i & 31; double rev = (double)t * a.invf[j] * 0.15915494309189535; rev -= floor(rev);
            const float rf = (float)rev; COS[i] = __builtin_amdgcn_cosf(rf); SIN[i] = __builtin_amdgcn_sinf(rf);
        }
        if (bx == 0 && wave < DEPTH) {
            const int l = wave;
            const float p1 = wave_sum(a.in[3][l * 64 + lane] * a.in[4][l * 64 + lane]), p2 = wave_sum(a.in[5][l * 64 + lane] * a.in[6][l * 64 + lane]);
            if (lane == 0) LAM[l] = expf(p1) - expf(p2) + a.lam_init[l];
        }
    }
    GRID_SYNC();

#pragma unroll 1
    for (int l = 0; l < DEPTH; ++l) {
        const float* ss1 = SS + (size_t)(2 * l) * SEQ * 32; float* ss2 = SS + (size_t)(2 * l + 1) * SEQ * 32; float* ss3 = SS + (size_t)(2 * l + 2) * SEQ * 32;
        for (int rep = 0; rep < REP_P1; ++rep) {
            pg8::Gemm g{XB, WinT + (size_t)l * INC * DM, SEQ, INC, DM}; pg8::StaticOrder S; S.init(SEQ, INC, G, bx);
            pg8::EpiProj E{PROJ, ss1, COS, SIN};
            pg8::gemm_phase<pg8::EpiProj, pg8::StaticOrder, true, true>(ldsl, g, S, E);
        }
        xcd_barrier(xbar);
        {
            for (int rep = 0; rep < REP_P2; ++rep)
            for (int u = bx; u < 8 * 32; u += G) { const int h = u >> 5, rb = u & 31;
                att::na_unit(PROJ, MIX, NASS, h, rb, a.in[9] + ((size_t)l * 8 + h) * 15 * 31, (char*)lds); }
            const float lam = LAM[l], oml = 1.0f - a.lam_init[l];
            for (int rep = 0; rep < REP_P3; ++rep)
            for (int u = bx; u < 8 * 64; u += G) { const int h = u & 7, qb = u >> 3;
                att::diff_unit(PROJ, MIX, h, qb * 128, lam, oml, a.in[7] + l * 128, (char*)lds); }
        }
        xcd_barrier(xbar);
        for (int rep = 0; rep < REP_P4; ++rep) {
            pg8::Gemm g{MIX, WoutT + (size_t)l * DM * DM, SEQ, DM, DM}; pg8::StaticOrder S; S.init(SEQ, DM, G, bx);
            pg8::EpiResidMid E{(l == 0 && rep == 0) ? a.in[0] : (const float*)X, X, XB, ss2, (rep & 1) ? -1.f : 1.f, NASS};
            pg8::gemm_phase<pg8::EpiResidMid, pg8::StaticOrder, true, true>(ldsl, g, S, E);
        }
        xcd_barrier(xbar);
        for (int rep = 0; rep < REP_P5; ++rep) {
            pg8::Gemm g{XB, WmiT + (size_t)l * FF * DM, SEQ, FF, DM}; pg8::StaticOrder S; S.init(SEQ, FF, G, bx);
            pg8::EpiRelu2 E{U, ss2};
            pg8::gemm_phase<pg8::EpiRelu2, pg8::StaticOrder, true, true>(ldsl, g, S, E);
        }
        xcd_barrier(xbar);
        for (int rep = 0; rep < REP_P6; ++rep) {
            pg8::Gemm g{U, WmoT + (size_t)l * DM * FF, SEQ, DM, FF}; pg8::StaticOrder S; S.init(SEQ, DM, G, bx);
            pg8::EpiResid E{X, X, XB, ss3, (rep & 1) ? -1.f : 1.f, nullptr};
            pg8::gemm_phase<pg8::EpiResid, pg8::StaticOrder, true, true>(ldsl, g, S, E);
        }
        xcd_barrier(xbar);
    }
    {
        const float* fg = a.in[14]; const float* ssf = SS + (size_t)8 * SEQ * 32;
        int lnf = threadIdx.x; asm volatile("" : "+v"(lnf)); lnf &= 63;
        for (int m = gw; m < SEQ; m += NGW) {
            const float rn = rsqrtf(wave_sum(lnf < 32 ? ssf[(size_t)m * 32 + lnf] : 0.f) * (1.0f / 2048.0f) + 1e-6f);
            const v4f* xr = (const v4f*)(X + (size_t)m * DM) + lnf; v4f* xo = (v4f*)(a.out + (size_t)m * DM) + lnf; const v4f* gp = (const v4f*)fg + lnf;
#pragma unroll
            for (int j = 0; j < 8; ++j) xo[64 * j] = xr[64 * j] * rn * gp[64 * j];
        }
    }
}

extern "C" void kernel_launch(void* const* d_in, const int* in_sizes, int n_in, void* d_out, int out_size, void* d_ws, size_t ws_size, hipStream_t stream) {
    static int grid_blocks = 0;
    if (grid_blocks == 0) {
        if (n_in != 15 || out_size != SEQ * DM || ws_size < WS_END) { fprintf(stderr, "kernel_launch: unexpected shapes (n_in %d out %d ws %zu, need %zu)\n", n_in, out_size, ws_size, (size_t)WS_END); grid_blocks = -1; return; }
        int dev = 0, cus = 0, per_cu = 0;
        hipGetDevice(&dev); hipDeviceGetAttribute(&cus, hipDeviceAttributeMultiprocessorCount, dev);
        if (hipFuncSetAttribute((const void*)fwd_megakernel, hipFuncAttributeMaxDynamicSharedMemorySize, LDS_BYTES) != hipSuccess) { fprintf(stderr, "kernel_launch: hipFuncSetAttribute failed\n"); grid_blocks = -1; return; }
        if (hipOccupancyMaxActiveBlocksPerMultiprocessor(&per_cu, (const void*)fwd_megakernel, NTHR, LDS_BYTES) != hipSuccess || per_cu < 1) { fprintf(stderr, "kernel_launch: occupancy query gave %d\n", per_cu); per_cu = 1; (void)hipGetLastError(); }
        grid_blocks = cus * per_cu;
    }
    if (grid_blocks < 0) return;
    Args a{};
    for (int i = 0; i < 15; ++i) a.in[i] = (const float*)d_in[i];
    a.out = (float*)d_out; a.ws = (unsigned char*)d_ws;
    for (int j = 0; j < 32; ++j) a.invf[j] = 1.0 / pow(10000.0, (double)(2 * j) / 64.0);
    for (int l = 0; l < 4; ++l) a.lam_init[l] = (float)(0.8 - 0.6 * exp(-0.3 * l));
    if (hipMemsetAsync((char*)d_ws + WS_BAR, 0, XCD_BAR_WORDS * 4, stream) != hipSuccess) { fprintf(stderr, "kernel_launch: hipMemsetAsync of the barrier words failed\n"); return; }
    void* args[] = {&a};
    hipError_t e = hipLaunchCooperativeKernel((void*)fwd_megakernel, dim3(grid_blocks), dim3(NTHR), args, LDS_BYTES, stream);
    if (e != hipSuccess) fprintf(stderr, "cooperative launch failed: %s (grid %d)\n", hipGetErrorString(e), grid_blocks);
}
```

```cpp
#include <hip/hip_runtime.h>
#include <hip/hip_cooperative_groups.h>
#include <cstdio>
#include <cstdint>
namespace cg = cooperative_groups;
namespace pg8 {
#define PG8_LAS __attribute__((address_space(3)))
typedef unsigned short bf16_t;
typedef short bf16x8 __attribute__((ext_vector_type(8)));
typedef float f32x4 __attribute__((ext_vector_type(4)));
typedef unsigned u32x4 __attribute__((ext_vector_type(4)));
constexpr int BM = 256, BK = 64, HALF = 128, HTB = HALF * BK * 2  , STAGE_BYTES = 8 * HTB, NXCD = 8, WGM = 4;

__host__ __device__ __forceinline__ int lds_byte(int r, int c) { const int st = (r >> 4) * 2 + (c >> 5), rr = r & 15, cc = c & 31, ob = rr * 64 + cc * 2; return st * 1024 + (ob ^ (((ob >> 9) & 1) << 5)); }
__host__ __device__ __forceinline__ void stage_rc(int b, int& R, int& C) { const int st = b / 1024, sb = b % 1024, swz = sb ^ (((sb >> 9) & 1) << 5); R = (st >> 1) * 16 + swz / 64; C = (st & 1) * 32 + (swz % 64) / 2; }
__host__ __device__ __forceinline__ int perm32(int rho) { const int n = rho >> 4, i = rho & 15; return 8 * (i >> 2) + 4 * n + (i & 3); }

struct Unit { int pm, pn; };
struct Gemm { const bf16_t* A; const bf16_t* Bt; int M, N, K; };

struct StaticOrder {
    int nM, nN, nwg, G, c;
    __host__ __device__ void init(int M, int N, int G_, int c_) { nM = M / BM; nN = N / BM; nwg = nM * nN; G = G_; c = c_; }
    __host__ __device__ bool next(int i, Unit& u) const {
        const long L = (long)i * G + c; if (L >= nwg) return false;
        int wgid = (int)L; { const int q = nwg / NXCD, r = nwg % NXCD, xcd = wgid % NXCD, off = wgid / NXCD; wgid = (xcd < r ? xcd * (q + 1) : r * (q + 1) + (xcd - r) * q) + off; }
        const int nig = WGM * nN, gid = wgid / nig, fm = gid * WGM, gsz = (nM - fm) < WGM ? (nM - fm) : WGM;
        u.pm = fm + ((wgid % nig) % gsz); u.pn = (wgid % nig) / gsz; return true;
    }
    __device__ __forceinline__ void a_ready(const Unit&) const {}
    __device__ __forceinline__ void done(const Unit&) const {}
};

__device__ __forceinline__ unsigned cvt_pk_bf16(float lo, float hi) { unsigned r; asm volatile("v_cvt_pk_bf16_f32 %0, %1, %2" : "=v"(r) : "v"(lo), "v"(hi)); return r; }
typedef float f32x2 __attribute__((ext_vector_type(2)));
typedef unsigned u32x2 __attribute__((ext_vector_type(2)));
constexpr float RMS_EPS = 1e-6f;
__device__ __forceinline__ float row_rstd(const float* ss, int row, int fq) {
    const f32x4* sp = (const f32x4*)(ss + (size_t)row * 32 + fq * 8); const f32x4 a = sp[0], b = sp[1];
    float s = ((a[0] + a[1]) + (a[2] + a[3])) + ((b[0] + b[1]) + (b[2] + b[3]));
    s += __shfl_xor(s, 16); s += __shfl_xor(s, 32);
    return rsqrtf(s * (1.0f / 2048.0f) + RMS_EPS);
}
struct EpiProj {
    static constexpr bool PERM = true, AFTER_DRAIN = false, MIDK = false;
    bf16_t* O; const float* ss; const float* cosT; const float* sinT;
    __device__ __forceinline__ void operator()(const f32x4 (&acc)[2][2][4][2], const Unit& u, int wr, int wc, int fr, int fq) const {
        const int row0 = u.pm * BM + wr * 64 + fr; const int colt = u.pn * BM;
        const bool rope = colt < 2048;
        const float qs = colt < 1024 ? 0.125f * 1.4426950408889634f : 1.f;
        const int g = (wc & 1) * 4 + fq;
        const int pos0 = colt + wc * 32 + 8 * fq;
        const int rbase = colt + 64 * (wc >> 1) + 4 * g;
#pragma unroll
        for (int ai = 0; ai < 2; ++ai)
#pragma unroll
            for (int m = 0; m < 4; ++m) {
                const int row = row0 + ai * HALF + m * 16;
                const float rs = row_rstd(ss, row, fq) * qs;
                bf16_t* rowp = O + (size_t)row * 6144;
                if (rope) {
                    const f32x4 c4 = *(const f32x4*)(cosT + row * 32 + 4 * g), s4 = *(const f32x4*)(sinT + row * 32 + 4 * g);
#pragma unroll
                    for (int bj = 0; bj < 2; ++bj) {
                        const f32x4 v0 = acc[ai][bj][m][0] * rs, v1 = acc[ai][bj][m][1] * rs;
                        const f32x4 o1 = v0 * c4 - v1 * s4, o2 = v1 * c4 + v0 * s4;
                        u32x2 w1, w2; w1.x = cvt_pk_bf16(o1[0], o1[1]); w1.y = cvt_pk_bf16(o1[2], o1[3]); w2.x = cvt_pk_bf16(o2[0], o2[1]); w2.y = cvt_pk_bf16(o2[2], o2[3]);
                        *(u32x2*)(rowp + rbase + bj * HALF) = w1; *(u32x2*)(rowp + rbase + bj * HALF + 32) = w2;
                    }
                } else {
#pragma unroll
                    for (int bj = 0; bj < 2; ++bj) {
                        const f32x4 v0 = acc[ai][bj][m][0] * rs, v1 = acc[ai][bj][m][1] * rs;
                        u32x4 w; w.x = cvt_pk_bf16(v0[0], v0[1]); w.y = cvt_pk_bf16(v0[2], v0[3]); w.z = cvt_pk_bf16(v1[0], v1[1]); w.w = cvt_pk_bf16(v1[2], v1[3]);
                        *(u32x4*)(rowp + pos0 + bj * HALF) = w;
                    }
                }
            }
    }
};
struct EpiRelu2 {
    static constexpr bool PERM = true, AFTER_DRAIN = false, MIDK = false;
    bf16_t* O; const float* ss;
    __device__ __forceinline__ void operator()(const f32x4 (&acc)[2][2][4][2], const Unit& u, int wr, int wc, int fr, int fq) const {
        const int row0 = u.pm * BM + wr * 64 + fr; const int pos0 = u.pn * BM + wc * 32 + 8 * fq;
#pragma unroll
        for (int ai = 0; ai < 2; ++ai)
#pragma unroll
            for (int m = 0; m < 4; ++m) {
                const int row = row0 + ai * HALF + m * 16;
                const float rs = row_rstd(ss, row, fq);
                bf16_t* rowp = O + (size_t)row * 8192 + pos0;
#pragma unroll
                for (int bj = 0; bj < 2; ++bj) {
                    f32x4 v0 = acc[ai][bj][m][0] * rs, v1 = acc[ai][bj][m][1] * rs;
#pragma unroll
                    for (int e = 0; e < 4; ++e) { v0[e] = fmaxf(v0[e], 0.f); v1[e] = fmaxf(v1[e], 0.f); }
                    v0 = v0 * v0; v1 = v1 * v1;
                    u32x4 w; w.x = cvt_pk_bf16(v0[0], v0[1]); w.y = cvt_pk_bf16(v0[2], v0[3]); w.z = cvt_pk_bf16(v1[0], v1[1]); w.w = cvt_pk_bf16(v1[2], v1[3]);
                    *(u32x4*)(rowp + bj * HALF) = w;
                }
            }
    }
};
template <bool MID> struct EpiResidT {
    static constexpr bool PERM = false, AFTER_DRAIN = false, MIDK = MID;
    const float* Xin; float* X; bf16_t* XB; float* ssout; float sign; const float* nass;
    __device__ __forceinline__ void mid(f32x4 (&acc)[2][2][4][2], const Unit& u, int wr, int wc, int fr, int fq) const {
        int t_ = threadIdx.x; asm volatile("" : "+v"(t_));
        const int row0 = u.pm * BM + wr * 64 + (t_ & 15);
#pragma unroll
        for (int ai = 0; ai < 2; ++ai)
#pragma unroll
            for (int m = 0; m < 4; ++m) {
                const f32x4* sp = (const f32x4*)(nass + (size_t)(row0 + ai * HALF + m * 16) * 8); const f32x4 a = sp[0], b = sp[1];
                const float rn = rsqrtf((((a[0] + a[1]) + (a[2] + a[3])) + ((b[0] + b[1]) + (b[2] + b[3]))) * (1.0f / 1024.0f) + RMS_EPS);
#pragma unroll
                for (int bj = 0; bj < 2; ++bj)
#pragma unroll
                    for (int n = 0; n < 2; ++n) acc[ai][bj][m][n] = acc[ai][bj][m][n] * rn;
            }
    }
    __device__ __forceinline__ void operator()(const f32x4 (&acc)[2][2][4][2], const Unit& u, int wr, int wc, int fr, int fq) const {
        const int row0 = u.pm * BM + wr * 64 + fr; const int col0 = u.pn * BM + wc * 32 + 4 * fq;
#pragma unroll
        for (int ai = 0; ai < 2; ++ai)
#pragma unroll
            for (int m = 0; m < 4; ++m) {
                const int row = row0 + ai * HALF + m * 16; float sq = 0.f;
#pragma unroll
                for (int bj = 0; bj < 2; ++bj)
#pragma unroll
                    for (int n = 0; n < 2; ++n) {
                        const size_t off = (size_t)row * 2048 + col0 + bj * HALF + n * 16;
                        const f32x4 xv = *(const f32x4*)(Xin + off) + acc[ai][bj][m][n] * sign;
                        *(f32x4*)(X + off) = xv;
                        u32x2 w; w.x = cvt_pk_bf16(xv[0], xv[1]); w.y = cvt_pk_bf16(xv[2], xv[3]);
                        *(u32x2*)(XB + off) = w;
                        sq += (xv[0] * xv[0] + xv[1] * xv[1]) + (xv[2] * xv[2] + xv[3] * xv[3]);
                    }
                sq += __shfl_xor(sq, 16); sq += __shfl_xor(sq, 32);
                if (fq == 0) ssout[(size_t)row * 32 + u.pn * 4 + wc] = sq;
            }
    }
};
typedef EpiResidT<false> EpiResid; typedef EpiResidT<true> EpiResidMid;
template <class Epi, class Sched, bool ALIGN_EPI = false, bool SP2 = false>
__device__ __forceinline__ void gemm_phase(PG8_LAS unsigned char* lds, const Gemm g, const Sched& S, const Epi& E) {
    int tid_ = threadIdx.x; asm volatile("" : "+v"(tid_));
    const int tid = tid_, wid = __builtin_amdgcn_readfirstlane(tid >> 6), lane = tid & 63, wr = wid >> 2, wc = wid & 3, fr = lane & 15, fq = lane >> 4;
    const int K = g.K, nt = K / BK;
    unsigned voffA[2], voffB[2];
#pragma unroll
    for (int i = 0; i < 2; ++i) { int R, C; stage_rc(tid * 16 + i * 8192, R, C); const int Rb = Epi::PERM ? ((R & ~31) + perm32(R & 31)) : R;
        voffA[i] = (unsigned)(R * K + C) * 2u; voffB[i] = (unsigned)(Rb * K + C) * 2u; }
    const size_t kstep = (size_t)(BK * 2);
    const size_t hstep = (size_t)HALF * K * 2;
    const size_t tstep = 2 * hstep;
    const unsigned ldsw = (unsigned)wid * 1024u;
    const int aoff = lds_byte(wr * 64 + fr, fq * 8), boff = lds_byte(wc * 32 + fr, fq * 8);
#define PG8_SA(b, h) (((b) * 2 + (h)) * HTB)
#define PG8_SB(b, h) ((4 + (b) * 2 + (h)) * HTB)
#define PG8_STAGE(bufoff, gbase, voff) do { _Pragma("unroll") for (int _i = 0; _i < 2; ++_i) \
        __builtin_amdgcn_global_load_lds((const unsigned*)((const char*)(gbase) + (voff)[_i]), (PG8_LAS unsigned*)(lds + (bufoff) + ldsw + _i * 8192), 16, 0, 0); } while (0)
#define PG8_LDA(dst, b, h) do { _Pragma("unroll") for (int m = 0; m < 4; ++m) _Pragma("unroll") for (int k = 0; k < 2; ++k) dst[m][k] = *(const PG8_LAS bf16x8*)(lds + PG8_SA(b, h) + aoff + m * 2048 + k * 1024); } while (0)
#define PG8_LDB(dst, b, h) do { _Pragma("unroll") for (int n = 0; n < 2; ++n) _Pragma("unroll") for (int k = 0; k < 2; ++k) dst[n][k] = *(const PG8_LAS bf16x8*)(lds + PG8_SB(b, h) + boff + n * 2048 + k * 1024); } while (0)
#define PG8_MMA(ai, bj, At, Bt) do { __builtin_amdgcn_s_setprio(1); _Pragma("unroll") for (int m = 0; m < 4; ++m) _Pragma("unroll") for (int n = 0; n < 2; ++n) _Pragma("unroll") for (int k = 0; k < 2; ++k) \
        acc[ai][bj][m][n] = __builtin_amdgcn_mfma_f32_16x16x32_bf16(Bt[n][k], At[m][k], acc[ai][bj][m][n], 0, 0, 0); __builtin_amdgcn_s_setprio(0); } while (0)
#define PG8_WAIT_V(n) asm volatile("s_waitcnt vmcnt(" #n ")" ::: "memory")
#define PG8_WAIT_L(n) asm volatile("s_waitcnt lgkmcnt(" #n ")" ::: "memory")
#define PG8_BAR __builtin_amdgcn_s_barrier()
#define PG8_SCHED __builtin_amdgcn_sched_barrier(0)
    Unit cur, nxt; int ui = 0;
    if (!S.next(0, cur)) return;
    f32x4 acc[2][2][4][2];
#pragma unroll
    for (int a = 0; a < 2; ++a)
#pragma unroll
        for (int b = 0; b < 2; ++b)
#pragma unroll
            for (int m = 0; m < 4; ++m)
#pragma unroll
                for (int n = 0; n < 2; ++n) acc[a][b][m][n] = (f32x4){0.f, 0.f, 0.f, 0.f};
    bf16x8 At[4][2], B0[2][2], B1[2][2];
    const char* cA = (const char*)g.A + (size_t)cur.pm * tstep; const char* cB = (const char*)g.Bt + (size_t)cur.pn * tstep;
    S.a_ready(cur);
    if constexpr (SP2) {
        PG8_STAGE(PG8_SB(0, 0), cB, voffB); PG8_STAGE(PG8_SB(0, 1), cB + hstep, voffB); PG8_STAGE(PG8_SA(0, 0), cA, voffA); PG8_STAGE(PG8_SA(0, 1), cA + hstep, voffA);
        if (wr == 1) PG8_BAR;
        PG8_WAIT_V(2); PG8_BAR;
        PG8_STAGE(PG8_SB(1, 0), cB + kstep, voffB); PG8_STAGE(PG8_SA(1, 0), cA + kstep, voffA); PG8_STAGE(PG8_SB(1, 1), cB + hstep + kstep, voffB);
        PG8_WAIT_V(6); PG8_BAR;
    } else {
        PG8_STAGE(PG8_SB(0, 0), cB, voffB); PG8_STAGE(PG8_SA(0, 0), cA, voffA); PG8_STAGE(PG8_SB(0, 1), cB + hstep, voffB); PG8_STAGE(PG8_SA(0, 1), cA + hstep, voffA);
        if (wr == 1) PG8_BAR;
        PG8_WAIT_V(4); PG8_BAR;
        PG8_STAGE(PG8_SB(1, 0), cB + kstep, voffB); PG8_STAGE(PG8_SA(1, 0), cA + kstep, voffA); PG8_STAGE(PG8_SB(1, 1), cB + hstep + kstep, voffB);
        PG8_WAIT_V(6); PG8_BAR;
    }
    for (;;) {
        const bool has_next = S.next(ui + 1, nxt);
        const char* nA = has_next ? (const char*)g.A + (size_t)nxt.pm * tstep : cA; const char* nB = has_next ? (const char*)g.Bt + (size_t)nxt.pn * tstep : cB;
        for (int t = 0; t < nt; t += 2) {
            if constexpr (Epi::MIDK) { if (t == nt / 2) E.mid(acc, cur, wr, wc, fr, fq); }
            const bool last = (t == nt - 2);
            const char* a1 = cA + (size_t)(t + 1) * kstep;
            const char* a2 = last ? nA : cA + (size_t)(t + 2) * kstep; const char* b2 = last ? nB : cB + (size_t)(t + 2) * kstep;
            const char* a3 = a2 + kstep; const char* b3 = b2 + kstep;
            if (last && has_next) S.a_ready(nxt);
            if constexpr (SP2) {
            PG8_LDB(B0, 0, 0); PG8_LDB(B1, 0, 1); PG8_SCHED; PG8_LDA(At, 0, 0); PG8_STAGE(PG8_SA(1, 1), a1 + hstep, voffA);
            PG8_WAIT_V(8); PG8_WAIT_L(0); PG8_BAR; PG8_MMA(0, 0, At, B0); PG8_MMA(0, 1, At, B1); PG8_BAR; PG8_SCHED;
            PG8_LDA(At, 0, 1); PG8_STAGE(PG8_SB(0, 0), b2, voffB); PG8_STAGE(PG8_SB(0, 1), b2 + hstep, voffB); PG8_STAGE(PG8_SA(0, 0), a2, voffA);
            PG8_WAIT_V(8); PG8_WAIT_L(0); PG8_BAR; PG8_MMA(1, 0, At, B0); PG8_MMA(1, 1, At, B1); PG8_BAR; PG8_SCHED;
            PG8_LDB(B0, 1, 0); PG8_LDB(B1, 1, 1); PG8_SCHED; PG8_LDA(At, 1, 0); PG8_STAGE(PG8_SA(0, 1), a2 + hstep, voffA);
            PG8_WAIT_V(8); PG8_WAIT_L(0); PG8_BAR; PG8_MMA(0, 0, At, B0); PG8_MMA(0, 1, At, B1); PG8_BAR; PG8_SCHED;
            PG8_LDA(At, 1, 1); PG8_STAGE(PG8_SB(1, 0), b3, voffB); PG8_STAGE(PG8_SB(1, 1), b3 + hstep, voffB); PG8_STAGE(PG8_SA(1, 0), a3, voffA);
            PG8_WAIT_V(8); PG8_WAIT_L(0); PG8_BAR; PG8_MMA(1, 0, At, B0); PG8_MMA(1, 1, At, B1); PG8_BAR; PG8_SCHED;
            } else {
            PG8_LDB(B0, 0, 0); PG8_SCHED; PG8_LDA(At, 0, 0); PG8_STAGE(PG8_SA(1, 1), a1 + hstep, voffA);
            PG8_WAIT_L(8); PG8_BAR; PG8_WAIT_L(0); PG8_MMA(0, 0, At, B0); PG8_BAR; PG8_SCHED;
            PG8_LDB(B1, 0, 1); PG8_STAGE(PG8_SB(0, 0), b2, voffB);
            PG8_BAR; PG8_WAIT_L(0); PG8_MMA(0, 1, At, B1); PG8_BAR;
            PG8_LDA(At, 0, 1); PG8_STAGE(PG8_SA(0, 0), a2, voffA);
            PG8_BAR; PG8_WAIT_L(0); PG8_MMA(1, 0, At, B0); PG8_BAR; PG8_SCHED;
            PG8_STAGE(PG8_SB(0, 1), b2 + hstep, voffB);
            PG8_WAIT_V(6); PG8_BAR; PG8_MMA(1, 1, At, B1); PG8_BAR;
            PG8_LDB(B0, 1, 0); PG8_SCHED; PG8_LDA(At, 1, 0); PG8_STAGE(PG8_SA(0, 1), a2 + hstep, voffA);
            PG8_WAIT_L(8); PG8_BAR; PG8_WAIT_L(0); PG8_MMA(0, 0, At, B0); PG8_BAR; PG8_SCHED;
            PG8_LDB(B1, 1, 1); PG8_STAGE(PG8_SB(1, 0), b3, voffB);
            PG8_BAR; PG8_WAIT_L(0); PG8_MMA(0, 1, At, B1); PG8_BAR;
            PG8_LDA(At, 1, 1); PG8_STAGE(PG8_SA(1, 0), a3, voffA);
            PG8_BAR; PG8_WAIT_L(0); PG8_MMA(1, 0, At, B0); PG8_BAR; PG8_SCHED;
            PG8_STAGE(PG8_SB(1, 1), b3 + hstep, voffB);
            PG8_WAIT_V(6); PG8_BAR; PG8_MMA(1, 1, At, B1); PG8_BAR;
            }
        }
        if constexpr (ALIGN_EPI) { if (wr == 0) PG8_BAR; }
        if constexpr (!Epi::AFTER_DRAIN) { E(acc, cur, wr, wc, fr, fq); S.done(cur); }
        if (!has_next) break;
#pragma unroll
        for (int a = 0; a < 2; ++a)
#pragma unroll
            for (int b = 0; b < 2; ++b)
#pragma unroll
                for (int m = 0; m < 4; ++m)
#pragma unroll
                    for (int n = 0; n < 2; ++n) acc[a][b][m][n] = (f32x4){0.f, 0.f, 0.f, 0.f};
        cur = nxt; cA = nA; cB = nB; ++ui;
        if constexpr (ALIGN_EPI) { if (wr == 1) PG8_BAR; }
    }
    PG8_WAIT_V(0);
    if constexpr (!ALIGN_EPI) { if (wr == 0) PG8_BAR; }
    PG8_BAR;
    if constexpr (Epi::AFTER_DRAIN) { E.fused(acc, cur, wr, wc, fr, fq, lds, wid, lane); S.done(cur); }
#undef PG8_SA
#undef PG8_SB
#undef PG8_STAGE
#undef PG8_LDA
#undef PG8_LDB
#undef PG8_MMA
#undef PG8_WAIT_V
#undef PG8_WAIT_L
#undef PG8_BAR
#undef PG8_SCHED
}
}
namespace att {
typedef unsigned short bf16;
using bf16x8 = __attribute__((ext_vector_type(8))) short;
using s16x4  = __attribute__((ext_vector_type(4))) short;
using f32x16 = __attribute__((ext_vector_type(16))) float;
using u32x4  = __attribute__((ext_vector_type(4))) unsigned;
constexpr int LDP = 6144;
constexpr int SHM_V = 64 * 128 * 2, SHM_K = 64 * 128 * 2;
constexpr int OFF_WS = 2 * SHM_V + 2 * SHM_K, OFF_RPB = OFF_WS + 8 * 64 * 4, ATT_LDS = OFF_RPB + 2048;
constexpr float THR = 8.f;
#define KSWZ(row, colB) ((row) * 256 + ((colB) ^ (((row) & 7) << 4)))
#define SBAR() __builtin_amdgcn_sched_barrier(0)
__device__ __forceinline__ int crow(int r, int hi) { return (r & 3) + 8 * (r >> 2) + 4 * hi; }
__device__ __forceinline__ unsigned cvtpk(float lo, float hi) {
  unsigned r; asm volatile("v_cvt_pk_bf16_f32 %0, %1, %2" : "=v"(r) : "v"(lo), "v"(hi)); return r;
}
__device__ __forceinline__ bf16x8 ld8(const bf16* p) { return *reinterpret_cast<const bf16x8*>(p); }

template <int MODE> struct Cfg;
template <> struct Cfg<0> { static constexpr int ND0 = 4; static constexpr float SCALE = 0.125f; };
template <> struct Cfg<1> { static constexpr int ND0 = 8; static constexpr float SCALE = 0.088388347648318440f; };

template <int MODE>
__device__ __forceinline__ void partialSM(f32x16& p0, f32x16& p1, float& m_reg, float& mn, float& alpha) {
  constexpr float SCALE = Cfg<MODE>::SCALE;
  constexpr float C = SCALE * 1.4426950408889634f;
  float pmax = p0[0];
#pragma unroll
  for (int r = 1; r < 16; ++r) pmax = fmaxf(pmax, p0[r]);
#pragma unroll
  for (int r = 0; r < 16; ++r) pmax = fmaxf(pmax, p1[r]);
  { auto rr = __builtin_amdgcn_permlane32_swap(__float_as_uint(pmax), __float_as_uint(pmax), false, false);
    pmax = fmaxf(__uint_as_float(rr[0]), __uint_as_float(rr[1])); }
  if (__builtin_expect(__all(pmax - m_reg <= THR / SCALE), 1)) { mn = m_reg; alpha = 1.f; }
  else { mn = fmaxf(m_reg, pmax); alpha = __builtin_amdgcn_exp2f((m_reg - mn) * C); m_reg = mn; }
  float mnC = -mn * C;
#pragma unroll
  for (int r = 0; r < 16; ++r) p0[r] = fmaf(p0[r], C, mnC);
#pragma unroll
  for (int r = 0; r < 16; ++r) p1[r] = fmaf(p1[r], C, mnC);
#pragma unroll
  for (int r = 0; r < 16; ++r) p0[r] = __builtin_amdgcn_exp2f(p0[r]);
}
__device__ __forceinline__ void finishSM(f32x16& p0, f32x16& p1, float alpha, float& l_reg, bf16x8& pa0, bf16x8& pa1, bf16x8& pa2, bf16x8& pa3) {
#pragma unroll
  for (int r = 0; r < 16; ++r) p1[r] = __builtin_amdgcn_exp2f(p1[r]);
  float ps = 0;
#pragma unroll
  for (int r = 0; r < 16; ++r) ps += p0[r];
#pragma unroll
  for (int r = 0; r < 16; ++r) ps += p1[r];
  { auto rr = __builtin_amdgcn_permlane32_swap(__float_as_uint(ps), __float_as_uint(ps), false, false);
    ps = __uint_as_float(rr[0]) + __uint_as_float(rr[1]); }
  l_reg = l_reg * alpha + ps;
#define PK4(P, BASE, OUT) do { u32x4 w = {cvtpk(P[BASE + 0], P[BASE + 1]), cvtpk(P[BASE + 2], P[BASE + 3]), cvtpk(P[BASE + 4], P[BASE + 5]), cvtpk(P[BASE + 6], P[BASE + 7])}; \
    OUT = *reinterpret_cast<bf16x8*>(&w); } while (0)
  PK4(p0, 0, pa0); PK4(p0, 8, pa1); PK4(p1, 0, pa2); PK4(p1, 8, pa3);
#undef PK4
}
__device__ __forceinline__ void finishSM_ns(f32x16& p0, f32x16& p1, bf16x8& pa0, bf16x8& pa1, bf16x8& pa2, bf16x8& pa3) {
#pragma unroll
  for (int r = 0; r < 16; ++r) p1[r] = __builtin_amdgcn_exp2f(p1[r]);
#define PK4(P, BASE, OUT) do { u32x4 w = {cvtpk(P[BASE + 0], P[BASE + 1]), cvtpk(P[BASE + 2], P[BASE + 3]), cvtpk(P[BASE + 4], P[BASE + 5]), cvtpk(P[BASE + 6], P[BASE + 7])}; \
    OUT = *reinterpret_cast<bf16x8*>(&w); } while (0)
  PK4(p0, 0, pa0); PK4(p0, 8, pa1); PK4(p1, 0, pa2); PK4(p1, 8, pa3);
#undef PK4
}
__device__ __forceinline__ void sm_sum(const f32x16& p0, const f32x16& p1, float& ps) {
  ps = 0;
#pragma unroll
  for (int r = 0; r < 16; ++r) ps += p0[r];
#pragma unroll
  for (int r = 0; r < 16; ++r) ps += p1[r];
}
template <int MODE>
__device__ __forceinline__ void sm_lmax(float ps, float alpha_prev, float& l_reg, const f32x16& p0, const f32x16& p1, float& m_reg, float& mn, float& alpha, float& mnC) {
  constexpr float SCALE = Cfg<MODE>::SCALE; constexpr float C = SCALE * 1.4426950408889634f;
  { auto rr = __builtin_amdgcn_permlane32_swap(__float_as_uint(ps), __float_as_uint(ps), false, false);
    ps = __uint_as_float(rr[0]) + __uint_as_float(rr[1]); }
  l_reg = l_reg * alpha_prev + ps;
  float pmax = p0[0];
#pragma unroll
  for (int r = 1; r < 16; ++r) pmax = fmaxf(pmax, p0[r]);
#pragma unroll
  for (int r = 0; r < 16; ++r) pmax = fmaxf(pmax, p1[r]);
  { auto rr = __builtin_amdgcn_permlane32_swap(__float_as_uint(pmax), __float_as_uint(pmax), false, false);
    pmax = fmaxf(__uint_as_float(rr[0]), __uint_as_float(rr[1])); }
  if (__builtin_expect(__all(pmax - m_reg <= THR / SCALE), 1)) { mn = m_reg; alpha = 1.f; }
  else { mn = fmaxf(m_reg, pmax); alpha = __builtin_amdgcn_exp2f((m_reg - mn) * C); m_reg = mn; }
  mnC = -mn * C;
}
template <int MODE>
__device__ __forceinline__ void sm_fma(f32x16& p0, f32x16& p1, float mnC) {
  constexpr float C = Cfg<MODE>::SCALE * 1.4426950408889634f;
#pragma unroll
  for (int r = 0; r < 16; ++r) p0[r] = fmaf(p0[r], C, mnC);
#pragma unroll
  for (int r = 0; r < 16; ++r) p1[r] = fmaf(p1[r], C, mnC);
}
__device__ __forceinline__ void sm_exp0(f32x16& p0) {
#pragma unroll
  for (int r = 0; r < 16; ++r) p0[r] = __builtin_amdgcn_exp2f(p0[r]);
}
template <int ND0>
__device__ __forceinline__ void qkt(f32x16& p0, f32x16& p1, const bf16* Ks, const bf16x8* qr, int r32, int hi, int kcb) {
  p0 = f32x16{}; p1 = f32x16{};
#pragma unroll
  for (int d0 = 0; d0 < ND0; ++d0) { int cb = kcb + (d0 * 16 + hi * 8) * 2;
    bf16x8 b0 = *reinterpret_cast<const bf16x8*>((const char*)Ks + KSWZ(r32, cb));
    bf16x8 b1 = *reinterpret_cast<const bf16x8*>((const char*)Ks + KSWZ(32 + r32, cb));
    p0 = __builtin_amdgcn_mfma_f32_32x32x16_bf16(b0, qr[d0], p0, 0, 0, 0);
    p1 = __builtin_amdgcn_mfma_f32_32x32x16_bf16(b1, qr[d0], p1, 0, 0, 0); }
}
constexpr float THRL = 8.f * 1.4426950408889634f;
template <int ND0>
__device__ __forceinline__ void qk_rd(bf16x8 (&kb0)[ND0], bf16x8 (&kb1)[ND0], const bf16* Ks, int r32, int hi, int kcb) {
#pragma unroll
  for (int d0 = 0; d0 < ND0; ++d0) { int cb = kcb + (d0 * 16 + hi * 8) * 2;
    kb0[d0] = *reinterpret_cast<const bf16x8*>((const char*)Ks + KSWZ(r32, cb));
    kb1[d0] = *reinterpret_cast<const bf16x8*>((const char*)Ks + KSWZ(32 + r32, cb)); }
}
template <int ND0>
__device__ __forceinline__ void qk_mm(f32x16& p0, f32x16& p1, const bf16x8 (&kb0)[ND0], const bf16x8 (&kb1)[ND0], const bf16x8* qr, const f32x16& negm) {
#pragma unroll
  for (int d0 = 0; d0 < ND0; ++d0) {
    if (d0 == 0) { p0 = __builtin_amdgcn_mfma_f32_32x32x16_bf16(kb0[d0], qr[d0], negm, 0, 0, 0); p1 = __builtin_amdgcn_mfma_f32_32x32x16_bf16(kb1[d0], qr[d0], negm, 0, 0, 0); }
    else { p0 = __builtin_amdgcn_mfma_f32_32x32x16_bf16(kb0[d0], qr[d0], p0, 0, 0, 0); p1 = __builtin_amdgcn_mfma_f32_32x32x16_bf16(kb1[d0], qr[d0], p1, 0, 0, 0); } }
}
template <int ND0>
__device__ __forceinline__ void qkt_c(f32x16& p0, f32x16& p1, const bf16* Ks, const bf16x8* qr, int r32, int hi, int kcb, const f32x16& negm) {
  bf16x8 kb0[ND0], kb1[ND0];
#pragma unroll
  for (int d0 = 0; d0 < ND0; ++d0) { int cb = kcb + (d0 * 16 + hi * 8) * 2;
    kb0[d0] = *reinterpret_cast<const bf16x8*>((const char*)Ks + KSWZ(r32, cb));
    kb1[d0] = *reinterpret_cast<const bf16x8*>((const char*)Ks + KSWZ(32 + r32, cb)); }
  SBAR();
#pragma unroll
  for (int d0 = 0; d0 < ND0; ++d0) { const bf16x8 b0 = kb0[d0], b1 = kb1[d0];
    if (d0 == 0) { p0 = __builtin_amdgcn_mfma_f32_32x32x16_bf16(b0, qr[d0], negm, 0, 0, 0); p1 = __builtin_amdgcn_mfma_f32_32x32x16_bf16(b1, qr[d0], negm, 0, 0, 0); }
    else { p0 = __builtin_amdgcn_mfma_f32_32x32x16_bf16(b0, qr[d0], p0, 0, 0, 0); p1 = __builtin_amdgcn_mfma_f32_32x32x16_bf16(b1, qr[d0], p1, 0, 0, 0); } }
}
__device__ __forceinline__ float rowmax32(const f32x16& p0, const f32x16& p1) {
  float pmax = p0[0];
#pragma unroll
  for (int r = 1; r < 16; ++r) pmax = fmaxf(pmax, p0[r]);
#pragma unroll
  for (int r = 0; r < 16; ++r) pmax = fmaxf(pmax, p1[r]);
  auto rr = __builtin_amdgcn_permlane32_swap(__float_as_uint(pmax), __float_as_uint(pmax), false, false);
  return fmaxf(__uint_as_float(rr[0]), __uint_as_float(rr[1]));
}
__device__ __forceinline__ void firstSM_l2(f32x16& p0, f32x16& p1, float& m_reg, f32x16& negm) {
  const float pmax = rowmax32(p0, p1);
  m_reg = pmax;
#pragma unroll
  for (int r = 0; r < 16; ++r) { negm[r] = -pmax; p0[r] -= pmax; p1[r] -= pmax; }
#pragma unroll
  for (int r = 0; r < 16; ++r) p0[r] = __builtin_amdgcn_exp2f(p0[r]);
}
__device__ __forceinline__ void sm_lmax_l2(float ps, float alpha_prev, float& l_reg, f32x16& p0, f32x16& p1, float& m_reg, float& alpha, f32x16& negm) {
  { auto rr = __builtin_amdgcn_permlane32_swap(__float_as_uint(ps), __float_as_uint(ps), false, false);
    ps = __uint_as_float(rr[0]) + __uint_as_float(rr[1]); }
  l_reg = l_reg * alpha_prev + ps;
  const float pmax = rowmax32(p0, p1);
  if (__builtin_expect(__all(pmax <= THRL), 1)) { alpha = 1.f; }
  else { const float dlt = fmaxf(pmax, 0.f); alpha = __builtin_amdgcn_exp2f(-dlt); m_reg += dlt;
#pragma unroll
    for (int r = 0; r < 16; ++r) { negm[r] -= dlt; p0[r] -= dlt; p1[r] -= dlt; } }
}
__device__ __forceinline__ void sm_exp_lo(f32x16& p0) {
#pragma unroll
  for (int r = 0; r < 8; ++r) p0[r] = __builtin_amdgcn_exp2f(p0[r]);
}
__device__ __forceinline__ void sm_exp_hi(f32x16& p0) {
#pragma unroll
  for (int r = 8; r < 16; ++r) p0[r] = __builtin_amdgcn_exp2f(p0[r]);
}
__device__ __forceinline__ int v_st(int k, int c) { return ((k >> 3) * 4 + (c >> 5)) * 512 + ((k & 7) * 32 + (c & 31)) * 2; }
__device__ __forceinline__ int v_rd_base(int lane) { return ((lane & 3) << 3) | (((lane >> 2) & 3) << 6) | (((lane >> 4) & 1) << 5) | (((lane >> 5) & 1) << 8); }
constexpr int v_rd_off(int d0, int ks, int half) { return d0 * 512 + ks * 4096 + half * 2048; }
template <int OFF> __device__ __forceinline__ s16x4 tr_read(int vb) {
  s16x4 r; asm volatile("ds_read_b64_tr_b16 %0, %1 offset:%2" : "=&v"(r) : "v"(vb), "i"(OFF) : "memory"); return r;
}
template <int D0> __device__ __forceinline__ void pv_one(f32x16& od, int vb, bf16x8 pa0, bf16x8 pa1, bf16x8 pa2, bf16x8 pa3) {
  const s16x4 l0 = tr_read<v_rd_off(D0, 0, 0)>(vb), h0 = tr_read<v_rd_off(D0, 0, 1)>(vb), l1 = tr_read<v_rd_off(D0, 1, 0)>(vb), h1 = tr_read<v_rd_off(D0, 1, 1)>(vb);
  const s16x4 l2 = tr_read<v_rd_off(D0, 2, 0)>(vb), h2 = tr_read<v_rd_off(D0, 2, 1)>(vb), l3 = tr_read<v_rd_off(D0, 3, 0)>(vb), h3 = tr_read<v_rd_off(D0, 3, 1)>(vb);
  asm volatile("s_waitcnt lgkmcnt(0)" ::: "memory"); SBAR();
#define PK(L, H) (bf16x8){L[0], L[1], L[2], L[3], H[0], H[1], H[2], H[3]}
  od = __builtin_amdgcn_mfma_f32_32x32x16_bf16(pa0, PK(l0, h0), od, 0, 0, 0);
  od = __builtin_amdgcn_mfma_f32_32x32x16_bf16(pa1, PK(l1, h1), od, 0, 0, 0);
  od = __builtin_amdgcn_mfma_f32_32x32x16_bf16(pa2, PK(l2, h2), od, 0, 0, 0);
  od = __builtin_amdgcn_mfma_f32_32x32x16_bf16(pa3, PK(l3, h3), od, 0, 0, 0);
#undef PK
}
__device__ __forceinline__ void pv_d0(f32x16* o, int vb, bf16x8 pa0, bf16x8 pa1, bf16x8 pa2, bf16x8 pa3) {
  pv_one<0>(o[0], vb, pa0, pa1, pa2, pa3); pv_one<1>(o[1], vb, pa0, pa1, pa2, pa3); pv_one<2>(o[2], vb, pa0, pa1, pa2, pa3); pv_one<3>(o[3], vb, pa0, pa1, pa2, pa3);
}
struct VFrag { s16x4 l0, h0, l1, h1, l2, h2, l3, h3; };
template <int D0> __device__ __forceinline__ void pv_rd(VFrag& f, int vb) {
  f.l0 = tr_read<v_rd_off(D0, 0, 0)>(vb); f.h0 = tr_read<v_rd_off(D0, 0, 1)>(vb); f.l1 = tr_read<v_rd_off(D0, 1, 0)>(vb); f.h1 = tr_read<v_rd_off(D0, 1, 1)>(vb);
  f.l2 = tr_read<v_rd_off(D0, 2, 0)>(vb); f.h2 = tr_read<v_rd_off(D0, 2, 1)>(vb); f.l3 = tr_read<v_rd_off(D0, 3, 0)>(vb); f.h3 = tr_read<v_rd_off(D0, 3, 1)>(vb);
}
template <int NW_>
__device__ __forceinline__ void pv_mm(f32x16& od, const VFrag& f, bf16x8 pa0, bf16x8 pa1, bf16x8 pa2, bf16x8 pa3) {
  if (NW_ == 8) asm volatile("s_waitcnt lgkmcnt(8)" ::: "memory"); else asm volatile("s_waitcnt lgkmcnt(0)" ::: "memory");
  SBAR();
#define PK(L, H) (bf16x8){L[0], L[1], L[2], L[3], H[0], H[1], H[2], H[3]}
  od = __builtin_amdgcn_mfma_f32_32x32x16_bf16(pa0, PK(f.l0, f.h0), od, 0, 0, 0);
  od = __builtin_amdgcn_mfma_f32_32x32x16_bf16(pa1, PK(f.l1, f.h1), od, 0, 0, 0);
  od = __builtin_amdgcn_mfma_f32_32x32x16_bf16(pa2, PK(f.l2, f.h2), od, 0, 0, 0);
  od = __builtin_amdgcn_mfma_f32_32x32x16_bf16(pa3, PK(f.l3, f.h3), od, 0, 0, 0);
#undef PK
}
__device__ __forceinline__ void na_fix(f32x16& p0, f32x16& p1, int kr, int qr_, int rs, int qc, int cs, int hi, const float* rpbS) {
  const float NEG = -__builtin_inff();
  if (kr < rs || kr >= rs + 8) {
#pragma unroll
    for (int r = 0; r < 16; ++r) { p0[r] = NEG; p1[r] = NEG; }
  } else {
    const float* brow = rpbS + (kr - qr_ + 7) * 31 + (15 - qc);
#pragma unroll
    for (int g = 0; g < 4; ++g) {
#pragma unroll
      for (int q = 0; q < 4; ++q) { const int r = 4 * g + q;
        const int k0 = crow(r, hi), k1 = 32 + k0;
        const bool v0 = (unsigned)(k0 - cs) < 16u, v1 = (unsigned)(k1 - cs) < 16u;
        const float b0 = brow[v0 ? k0 : qc], b1 = brow[v1 ? k1 : qc];
        p0[r] = (p0[r] + b0) + (v0 ? 0.f : NEG); p1[r] = (p1[r] + b1) + (v1 ? 0.f : NEG);
      }
      SBAR();
    }
  }
}

template <int MODE>
__device__ __forceinline__ void attn_core(const bf16* __restrict__ Qw, const bf16* __restrict__ Kh, const bf16* __restrict__ Vh, const int NT, char* lds, const int kcb,
                                          const int, const int, const int, const int, const int, f32x16 (&o)[4], float& l_reg) {
  constexpr int ND0 = Cfg<MODE>::ND0;
  int tid_ = threadIdx.x; asm volatile("" : "+v"(tid_));
  const int tid = tid_, wid = __builtin_amdgcn_readfirstlane(tid >> 6), lane = tid & 63, r32 = lane & 31, hi = lane >> 5, half = wid >> 2, ht = tid & 255;
  bf16* V_lds = (bf16*)lds; bf16* K_lds = (bf16*)(lds + 2 * SHM_V);
  float* ws = (float*)(lds + OFF_WS) + wid * 64; float* al_l = ws + 32;
  float m_reg = 0.f; l_reg = 0.f; f32x16 negm = f32x16{};
#pragma unroll
  for (int d = 0; d < 4; ++d) o[d] = f32x16{};
  bf16x8 qr[ND0];
#pragma unroll
  for (int d0 = 0; d0 < ND0; ++d0) qr[d0] = ld8(Qw + d0 * 16);
  const int vb0 = (int)(uintptr_t)V_lds + v_rd_base(lane);
  {
    const int sr = tid >> 4, sc = (tid & 15) * 8;
    const bf16x8 v0 = ld8(&Vh[(long)sr * LDP + sc]), v1 = ld8(&Vh[(long)(32 + sr) * LDP + sc]), k0 = ld8(&Kh[(long)sr * LDP + sc]), k1 = ld8(&Kh[(long)(32 + sr) * LDP + sc]);
    *(bf16x8*)((char*)V_lds + v_st(sr, sc)) = v0; *(bf16x8*)((char*)V_lds + v_st(32 + sr, sc)) = v1;
    *(bf16x8*)((char*)K_lds + KSWZ(sr, sc * 2)) = k0; *(bf16x8*)((char*)K_lds + KSWZ(32 + sr, sc * 2)) = k1; }
  const int hr = ht >> 4, hc = (ht & 15) * 8;
  const bf16* Sg = (half == 0 ? Kh : Vh) + (long)hr * LDP + hc;
  char* Sl = half == 0 ? (char*)K_lds : (char*)V_lds;
  int soff[4];
#pragma unroll
  for (int i = 0; i < 4; ++i) soff[i] = half == 0 ? KSWZ(hr + 16 * i, hc * 2) : v_st(hr + 16 * i, hc);
  bf16x8 st[4], su[4];
#define HLOAD(R, t) do { _Pragma("unroll") for (int i = 0; i < 4; ++i) R[i] = ld8(Sg + (long)((t) * 64 + 16 * i) * LDP); } while (0)
#define HWRITE(R, b) do { _Pragma("unroll") for (int i = 0; i < 4; ++i) *(bf16x8*)(Sl + (b) * SHM_V + soff[i]) = R[i]; } while (0)
#define BAR_P() do { asm volatile("" : "+v"(p0), "+v"(p1)); SBAR(); asm volatile("s_waitcnt lgkmcnt(0)\n\ts_barrier" ::: "memory"); SBAR(); } while (0)
#define BAR_A() do { asm volatile("" : "+v"(pa0), "+v"(pa1), "+v"(pa2), "+v"(pa3)); SBAR(); asm volatile("s_waitcnt lgkmcnt(0)\n\ts_barrier" ::: "memory"); SBAR(); } while (0)
  f32x16 p0 = f32x16{}, p1 = f32x16{}; bf16x8 pa0, pa1, pa2, pa3; float alpha;
#define MSEG(VB, KS) do { VFrag fa_, fb_; bf16x8 kb0_[ND0], kb1_[ND0]; \
    pv_rd<0>(fa_, VB); pv_rd<1>(fb_, VB); pv_mm<8>(o[0], fa_, pa0, pa1, pa2, pa3); \
    pv_rd<2>(fa_, VB); pv_mm<8>(o[1], fb_, pa0, pa1, pa2, pa3); \
    pv_rd<3>(fb_, VB); pv_mm<8>(o[2], fa_, pa0, pa1, pa2, pa3); \
    qk_rd<ND0>(kb0_, kb1_, KS, r32, hi, kcb); pv_mm<8>(o[3], fb_, pa0, pa1, pa2, pa3); \
    qk_mm<ND0>(p0, p1, kb0_, kb1_, qr, negm); } while (0)
#define VSEG(FIRST) do { alpha = 1.f; const float pmax_ = rowmax32(p0, p1); \
    if (FIRST) { m_reg = pmax_; _Pragma("unroll") for (int r = 0; r < 16; ++r) { negm[r] = -pmax_; p0[r] -= pmax_; p1[r] -= pmax_; } } \
    else if (!__builtin_expect(__all(pmax_ <= THRL), 1)) { const float dlt_ = fmaxf(pmax_, 0.f); alpha = __builtin_amdgcn_exp2f(-dlt_); m_reg += dlt_; \
      _Pragma("unroll") for (int r = 0; r < 16; ++r) { negm[r] -= dlt_; p0[r] -= dlt_; p1[r] -= dlt_; } \
      if (hi == 0) al_l[r32] = alpha; asm volatile("s_waitcnt lgkmcnt(0)" ::: "memory"); \
      _Pragma("unroll") for (int d = 0; d < 4; ++d) _Pragma("unroll") for (int r = 0; r < 16; ++r) o[d][r] *= al_l[crow(r, hi)]; } \
    sm_exp0(p0); finishSM(p0, p1, alpha, l_reg, pa0, pa1, pa2, pa3); } while (0)
  __syncthreads();
  HLOAD(st, 1); HLOAD(su, 2);
  if (half == 1) BAR_P();
  qkt<ND0>(p0, p1, K_lds, qr, r32, hi, kcb);
  BAR_P();
  VSEG(true); HWRITE(st, 1); BAR_A();
  MSEG(vb0, (bf16*)((char*)K_lds + SHM_K)); if (3 < NT) HLOAD(st, 3); BAR_P();
#pragma unroll 1
  for (int j = 1; j + 1 < NT; j += 2) {
    VSEG(false); HWRITE(su, 0); BAR_A();
    MSEG(vb0 + SHM_V, K_lds); if (j + 3 < NT) HLOAD(su, j + 3); BAR_P();
    VSEG(false); HWRITE(st, 1); BAR_A();
    MSEG(vb0, (bf16*)((char*)K_lds + SHM_K)); if (j + 4 < NT) HLOAD(st, j + 4); BAR_P();
  }
  VSEG(false); BAR_A();
  pv_d0(o, vb0 + SHM_V, pa0, pa1, pa2, pa3); BAR_P();
  if (half == 0) BAR_P();
#undef VSEG
#undef MSEG
#undef HLOAD
#undef HWRITE
#undef BAR_P
#undef BAR_A
}
__device__ __forceinline__ float half_sum32(float v) {
#pragma unroll
  for (int o = 1; o < 32; o <<= 1) v += __shfl_xor(v, o);
  return v;
}
__device__ __forceinline__ void diff_unit(const bf16* __restrict__ proj, bf16* __restrict__ mix, int h, int q0, float lam, float oml, const float* __restrict__ subg, char* lds) {
  int tid_ = threadIdx.x; asm volatile("" : "+v"(tid_));
  const int tid = tid_, wid = tid >> 6, lane = tid & 63, r32 = lane & 31, hi = lane >> 5, map = wid >> 2, wq = wid & 3;
  const bf16* Qw = proj + (size_t)(q0 + wq * 32 + r32) * LDP + h * 128 + map * 64 + hi * 8;
  f32x16 o[4]; float l_reg;
  attn_core<0>(Qw, proj + 1024 + h * 128, proj + 2048 + h * 128, 8192 / 64, lds, map * 128, 0, 0, 0, 0, 0, o, l_reg);
  float* ws = (float*)(lds + OFF_WS) + wid * 64;
  if (hi == 0) ws[r32] = l_reg;
  asm volatile("s_waitcnt lgkmcnt(0)" ::: "memory");
  float rli[16];
#pragma unroll
  for (int r = 0; r < 16; ++r) rli[r] = __builtin_amdgcn_rcpf(ws[crow(r, hi)]);
  __syncthreads();
  float* X = (float*)lds + (wq * 64) * 64 + lane;
  if (map == 1) {
#pragma unroll
    for (int d = 0; d < 4; ++d)
#pragma unroll
      for (int r = 0; r < 16; ++r) X[(d * 16 + r) * 64] = o[d][r] * rli[r];
  }
  __syncthreads();
  if (map == 0) {
    float gv[4];
#pragma unroll
    for (int d = 0; d < 4; ++d) gv[d] = subg[32 * d + r32] * oml;
    bf16* Ow = mix + (size_t)(q0 + wq * 32) * 2048 + 1024 + h * 128 + r32;
#pragma unroll
    for (int r = 0; r < 16; ++r) {
      float dv[4]; float sq = 0.f;
#pragma unroll
      for (int d = 0; d < 4; ++d) { dv[d] = o[d][r] * rli[r] - lam * X[(d * 16 + r) * 64]; sq += dv[d] * dv[d]; }
      sq = half_sum32(sq);
      const float rn = rsqrtf(sq * (1.0f / 128.0f) + 1e-6f);
      bf16* orow = Ow + (size_t)crow(r, hi) * 2048;
#pragma unroll
      for (int d = 0; d < 4; ++d) orow[32 * d] = (bf16)(cvtpk(dv[d] * rn * gv[d], 0.f) & 0xffffu);
    }
  }
  __syncthreads();
}
__device__ __forceinline__ void attn_na_core(const bf16* __restrict__ Qw, const bf16* __restrict__ Kh, const bf16* __restrict__ Vh, const int NT, char* lds,
                                             const int na_qr, const int na_rs, const int na_qc, const int na_cs, const int na_k0, f32x16 (&o)[4], float& l_reg) {
  int tid_ = threadIdx.x; asm volatile("" : "+v"(tid_));
  const int tid = tid_, wid = tid >> 6, lane = tid & 63, r32 = lane & 31, hi = lane >> 5;
  bf16* V_lds = (bf16*)lds; bf16* K_lds = (bf16*)(lds + 2 * SHM_V);
  float* ws = (float*)(lds + OFF_WS) + wid * 64; float* al_l = ws + 32;
  const float* rpbS = (const float*)(lds + OFF_RPB);
  float m_reg = -1e30f; l_reg = 0.f;
#pragma unroll
  for (int d = 0; d < 4; ++d) o[d] = f32x16{};
  bf16x8 qr[8];
#pragma unroll
  for (int d0 = 0; d0 < 8; ++d0) qr[d0] = ld8(Qw + d0 * 16);
  const int sr = tid >> 4, sc = (tid & 15) * 8, vst0 = v_st(sr, sc), vst1 = v_st(32 + sr, sc);
  const int vb0 = (int)(uintptr_t)V_lds + v_rd_base(lane);
  bf16x8 vs0, vs1, ks0, ks1;
#define SLOAD(k0) do { vs0 = ld8(&Vh[(long)((k0) + sr) * LDP + sc]); vs1 = ld8(&Vh[(long)((k0) + 32 + sr) * LDP + sc]); \
    ks0 = ld8(&Kh[(long)((k0) + sr) * LDP + sc]); ks1 = ld8(&Kh[(long)((k0) + 32 + sr) * LDP + sc]); } while (0)
  SLOAD(0);
#pragma unroll 1
  for (int j = 0; j < NT; ++j) {
    __syncthreads();
    *(bf16x8*)((char*)V_lds + vst0) = vs0; *(bf16x8*)((char*)V_lds + vst1) = vs1;
    *(bf16x8*)((char*)K_lds + KSWZ(sr, sc * 2)) = ks0; *(bf16x8*)((char*)K_lds + KSWZ(32 + sr, sc * 2)) = ks1;
    if (j + 1 < NT) SLOAD((j + 1) * 64);
    __syncthreads();
    const int kr = na_k0 + j;
    if (kr >= na_rs && kr < na_rs + 8) {
      f32x16 p0, p1; float mn, al; bf16x8 pa0, pa1, pa2, pa3;
      qkt<8>(p0, p1, K_lds, qr, r32, hi, 0);
      na_fix(p0, p1, kr, na_qr, na_rs, na_qc, na_cs, hi, rpbS);
      partialSM<1>(p0, p1, m_reg, mn, al);
      if (__any(al < 1.f)) { if (hi == 0) al_l[r32] = al; asm volatile("s_waitcnt lgkmcnt(0)" ::: "memory");
#pragma unroll
        for (int d = 0; d < 4; ++d)
#pragma unroll
          for (int r = 0; r < 16; ++r) o[d][r] *= al_l[crow(r, hi)]; }
      finishSM(p0, p1, al, l_reg, pa0, pa1, pa2, pa3); SBAR();
      pv_d0(o, vb0, pa0, pa1, pa2, pa3);
    }
  }
#undef SLOAD
}
__device__ __forceinline__ void na_unit(const bf16* __restrict__ proj, bf16* __restrict__ mix, float* __restrict__ nass, int h, int rb, const float* __restrict__ rpb_h, char* lds) {
  int tid_ = threadIdx.x; asm volatile("" : "+v"(tid_));
  const int tid = tid_, wid = tid >> 6, lane = tid & 63, r32 = lane & 31, hi = lane >> 5;
  float* rpbS = (float*)(lds + OFF_RPB);
  if (tid < 15 * 31) rpbS[tid] = rpb_h[tid] * 11.313708498984761f;
  const int q0 = rb * 256; int k0row = rb * 4 - 4; k0row = k0row < 0 ? 0 : (k0row > 116 ? 116 : k0row);
  const int qr_ = rb * 4 + (wid >> 1), qc = (wid & 1) * 32 + r32;
  int rs = qr_ - 4; rs = rs < 0 ? 0 : (rs > 120 ? 120 : rs);
  int cs = qc - 8; cs = cs < 0 ? 0 : (cs > 48 ? 48 : cs);
  const bf16* Qw = proj + (size_t)(q0 + wid * 32 + r32) * LDP + 3072 + h * 128 + hi * 8;
  const bf16* Kh = proj + (size_t)k0row * 64 * LDP + 4096 + h * 128;
  const bf16* Vh = proj + (size_t)k0row * 64 * LDP + 5120 + h * 128;
  f32x16 o[4]; float l_reg;
  attn_na_core(Qw, Kh, Vh, 12, lds, qr_, rs, qc, cs, k0row, o, l_reg);
  int t2 = threadIdx.x; asm volatile("" : "+v"(t2));
  const int wid2 = t2 >> 6, r32b = t2 & 31, hib = (t2 >> 5) & 1;
  float* ws = (float*)(lds + OFF_WS) + wid2 * 64;
  if (hib == 0) ws[r32b] = l_reg;
  asm volatile("s_waitcnt lgkmcnt(0)" ::: "memory");
  bf16* Ow = mix + (size_t)(rb * 256 + wid2 * 32) * 2048 + h * 128 + r32b;
  float* nrow = nass + (size_t)(rb * 256 + wid2 * 32) * 8 + h;
#pragma unroll
  for (int r = 0; r < 16; ++r) {
    const float rl = __builtin_amdgcn_rcpf(ws[crow(r, hib)]);
    bf16* orow = Ow + (size_t)crow(r, hib) * 2048; float sq = 0.f;
#pragma unroll
    for (int d = 0; d < 4; ++d) { const float v = o[d][r] * rl; sq += v * v; orow[32 * d] = (bf16)(cvtpk(v, 0.f) & 0xffffu); }
    sq = half_sum32(sq);
    if (r32b == 0) nrow[(size_t)crow(r, hib) * 8] = sq;
  }
  __syncthreads();
}
#undef KSWZ
#undef SBAR
}
#define LAS __attribute__((address_space(3)))
typedef unsigned short bf16_t;
typedef unsigned v4u __attribute__((ext_vector_type(4)));
typedef unsigned v2u __attribute__((ext_vector_type(2)));
typedef float v4f __attribute__((ext_vector_type(4)));
#define XB_TMO      128
#define XB_XCNT(j)  (256  + 64 * (j))
#define XB_XSUB(j)  (1280 + 64 * (j))
#define XB_XGEN(j)  (2304 + 64 * (j))
#define XB_TOP      3328
#define XB_TOPGEN   3392
#define XCD_BAR_WORDS 3456
#define XB_SPIN_CAP (1u << 18)

__device__ __forceinline__ unsigned xb_ld(unsigned* p)              { return __hip_atomic_load(p, __ATOMIC_RELAXED, __HIP_MEMORY_SCOPE_AGENT); }
__device__ __forceinline__ unsigned xb_add(unsigned* p, unsigned v) { return __hip_atomic_fetch_add(p, v, __ATOMIC_RELAXED, __HIP_MEMORY_SCOPE_AGENT); }
__device__ __forceinline__ unsigned xb_xcc_id() { return (unsigned)__builtin_amdgcn_s_getreg((3 << 11) | 20) & 0xFu; }
#define XB_SPIN(cond, bar) do { unsigned _sp = 0; while (cond) { __builtin_amdgcn_s_sleep(1); \
    if ((++_sp & 255u) == 0u) { if (xb_ld(&(bar)[XB_TMO])) break; if (_sp > XB_SPIN_CAP) { atomicAdd(&(bar)[XB_TMO], 1u); break; } } } } while (0)

struct XcdBarrier {
    unsigned* bar; unsigned x;
    volatile LAS unsigned* st;
};

__device__ __forceinline__ XcdBarrier xcd_barrier_post(unsigned* bar, volatile LAS unsigned* st) {
    XcdBarrier b; b.bar = bar; b.x = xb_xcc_id(); b.st = st;
    if (threadIdx.x == 0) (void)xb_add(&bar[XB_XCNT(b.x)], 1u);
    return b;
}
__device__ __forceinline__ void xcd_barrier_complete(unsigned* bar, unsigned x, unsigned& nloc, unsigned& nx) {
    const unsigned G = gridDim.x * gridDim.y * gridDim.z;
    unsigned sum, cnt, mine, sp = 0u;
    for (;;) {
        sum = 0u; cnt = 0u; mine = 0u;
#pragma unroll
        for (unsigned j = 0; j < 16; ++j) { const unsigned c = xb_ld(&bar[XB_XCNT(j)]); sum += c; cnt += (c > 0u) ? 1u : 0u; mine = (j == x) ? c : mine; }
        if (sum == G) break;
        __builtin_amdgcn_s_sleep(1);
        if ((++sp & 255u) == 0u) { if (xb_ld(&bar[XB_TMO])) break; if (sp > XB_SPIN_CAP) { atomicAdd(&bar[XB_TMO], 1u); break; } }
    }
    nloc = mine > 0u ? mine : 1u; nx = cnt > 0u ? cnt : 1u;
}

__device__ __forceinline__ void xcd_barrier(const XcdBarrier& b) {
    asm volatile("s_waitcnt vmcnt(0)" ::: "memory");
    __syncthreads();
    if (threadIdx.x == 0) {
        unsigned* bar = b.bar;
        __builtin_amdgcn_s_waitcnt(0);
        unsigned nloc = b.st[0], nx = b.st[1];
        if (nloc == 0u) { xcd_barrier_complete(bar, b.x, nloc, nx); b.st[0] = nloc; b.st[1] = nx; }
        const unsigned old = xb_add(&bar[XB_XSUB(b.x)], 1u);
        const unsigned gen = old / nloc;
        if (old + 1u == (gen + 1u) * nloc) {
            __builtin_amdgcn_fence(__ATOMIC_RELEASE, "agent");
            asm volatile("s_waitcnt vmcnt(0)" ::: "memory");
            const unsigned og = xb_add(&bar[XB_TOP], 1u);
            const unsigned tg = og / nx;
            if (og + 1u == (tg + 1u) * nx) xb_add(&bar[XB_TOPGEN], 1u);
            else XB_SPIN(xb_ld(&bar[XB_TOPGEN]) == tg, bar);
            __builtin_amdgcn_fence(__ATOMIC_ACQUIRE, "agent");
            xb_add(&bar[XB_XGEN(b.x)], 1u);
            asm volatile("s_waitcnt vmcnt(0)" ::: "memory");
        } else {
            XB_SPIN(xb_ld(&bar[XB_XGEN(b.x)]) == gen, bar);
            __builtin_amdgcn_fence(__ATOMIC_ACQUIRE, "agent");
            asm volatile("s_waitcnt vmcnt(0)" ::: "memory");
        }
    }
    __syncthreads();
}

constexpr int SEQ = 8192, DM = 2048, INC = 6144, FF = 8192, DEPTH = 4, NTHR = 512;
constexpr size_t SZ_WIN = (size_t)INC * DM * 2, SZ_WOUT = (size_t)DM * DM * 2, SZ_WMI = (size_t)FF * DM * 2, SZ_WMO = (size_t)DM * FF * 2;
constexpr size_t WS_WIN = 0, WS_WOUT = WS_WIN + DEPTH * SZ_WIN, WS_WMI = WS_WOUT + DEPTH * SZ_WOUT, WS_WMO = WS_WMI + DEPTH * SZ_WMI;
constexpr size_t WS_X = WS_WMO + DEPTH * SZ_WMO, WS_XB = WS_X + (size_t)SEQ * DM * 4, WS_PROJ = WS_XB + (size_t)SEQ * DM * 2, WS_MIX = WS_PROJ + (size_t)SEQ * INC * 2;
constexpr size_t WS_U = WS_MIX + (size_t)SEQ * DM * 2, WS_SS = WS_U + (size_t)SEQ * FF * 2, WS_COS = WS_SS + 9 * (size_t)SEQ * 32 * 4, WS_SIN = WS_COS + (size_t)SEQ * 32 * 4;
constexpr size_t WS_LAM = WS_SIN + (size_t)SEQ * 32 * 4, WS_BAR = WS_LAM + 256, WS_NASS = WS_BAR + 16384, WS_END = WS_NASS + (size_t)SEQ * 8 * 4;
#ifndef REP_P0
#define REP_P0 1
#endif
#ifndef REP_P1
#define REP_P1 1
#endif
#ifndef REP_P2
#define REP_P2 1
#endif
#ifndef REP_P3
#define REP_P3 1
#endif
#ifndef REP_P4
#define REP_P4 1
#endif
#ifndef REP_P6
#define REP_P6 1
#endif
#ifndef REP_P5
#define REP_P5 1
#endif
constexpr int LDS_BYTES = 139264;
static_assert(att::ATT_LDS <= LDS_BYTES && pg8::STAGE_BYTES <= LDS_BYTES, "LDS map");

struct Args {
    const float* in[15]; float* out; unsigned char* ws;
    double invf[32];
    float lam_init[4]; int pad[2];
};

__device__ __forceinline__ float wave_sum(float v) {
#pragma unroll
    for (int o = 1; o < 64; o <<= 1) v += __shfl_xor(v, o);
    return v;
}
__device__ __forceinline__ unsigned pk2(float lo, float hi) { return pg8::cvt_pk_bf16(lo, hi); }

struct TpItem { const float* W; bf16_t* WT; const float* gv; int K, N, k0, n0, krot; bool perm; };
__device__ __forceinline__ void tp_load(const TpItem& d, int lane, float (&w)[32]) {
    const float* wp = d.W + (size_t)(d.k0 + (lane >> 5)) * d.N + d.n0 + (lane & 31);
#pragma unroll
    for (int i = 0; i < 32; ++i) w[i] = wp[(size_t)(2 * i) * d.N];
}
__device__ __forceinline__ void tp_store(const TpItem& d, int lane, const float (&w)[32], LAS float* scr) {
    const int c = lane & 7;
    v4f g0 = {1.f, 1.f, 1.f, 1.f}, g1 = {1.f, 1.f, 1.f, 1.f};
    if (d.gv) { g0 = *(const v4f*)(d.gv + d.k0 + 8 * c); g1 = *(const v4f*)(d.gv + d.k0 + 8 * c + 4); }
#pragma unroll
    for (int i = 0; i < 32; ++i) scr[(2 * i + (lane >> 5)) * 33 + (lane & 31)] = w[i];
    asm volatile("s_waitcnt lgkmcnt(0)" ::: "memory");
#pragma unroll
    for (int j = 0; j < 4; ++j) { const int n = (lane >> 3) + 8 * j; const LAS float* s = scr + (8 * c) * 33 + n;
        v4u o; o.x = pk2(s[0 * 33] * g0.x, s[1 * 33] * g0.y); o.y = pk2(s[2 * 33] * g0.z, s[3 * 33] * g0.w); o.z = pk2(s[4 * 33] * g1.x, s[5 * 33] * g1.y); o.w = pk2(s[6 * 33] * g1.z, s[7 * 33] * g1.w);
        const int no = d.n0 + n; int dst = no;
        if (d.perm && no < 2048) { const int q = no & 63; dst = (no & ~63) + 8 * ((q & 31) >> 2) + 4 * (q >> 5) + (q & 3); }
        *(v4u*)(d.WT + (size_t)dst * d.K + ((d.k0 + d.krot) & (d.K - 1)) + 8 * c) = o; }
    asm volatile("s_waitcnt lgkmcnt(0)" ::: "memory");
}

__global__ void __launch_bounds__(NTHR, 2) fwd_megakernel(Args a) {
    extern __shared__ __attribute__((aligned(16))) unsigned char lds[];
    cg::grid_group grid = cg::this_grid();
#define GRID_SYNC() do { asm volatile("s_waitcnt vmcnt(0) lgkmcnt(0)" ::: "memory"); grid.sync(); __builtin_amdgcn_fence(__ATOMIC_ACQUIRE, "agent"); asm volatile("s_waitcnt vmcnt(0)" ::: "memory"); } while (0)
    const int tid = threadIdx.x, lane = tid & 63, wave = __builtin_amdgcn_readfirstlane(tid >> 6);
    const int G = gridDim.x, bx = blockIdx.x;
    const int gw = bx * 8 + wave, NGW = G * 8;
    unsigned char* ws = a.ws;
    bf16_t* WinT = (bf16_t*)(ws + WS_WIN); bf16_t* WoutT = (bf16_t*)(ws + WS_WOUT); bf16_t* WmiT = (bf16_t*)(ws + WS_WMI); bf16_t* WmoT = (bf16_t*)(ws + WS_WMO);
    float* X = (float*)(ws + WS_X); bf16_t* XB = (bf16_t*)(ws + WS_XB); bf16_t* PROJ = (bf16_t*)(ws + WS_PROJ); bf16_t* MIX = (bf16_t*)(ws + WS_MIX); bf16_t* U = (bf16_t*)(ws + WS_U);
    float* SS = (float*)(ws + WS_SS); float* COS = (float*)(ws + WS_COS); float* SIN = (float*)(ws + WS_SIN); float* LAM = (float*)(ws + WS_LAM); float* NASS = (float*)(ws + WS_NASS);
    LAS unsigned char* ldsl = (LAS unsigned char*)lds;
    volatile LAS unsigned* bst = (volatile LAS unsigned*)(ldsl + 135168);
    if (tid < 2) bst[tid] = 0u;
    __syncthreads();
    const XcdBarrier xbar = xcd_barrier_post((unsigned*)(ws + WS_BAR), bst);

    for (int rep = 0; rep < REP_P0; ++rep) {
        LAS float* scr = (LAS float*)(ldsl + wave * 16384);
        constexpr int I_IN = (DM / 64) * (INC / 32), I_OUT = (DM / 64) * (DM / 32), I_MI = (DM / 64) * (FF / 32), I_MO = (FF / 64) * (DM / 32), I_L = I_IN + I_OUT + I_MI + I_MO;
        auto mk = [&](int it) {
            TpItem d; const int l = it / I_L; int r = it % I_L; d.gv = nullptr; d.perm = false; d.krot = 0;
            if (r < I_IN) { d.W = a.in[2] + (size_t)l * DM * INC; d.K = DM; d.N = INC; d.WT = WinT + (size_t)l * INC * DM; d.gv = a.in[1] + l * DM; d.perm = true; }
            else if ((r -= I_IN) < I_OUT) {
                d.W = a.in[10] + (size_t)l * DM * DM; d.K = DM; d.N = DM; d.WT = WoutT + (size_t)l * DM * DM; d.krot = 1024; if (r / (DM / 32) >= 16) d.gv = a.in[8] + l * 1024 - 1024; }
            else if ((r -= I_OUT) < I_MI) { d.W = a.in[12] + (size_t)l * DM * FF; d.K = DM; d.N = FF; d.WT = WmiT + (size_t)l * FF * DM; d.gv = a.in[11] + l * DM; }
            else { r -= I_MI; d.W = a.in[13] + (size_t)l * FF * DM; d.K = FF; d.N = DM; d.WT = WmoT + (size_t)l * DM * FF; }
            const int nblk = d.N / 32; d.k0 = 64 * (r / nblk); d.n0 = 32 * (r % nblk);
            return d; };
        {
            constexpr int NIT = DEPTH * I_L; float wa[32], wb[32]; int it = gw;
            TpItem da = mk(it < NIT ? it : 0), db = da;
            if (it < NIT) tp_load(da, lane, wa);
            while (it < NIT) {
                const int itb = it + NGW; if (itb < NIT) { db = mk(itb); tp_load(db, lane, wb); }
                tp_store(da, lane, wa, scr);
                if (itb >= NIT) break;
                const int ita = itb + NGW; if (ita < NIT) { da = mk(ita); tp_load(da, lane, wa); }
                tp_store(db, lane, wb, scr);
                it = ita;
            }
        }
        for (int m = gw; m < SEQ; m += NGW) {
            const v4f* xr = (const v4f*)(a.in[0] + (size_t)m * DM) + lane; v2u* bo = (v2u*)(XB + (size_t)m * DM) + lane;
            float s = 0.f;
#pragma unroll
            for (int j = 0; j < 8; ++j) { const v4f v = xr[64 * j]; v2u w; w.x = pk2(v.x, v.y); w.y = pk2(v.z, v.w); bo[64 * j] = w; s += (v.x * v.x + v.y * v.y) + (v.z * v.z + v.w * v.w); }
            s = wave_sum(s);
            if (lane < 32) SS[(size_t)m * 32 + lane] = lane == 0 ? s : 0.f;
        }
        for (int i = bx * NTHR + tid; i < SEQ * 32; i += G * NTHR) {
            const int t = i >> 5, j = i & 31; double rev = (double)t * a.invf[j] * 0.15915494309189535; rev -= floor(rev);
            const float rf = (float)rev; COS[i] = __builtin_amdgcn_cosf(rf); SIN[i] = __builtin_amdgcn_sinf(rf);
        }
        if (bx == 0 && wave < DEPTH) {
            const int l = wave;
            const float p1 = wave_sum(a.in[3][l * 64 + lane] * a.in[4][l * 64 + lane]), p2 = wave_sum(a.in[5][l * 64 + lane] * a.in[6][l * 64 + lane]);
            if (lane == 0) LAM[l] = expf(p1) - expf(p2) + a.lam_init[l];
        }
    }
    GRID_SYNC();

#pragma unroll 1
    for (int l = 0; l < DEPTH; ++l) {
        const float* ss1 = SS + (size_t)(2 * l) * SEQ * 32; float* ss2 = SS + (size_t)(2 * l + 1) * SEQ * 32; float* ss3 = SS + (size_t)(2 * l + 2) * SEQ * 32;
        for (int rep = 0; rep < REP_P1; ++rep) {
            pg8::Gemm g{XB, WinT + (size_t)l * INC * DM, SEQ, INC, DM}; pg8::StaticOrder S; S.init(SEQ, INC, G, bx);
            pg8::EpiProj E{PROJ, ss1, COS, SIN};
            pg8::gemm_phase<pg8::EpiProj, pg8::StaticOrder, true, true>(ldsl, g, S, E);
        }
        xcd_barrier(xbar);
        {
            for (int rep = 0; rep < REP_P2; ++rep)
            for (int u = bx; u < 8 * 32; u += G) { const int h = u >> 5, rb = u & 31;
                att::na_unit(PROJ, MIX, NASS, h, rb, a.in[9] + ((size_t)l * 8 + h) * 15 * 31, (char*)lds); }
            const float lam = LAM[l], oml = 1.0f - a.lam_init[l];
            for (int rep = 0; rep < REP_P3; ++rep)
            for (int u = bx; u < 8 * 64; u += G) { const int h = u & 7, qb = u >> 3;
                att::diff_unit(PROJ, MIX, h, qb * 128, lam, oml, a.in[7] + l * 128, (char*)lds); }
        }
        xcd_barrier(xbar);
        for (int rep = 0; rep < REP_P4; ++rep) {
            pg8::Gemm g{MIX, WoutT + (size_t)l * DM * DM, SEQ, DM, DM}; pg8::StaticOrder S; S.init(SEQ, DM, G, bx);
            pg8::EpiResidMid E{(l == 0 && rep == 0) ? a.in[0] : (const float*)X, X, XB, ss2, (rep & 1) ? -1.f : 1.f, NASS};
            pg8::gemm_phase<pg8::EpiResidMid, pg8::StaticOrder, true, true>(ldsl, g, S, E);
        }
        xcd_barrier(xbar);
        for (int rep = 0; rep < REP_P5; ++rep) {
            pg8::Gemm g{XB, WmiT + (size_t)l * FF * DM, SEQ, FF, DM}; pg8::StaticOrder S; S.init(SEQ, FF, G, bx);
            pg8::EpiRelu2 E{U, ss2};
            pg8::gemm_phase<pg8::EpiRelu2, pg8::StaticOrder, true, true>(ldsl, g, S, E);
        }
        xcd_barrier(xbar);
        for (int rep = 0; rep < REP_P6; ++rep) {
            pg8::Gemm g{U, WmoT + (size_t)l * DM * FF, SEQ, DM, FF}; pg8::StaticOrder S; S.init(SEQ, DM, G, bx);
            pg8::EpiResid E{X, X, XB, ss3, (rep & 1) ? -1.f : 1.f, nullptr};
            pg8::gemm_phase<pg8::EpiResid, pg8::StaticOrder, true, true>(ldsl, g, S, E);
        }
        xcd_barrier(xbar);
    }
    {
        const float* fg = a.in[14]; const float* ssf = SS + (size_t)8 * SEQ * 32;
        int lnf = threadIdx.x; asm volatile("" : "+v"(lnf)); lnf &= 63;
        for (int m = gw; m < SEQ; m += NGW) {
            const float rn = rsqrtf(wave_sum(lnf < 32 ? ssf[(size_t)m * 32 + lnf] : 0.f) * (1.0f / 2048.0f) + 1e-6f);
            const v4f* xr = (const v4f*)(X + (size_t)m * DM) + lnf; v4f* xo = (v4f*)(a.out + (size_t)m * DM) + lnf; const v4f* gp = (const v4f*)fg + lnf;
#pragma unroll
            for (int j = 0; j < 8; ++j) xo[64 * j] = xr[64 * j] * rn * gp[64 * j];
        }
    }
}

extern "C" void kernel_launch(void* const* d_in, const int* in_sizes, int n_in, void* d_out, int out_size, void* d_ws, size_t ws_size, hipStream_t stream) {
    static int grid_blocks = 0;
    if (grid_blocks == 0) {
        if (n_in != 15 || out_size != SEQ * DM || ws_size < WS_END) { fprintf(stderr, "kernel_launch: unexpected shapes (n_in %d out %d ws %zu, need %zu)\n", n_in, out_size, ws_size, (size_t)WS_END); grid_blocks = -1; return; }
        int dev = 0, cus = 0, per_cu = 0;
        hipGetDevice(&dev); hipDeviceGetAttribute(&cus, hipDeviceAttributeMultiprocessorCount, dev);
        if (hipFuncSetAttribute((const void*)fwd_megakernel, hipFuncAttributeMaxDynamicSharedMemorySize, LDS_BYTES) != hipSuccess) { fprintf(stderr, "kernel_launch: hipFuncSetAttribute failed\n"); grid_blocks = -1; return; }
        if (hipOccupancyMaxActiveBlocksPerMultiprocessor(&per_cu, (const void*)fwd_megakernel, NTHR, LDS_BYTES) != hipSuccess || per_cu < 1) { fprintf(stderr, "kernel_launch: occupancy query gave %d\n", per_cu); per_cu = 1; (void)hipGetLastError(); }
        grid_blocks = cus * per_cu;
    }
    if (grid_blocks < 0) return;
    Args a{};
    for (int i = 0; i < 15; ++i) a.in[i] = (const float*)d_in[i];
    a.out = (float*)d_out; a.ws = (unsigned char*)d_ws;
    for (int j = 0; j < 32; ++j) a.invf[j] = 1.0 / pow(10000.0, (double)(2 * j) / 64.0);
    for (int l = 0; l < 4; ++l) a.lam_init[l] = (float)(0.8 - 0.6 * exp(-0.3 * l));
    if (hipMemsetAsync((char*)d_ws + WS_BAR, 0, XCD_BAR_WORDS * 4, stream) != hipSuccess) { fprintf(stderr, "kernel_launch: hipMemsetAsync of the barrier words failed\n"); return; }
    void* args[] = {&a};
    hipError_t e = hipLaunchCooperativeKernel((void*)fwd_megakernel, dim3(grid_blocks), dim3(NTHR), args, LDS_BYTES, stream);
    if (e != hipSuccess) fprintf(stderr, "cooperative launch failed: %s (grid %d)\n", hipGetErrorString(e), grid_blocks);
}
```
